# Optimizing an MI355X kernel written in HIP

```python
import jax
import jax.numpy as jnp
from jax import lax
import numpy as np

D_MODEL = 1024
BATCH = 8
SEQ = 2048
DEPTH = 4

GRID_W = 64
CTX_LEN = 256
EPS = 1e-6
ROPE_THETA = 10000.0
Q_BLOCK = 128

A_HEADS = 8
A_NOPE = 64
A_ROPE = 32
A_V = 64
A_QK = A_NOPE + A_ROPE
KV_LORA = 256
Q_LORA = 768
A_WIDTH = A_HEADS * A_V

B_HEADS = 4
B_DK = 64
B_DV = 128
B_KW = B_HEADS * B_DK
B_WIDTH = B_HEADS * B_DV
GATE_RANK = 16
GATE_TAU = 16.0
CHUNK = 64

C_HEADS = 16
C_HD = 64
C_WIDTH = C_HEADS * C_HD
WIN_ROWS = 8
WIN_COLS = 16

EVEN_SPLITS = (Q_LORA, KV_LORA, A_ROPE, A_WIDTH, B_KW, B_KW, B_WIDTH, 2 * GATE_RANK, B_WIDTH)
EVEN_IN = sum(EVEN_SPLITS)
ODD_IN = 4 * C_WIDTH
N_EVEN = (DEPTH + 1) // 2
N_ODD = DEPTH // 2

kernel_name = "hybrid_mla_gla_natten_prefix_dit"


def rms_norm(x, gain):
    xf = x.astype(jnp.float32)
    y = xf * lax.rsqrt(jnp.mean(xf * xf, axis=-1, keepdims=True) + EPS)
    return (y * gain.astype(jnp.float32)).astype(x.dtype)


def split_cols(u, sizes):
    idx = np.cumsum(sizes)[:-1].tolist()
    return jnp.split(u, idx, axis=-1)


def modulation(cond, w, b):
    m = jnp.dot(jax.nn.silu(cond), w) + b
    return jnp.split(m[..., None, :], 3, axis=-1)


def axial_rope_tables(n):
    t = jnp.arange(n)
    row = (t // GRID_W).astype(jnp.float32)
    col = (t % GRID_W).astype(jnp.float32)
    d_ax = A_ROPE // 2
    inv = ROPE_THETA ** (-jnp.arange(0, d_ax, 2, dtype=jnp.float32) / d_ax)
    ang = jnp.stack([row[:, None] * inv, col[:, None] * inv], axis=1)
    return jnp.cos(ang), jnp.sin(ang)


def apply_axial_rope(x, cos, sin):
    shp = x.shape
    xr = x.astype(jnp.float32).reshape(shp[:-1] + (2, 2, shp[-1] // 4))
    x1, x2 = xr[..., 0, :], xr[..., 1, :]
    cs, sn = cos[None, :, None], sin[None, :, None]
    out = jnp.stack([x1 * cs - x2 * sn, x2 * cs + x1 * sn], axis=-2)
    return out.reshape(shp).astype(x.dtype)


def block_attention(q, k, v, scale):
    bsz, n, h, dq = q.shape
    nb = n // Q_BLOCK
    qb = q.reshape(bsz, nb, Q_BLOCK, h, dq).transpose(1, 0, 2, 3, 4)

    def one(qi):
        s = jnp.einsum('bqhd,bkhd->bhqk', qi, k, preferred_element_type=jnp.float32) * scale
        p = jax.nn.softmax(s, axis=-1).astype(v.dtype)
        return jnp.einsum('bhqk,bkhd->bqhd', p, v)

    o = lax.map(one, qb)
    return o.transpose(1, 0, 2, 3, 4).reshape(bsz, n, h, v.shape[-1])


def mla_heads(q_lat, kv_lat, k_rope, q_norm, w_uq, kv_norm, w_ukv, q_gain, k_gain, rope):
    bsz, n, _ = q_lat.shape
    q = jnp.dot(rms_norm(q_lat, q_norm), w_uq).reshape(bsz, n, A_HEADS, A_QK)
    kv = jnp.dot(rms_norm(kv_lat, kv_norm), w_ukv).reshape(bsz, n, A_HEADS, A_NOPE + A_V)
    k = jnp.concatenate(
        [kv[..., :A_NOPE], jnp.broadcast_to(k_rope[:, :, None, :], (bsz, n, A_HEADS, A_ROPE))], axis=-1)
    q = rms_norm(q, q_gain)
    k = rms_norm(k, k_gain)
    if rope is not None:
        cos, sin = rope
        q = jnp.concatenate([q[..., :A_NOPE], apply_axial_rope(q[..., A_NOPE:], cos, sin)], axis=-1)
        k = jnp.concatenate([k[..., :A_NOPE], apply_axial_rope(k[..., A_NOPE:], cos, sin)], axis=-1)
    return q, k, kv[..., A_NOPE:]


def gla_inputs(gq, gk, gv, g_lr, gate_w, gate_b):
    bsz, n, _ = gq.shape
    q = gq.reshape(bsz, n, B_HEADS, B_DK) * (B_DK ** -0.5)
    k = gk.reshape(bsz, n, B_HEADS, B_DK)
    v = gv.reshape(bsz, n, B_HEADS, B_DV)
    r = g_lr.reshape(bsz, n, 2, GATE_RANK)
    logits = jnp.einsum('bnzr,zrk->bnzk', r, gate_w) + gate_b
    g = (jax.nn.log_sigmoid(logits.astype(jnp.float32)) / GATE_TAU).reshape(bsz, n, 2, B_HEADS, B_DK)
    return q, k, v, g[:, :, 0], g[:, :, 1]


def gla_scan(q, k, v, g, s0):
    bsz, n, h, dk = q.shape
    dv = v.shape[-1]
    nc = n // CHUNK

    def to_chunks(t):
        return t.astype(jnp.float32).reshape(bsz, nc, CHUNK, h, t.shape[-1]).transpose(1, 0, 3, 2, 4)

    mask = jnp.tril(jnp.ones((CHUNK, CHUNK), dtype=bool))

    def step(state, inp):
        qi, ki, vi, gi = inp
        b = jnp.cumsum(gi, axis=-2)
        b_last = b[..., -1:, :]
        q_t = qi * jnp.exp(b)
        k_t = ki * jnp.exp(-b)
        att = jnp.where(mask, jnp.einsum('bhld,bhmd->bhlm', q_t, k_t), 0.0)
        o = jnp.einsum('bhld,bhde->bhle', q_t, state) + jnp.einsum('bhlm,bhme->bhle', att, vi)
        k_dec = ki * jnp.exp(b_last - b)
        state = state * jnp.exp(b_last)[..., 0, :, None] + jnp.einsum('bhld,bhle->bhde', k_dec, vi)
        return state, o

    s_final, o = lax.scan(step, s0, (to_chunks(q), to_chunks(k), to_chunks(v), to_chunks(g)))
    return o.transpose(1, 0, 3, 2, 4).reshape(bsz, n, h, dv), s_final


def gla_bidirectional(lat, ctx):
    ql, kl, vl, gfl, gbl = lat
    qc, kc, vc, gfc, gbc = ctx
    s0 = jnp.zeros((ql.shape[0], B_HEADS, B_DK, B_DV), jnp.float32)
    flip = lambda t: jnp.flip(t, axis=1)
    oc_f, sc_f = gla_scan(qc, kc, vc, gfc, s0)
    oc_b, sc_b = gla_scan(flip(qc), flip(kc), flip(vc), flip(gbc), s0)
    ol_f, _ = gla_scan(ql, kl, vl, gfl, sc_f)
    ol_b, _ = gla_scan(flip(ql), flip(kl), flip(vl), flip(gbl), sc_b)
    return ol_f + flip(ol_b), oc_f + flip(oc_b)


def even_mixer(h, hc, rope, w_in, q_norm, w_uq, kv_norm, w_ukv, q_gain, k_gain,
               gate_w, gate_b, gla_norm, w_out, update_ctx):
    lat = split_cols(jnp.dot(h, w_in), EVEN_SPLITS)
    cp = split_cols(jnp.dot(hc, w_in), EVEN_SPLITS)
    mla_p = (q_norm, w_uq, kv_norm, w_ukv, q_gain, k_gain)
    q_x, k_x, v_x = mla_heads(lat[0], lat[1], lat[2], *mla_p, rope)
    q_c, k_c, v_c = mla_heads(cp[0], cp[1], cp[2], *mla_p, None)
    scale = A_QK ** -0.5
    a_x = block_attention(q_x, jnp.concatenate([k_x, k_c], axis=1), jnp.concatenate([v_x, v_c], axis=1), scale)
    b_x, b_c = gla_bidirectional(gla_inputs(lat[4], lat[5], lat[6], lat[7], gate_w, gate_b),
                                 gla_inputs(cp[4], cp[5], cp[6], cp[7], gate_w, gate_b))
    gla_gain = gla_norm.reshape(B_HEADS, B_DV)

    def readout(a, b, za, zb):
        bsz, n = a.shape[:2]
        a = a.reshape(bsz, n, A_WIDTH) * jax.nn.silu(za)
        b = rms_norm(b, gla_gain).reshape(bsz, n, B_WIDTH).astype(zb.dtype) * jax.nn.silu(zb)
        return jnp.dot(jnp.concatenate([a, b], axis=-1), w_out)

    y = readout(a_x, b_x, lat[3], lat[8])
    yc = None
    if update_ctx:
        a_c = block_attention(q_c, k_c, v_c, scale)
        yc = readout(a_c, b_c, cp[3], cp[8])
    return y, yc


def neighborhood_attention(q, k, v, k_ctx, v_ctx, rpb):
    bsz, n, h, d = q.shape
    rows = n // GRID_W
    kr = min(WIN_ROWS, rows)
    kc = WIN_COLS
    scale = d ** -0.5
    kg = k.reshape(bsz, rows, GRID_W, h, d)
    vg = v.reshape(bsz, rows, GRID_W, h, d)
    qg = q.reshape(bsz, rows, GRID_W, h, d).transpose(1, 0, 2, 3, 4)
    col = jnp.arange(GRID_W)
    col_start = jnp.clip(col - kc // 2, 0, GRID_W - kc)
    col_mask = (col[None, :] >= col_start[:, None]) & (col[None, :] < col_start[:, None] + kc)
    col_idx = jnp.clip(col[None, :] - col[:, None] + WIN_COLS - 1, 0, 2 * WIN_COLS - 2)

    def one_row(args):
        qr, r = args
        r_start = jnp.clip(r - kr // 2, 0, rows - kr)
        kb = lax.dynamic_slice_in_dim(kg, r_start, kr, axis=1)
        vb = lax.dynamic_slice_in_dim(vg, r_start, kr, axis=1)
        row_idx = r_start + jnp.arange(kr) - r + WIN_ROWS - 1
        bias = rpb[:, row_idx][:, :, col_idx].transpose(0, 2, 1, 3)
        s_lat = jnp.einsum('bqhd,brkhd->bhqrk', qr, kb, preferred_element_type=jnp.float32) * scale
        s_lat = s_lat + bias.astype(jnp.float32)[None]
        s_lat = jnp.where(col_mask[None, None, :, None, :], s_lat, -jnp.inf).reshape(bsz, h, GRID_W, kr * GRID_W)
        s_ctx = jnp.einsum('bqhd,bchd->bhqc', qr, k_ctx, preferred_element_type=jnp.float32) * scale
        p = jax.nn.softmax(jnp.concatenate([s_lat, s_ctx], axis=-1), axis=-1).astype(v.dtype)
        o = jnp.einsum('bhqk,bkhd->bqhd', p[..., :kr * GRID_W], vb.reshape(bsz, kr * GRID_W, h, d))
        return o + jnp.einsum('bhqc,bchd->bqhd', p[..., kr * GRID_W:], v_ctx)

    o = lax.map(one_row, (qg, jnp.arange(rows)))
    return o.transpose(1, 0, 2, 3, 4).reshape(bsz, n, h, d)


def odd_mixer(h, hc, w_in, q_gain, k_gain, rpb, w_out, update_ctx):
    def heads(u):
        bsz, n, _ = u.shape
        q, k, v, z = jnp.split(u, 4, axis=-1)
        sh = lambda t: t.reshape(bsz, n, C_HEADS, C_HD)
        return rms_norm(sh(q), q_gain), rms_norm(sh(k), k_gain), sh(v), z

    q_x, k_x, v_x, z_x = heads(jnp.dot(h, w_in))
    q_c, k_c, v_c, z_c = heads(jnp.dot(hc, w_in))
    o = neighborhood_attention(q_x, k_x, v_x, k_c, v_c, rpb)
    y = jnp.dot(o.reshape(h.shape[0], h.shape[1], C_WIDTH) * jax.nn.silu(z_x), w_out)
    yc = None
    if update_ctx:
        o_c = block_attention(q_c, k_c, v_c, C_HD ** -0.5)
        yc = jnp.dot(o_c.reshape(hc.shape[0], hc.shape[1], C_WIDTH) * jax.nn.silu(z_c), w_out)
    return y, yc


def setup_inputs(seed: int = 0) -> dict:
    key = jax.random.key(seed)
    ks = jax.random.split(key, 23)
    D = D_MODEL

    def normal(i, shape, s=1.0):
        return s * jax.random.normal(ks[i], shape, jnp.float32)

    def gain(i, shape):
        return 1.0 + normal(i, shape, 0.05)

    return {
        "x": normal(0, (BATCH, SEQ, D)),
        "c": normal(1, (BATCH, D)),
        "ctx": normal(2, (BATCH, CTX_LEN, D)),
        "c_ctx": normal(3, (D,)),
        "norm_g": gain(4, (DEPTH, D)),
        "ada_w": normal(5, (DEPTH, D, 3 * D), 0.5 * D ** -0.5),
        "ada_b": normal(6, (DEPTH, 3 * D), 0.02),
        "ev_w_in": normal(7, (N_EVEN, D, EVEN_IN), D ** -0.5),
        "ev_q_norm": gain(8, (N_EVEN, Q_LORA)),
        "ev_w_uq": normal(9, (N_EVEN, Q_LORA, A_HEADS * A_QK), Q_LORA ** -0.5),
        "ev_kv_norm": gain(10, (N_EVEN, KV_LORA)),
        "ev_w_ukv": normal(11, (N_EVEN, KV_LORA, A_HEADS * (A_NOPE + A_V)), KV_LORA ** -0.5),
        "ev_q_gain": gain(12, (N_EVEN, A_QK)),
        "ev_k_gain": gain(13, (N_EVEN, A_QK)),
        "ev_gate_w": normal(14, (N_EVEN, 2, GATE_RANK, B_KW), GATE_RANK ** -0.5),
        "ev_gate_b": normal(15, (N_EVEN, 2, B_KW), 0.1),
        "ev_gla_norm": gain(16, (N_EVEN, B_WIDTH)),
        "ev_w_out": normal(17, (N_EVEN, A_WIDTH + B_WIDTH, D), (A_WIDTH + B_WIDTH) ** -0.5),
        "od_w_in": normal(18, (N_ODD, D, ODD_IN), D ** -0.5),
        "od_q_gain": gain(19, (N_ODD, C_HD)),
        "od_k_gain": gain(20, (N_ODD, C_HD)),
        "od_rpb": normal(21, (N_ODD, C_HEADS, 2 * WIN_ROWS - 1, 2 * WIN_COLS - 1), 0.1),
        "od_w_out": normal(22, (N_ODD, C_WIDTH, D), C_WIDTH ** -0.5),
    }


def reference(x, c, ctx, c_ctx, norm_g, ada_w, ada_b, ev_w_in, ev_q_norm, ev_w_uq, ev_kv_norm, ev_w_ukv,
              ev_q_gain, ev_k_gain, ev_gate_w, ev_gate_b, ev_gla_norm, ev_w_out,
              od_w_in, od_q_gain, od_k_gain, od_rpb, od_w_out):
    rope = axial_rope_tables(x.shape[1])
    cx = ctx
    for i in range(DEPTH):
        update_ctx = i < DEPTH - 1
        shift, scale, gate = modulation(c, ada_w[i], ada_b[i])
        c_shift, c_scale, c_gate = modulation(c_ctx, ada_w[i], ada_b[i])
        h = rms_norm(x, norm_g[i]) * (1 + scale) + shift
        hc = rms_norm(cx, norm_g[i]) * (1 + c_scale) + c_shift
        j = i // 2
        if i % 2 == 0:
            y, yc = even_mixer(h, hc, rope, ev_w_in[j], ev_q_norm[j], ev_w_uq[j], ev_kv_norm[j], ev_w_ukv[j],
                               ev_q_gain[j], ev_k_gain[j], ev_gate_w[j], ev_gate_b[j], ev_gla_norm[j],
                               ev_w_out[j], update_ctx)
        else:
            y, yc = odd_mixer(h, hc, od_w_in[j], od_q_gain[j], od_k_gain[j], od_rpb[j], od_w_out[j], update_ctx)
        x = x + gate * y
        if update_ctx:
            cx = cx + c_gate * yc
    return x
```

```cpp
#include <hip/hip_runtime.h>
#include <hip/hip_cooperative_groups.h>
#include <stdint.h>
#include <stdio.h>
namespace cg = cooperative_groups;
#ifndef PHM
#define PHM 0xffff
#endif
#ifndef DBLM
#define DBLM 0
#endif
#define GSYNC() do { xcd_barrier(xbar); if (NREP(6) == 2) xcd_barrier(xbar); } while (0)
#define NREP(k) (((DBLM >> (k)) & 1) ? 2 : 1)

#define DI __device__ __forceinline__
typedef unsigned short bf16_t;
typedef short bf16x8 __attribute__((ext_vector_type(8)));
typedef short s16x4 __attribute__((ext_vector_type(4)));
typedef float f32x4 __attribute__((ext_vector_type(4)));
typedef float f32x16 __attribute__((ext_vector_type(16)));
typedef unsigned u32x4 __attribute__((ext_vector_type(4)));
typedef unsigned u32x2 __attribute__((ext_vector_type(2)));

constexpr int D = 1024, NB = 8, SEQ = 2048, CTXL = 256, NLAT = NB * SEQ, NCTX = NB * CTXL, NTOK = NLAT + NCTX, KEYS = SEQ + CTXL;
constexpr int EVEN_IN = 3136, ODD_IN = 4096;
constexpr int U1W = 1056, U2W = 2080;
constexpr int U2_ZA = 0, U2_QB = 512, U2_KB = 768, U2_VB = 1024, U2_GLR = 1536, U2_ZB = 1568;
constexpr float EPS = 1e-6f;
constexpr float LOG2E = 1.4426950408889634f;
constexpr int NCHUNK = 36;

constexpr size_t WS_WT = 0;
constexpr size_t WT_EV_IN = 0, WT_EV_UQ = (size_t)EVEN_IN * D * 2, WT_EV_UKV = WT_EV_UQ + (size_t)768 * 768 * 2,
                 WT_EV_OUT = WT_EV_UKV + (size_t)1024 * 256 * 2;
constexpr size_t WT_OD_IN = 0, WT_OD_OUT = (size_t)ODD_IN * D * 2;
constexpr size_t WT_BYTES = (size_t)ODD_IN * D * 2 + (size_t)D * D * 2;
constexpr size_t WS_MOD = WS_WT + WT_BYTES;
constexpr size_t WS_ROPEC = WS_MOD + 4 * 9 * 3072 * 4;
constexpr size_t WS_ROPES = WS_ROPEC + 2048 * 16 * 4;
constexpr size_t WS_DEC = WS_ROPES + 2048 * 16 * 4;
constexpr size_t WS_CX = WS_DEC + 64 * 36 * 64 * 4;
constexpr size_t WS_R1 = WS_CX + (size_t)NCTX * D * 4;
constexpr size_t R1_QA = 0, R1_KA = (size_t)NB * 8 * KEYS * 96 * 2, R1_VAT = 2 * R1_KA;
constexpr size_t R1_BYTES = 2 * R1_KA + (size_t)NB * 8 * 64 * KEYS * 2;
constexpr size_t WS_R2 = WS_R1 + R1_BYTES;
constexpr size_t R2_BYTES = (size_t)NTOK * U1W * 2;
constexpr size_t WS_U2 = WS_R2 + R2_BYTES;
constexpr size_t U2_BYTES = (size_t)NTOK * U2W * 2;
constexpr size_t WS_KVST = WS_U2 + U2_BYTES;
constexpr size_t KVST_BYTES = (size_t)64 * 36 * 8192 * 2;
constexpr size_t WS_END_EVEN = WS_KVST + KVST_BYTES;
constexpr size_t WS_OH = WS_R1;
constexpr size_t OH_BYTES = (size_t)NTOK * D * 2;
constexpr size_t WS_QC = WS_OH + OH_BYTES;
constexpr size_t QC_BYTES = (size_t)NB * 16 * KEYS * 64 * 2;
constexpr size_t WS_KC = WS_QC + QC_BYTES, WS_VCT = WS_KC + QC_BYTES, WS_ZC = WS_VCT + QC_BYTES;
constexpr size_t WS_END_ODD = WS_ZC + OH_BYTES;
constexpr size_t WS_BAR = ((WS_END_EVEN > WS_END_ODD ? WS_END_EVEN : WS_END_ODD) + 255) / 256 * 256;
constexpr size_t BAR_BYTES = 16384;
constexpr size_t WS_NEED = WS_BAR + BAR_BYTES;

constexpr int LDS_MAIN = 73728;
constexpr int LDS_BYTES = LDS_MAIN + 16;

struct Params {
  const float *x, *c, *ctx, *c_ctx, *norm_g, *ada_w, *ada_b, *ev_w_in, *ev_q_norm, *ev_w_uq, *ev_kv_norm, *ev_w_ukv,
      *ev_q_gain, *ev_k_gain, *ev_gate_w, *ev_gate_b, *ev_gla_norm, *ev_w_out, *od_w_in, *od_q_gain, *od_k_gain, *od_rpb, *od_w_out;
  float* out;
  unsigned char* ws;
};

typedef __bf16 bf16v2_t __attribute__((ext_vector_type(2)));
typedef float f32x2_t __attribute__((ext_vector_type(2)));
DI unsigned pk2(float lo, float hi) { f32x2_t f = {lo, hi}; bf16v2_t b = __builtin_convertvector(f, bf16v2_t); return __builtin_bit_cast(unsigned, b); }
DI bf16_t f2bf(float x) { return (bf16_t)(pk2(x, 0.f) & 0xffffu); }
DI float bf2f(bf16_t b) { return __uint_as_float((unsigned)b << 16); }
DI float bflo(unsigned u) { return __uint_as_float(u << 16); }
DI float bfhi(unsigned u) { return __uint_as_float(u & 0xffff0000u); }
DI u32x4 pack8(const float* v) { u32x4 o; o.x = pk2(v[0], v[1]); o.y = pk2(v[2], v[3]); o.z = pk2(v[4], v[5]); o.w = pk2(v[6], v[7]); return o; }
DI void unpack8(u32x4 u, float* v) { v[0] = bflo(u.x); v[1] = bfhi(u.x); v[2] = bflo(u.y); v[3] = bfhi(u.y); v[4] = bflo(u.z); v[5] = bfhi(u.z); v[6] = bflo(u.w); v[7] = bfhi(u.w); }
DI float wave_sum(float v) {
#pragma unroll
  for (int o = 32; o; o >>= 1) v += __shfl_xor(v, o);
  return v;
}
DI int tid_opaque() { int t = __builtin_amdgcn_workitem_id_x(); asm volatile("" : "+v"(t)); return t; }
DI void st_wt(u32x4* p, u32x4 v) { asm volatile("global_store_dwordx4 %0, %1, off sc1\n\ts_nop 1" :: "v"(p), "v"(v) : "memory"); }
DI void st_wt(f32x4* p, f32x4 v) { asm volatile("global_store_dwordx4 %0, %1, off sc1\n\ts_nop 1" :: "v"(p), "v"(v) : "memory"); }
DI float silu_f(float z) { return z / (1.f + __expf(-z)); }
DI float exp2_fast(float x) { return __builtin_amdgcn_exp2f(x); }
DI int crow(int i, int h) { return (i & 3) + 8 * (i >> 2) + 4 * h; }
#define MFMA32(a, b, c) __builtin_amdgcn_mfma_f32_32x32x16_bf16((a), (b), (c), 0, 0, 0)
#define MFMA16(a, b, c) __builtin_amdgcn_mfma_f32_16x16x32_bf16((a), (b), (c), 0, 0, 0)


#define XB_TMO      128
#define XB_XCNT(j)  (256  + 64 * (j))
#define XB_XSUB(j)  (1280 + 64 * (j))
#define XB_XGEN(j)  (2304 + 64 * (j))
#define XB_TOP      3328
#define XB_TOPGEN   3392
#define XCD_BAR_WORDS 3456
#define XB_SPIN_CAP (1u << 18)
#define LAS __attribute__((address_space(3)))
DI unsigned xb_ld(unsigned* p) { return __hip_atomic_load(p, __ATOMIC_RELAXED, __HIP_MEMORY_SCOPE_AGENT); }
DI unsigned xb_add(unsigned* p, unsigned v) { return __hip_atomic_fetch_add(p, v, __ATOMIC_RELAXED, __HIP_MEMORY_SCOPE_AGENT); }
DI unsigned xb_xcc_id() { return (unsigned)__builtin_amdgcn_s_getreg((3 << 11) | 20) & 0xFu; }
#define XB_SPIN(cond, bar) do { unsigned _sp = 0; while (cond) { __builtin_amdgcn_s_sleep(1); \
    if ((++_sp & 255u) == 0u) { if (xb_ld(&(bar)[XB_TMO])) break; if (_sp > XB_SPIN_CAP) { atomicAdd(&(bar)[XB_TMO], 1u); break; } } } } while (0)
struct XcdBarrier { unsigned* bar; unsigned x; volatile LAS unsigned* st; };
DI XcdBarrier xcd_barrier_post(unsigned* bar, volatile LAS unsigned* st) {
  XcdBarrier b; b.bar = bar; b.x = xb_xcc_id(); b.st = st;
  if (__builtin_amdgcn_workitem_id_x() == 0) (void)xb_add(&bar[XB_XCNT(b.x)], 1u);
  return b;
}
DI void xcd_barrier_complete(unsigned* bar, unsigned x, unsigned& nloc, unsigned& nx) {
  const unsigned G = gridDim.x * gridDim.y * gridDim.z;
  unsigned sum, cnt, mine, sp = 0u;
  for (;;) {
    sum = 0u; cnt = 0u; mine = 0u;
#pragma unroll
    for (unsigned j = 0; j < 16; ++j) { const unsigned c = xb_ld(&bar[XB_XCNT(j)]); sum += c; cnt += (c > 0u) ? 1u : 0u; mine = (j == x) ? c : mine; }
    if (sum == G) break;
    __builtin_amdgcn_s_sleep(1);
    if ((++sp & 255u) == 0u) { if (xb_ld(&bar[XB_TMO])) break; if (sp > XB_SPIN_CAP) { atomicAdd(&bar[XB_TMO], 1u); break; } }
  }
  nloc = mine > 0u ? mine : 1u; nx = cnt > 0u ? cnt : 1u;
}
DI void xcd_barrier(const XcdBarrier& b) {
  asm volatile("s_waitcnt vmcnt(0)" ::: "memory");
  __syncthreads();
  if (__builtin_amdgcn_workitem_id_x() == 0) {
    unsigned* bar = b.bar;
    const unsigned bx = xb_xcc_id();
    __builtin_amdgcn_s_waitcnt(0);
    unsigned nloc = b.st[0], nx = b.st[1];
    if (nloc == 0u) { xcd_barrier_complete(bar, bx, nloc, nx); b.st[0] = nloc; b.st[1] = nx; }
    const unsigned old = xb_add(&bar[XB_XSUB(bx)], 1u);
    const unsigned gen = old / nloc;
    if (old + 1u == (gen + 1u) * nloc) {
      __builtin_amdgcn_fence(__ATOMIC_RELEASE, "agent");
      asm volatile("s_waitcnt vmcnt(0)" ::: "memory");
      const unsigned og = xb_add(&bar[XB_TOP], 1u);
      const unsigned tg = og / nx;
      if (og + 1u == (tg + 1u) * nx) xb_add(&bar[XB_TOPGEN], 1u);
      else XB_SPIN(xb_ld(&bar[XB_TOPGEN]) == tg, bar);
      __builtin_amdgcn_fence(__ATOMIC_ACQUIRE, "agent");
      xb_add(&bar[XB_XGEN(bx)], 1u);
      asm volatile("s_waitcnt vmcnt(0)" ::: "memory");
    } else {
      XB_SPIN(xb_ld(&bar[XB_XGEN(bx)]) == gen, bar);
      __builtin_amdgcn_fence(__ATOMIC_ACQUIRE, "agent");
      asm volatile("s_waitcnt vmcnt(0)" ::: "memory");
    }
  }
  __syncthreads();
}

DI void tok_bp(int m, int& b, int& pos) {
  if (m < NLAT) { b = m >> 11; pos = m & 2047; } else { int mm = m - NLAT; b = mm >> 8; pos = SEQ + (mm & 255); }
}

DI void phase_setup(const Params& p, unsigned char* lds) {
  const int t = tid_opaque();
  float* MOD = (float*)(p.ws + WS_MOD);
  for (int item = blockIdx.x; item < 384; item += gridDim.x) {
    const int layer = item / 96, n0 = (item % 96) * 32;
    float* sc = (float*)lds;
    float* red = sc + 9 * 1024;
    __syncthreads();
    for (int i = t; i < 9 * 1024; i += 256) {
      const int r = i >> 10, k = i & 1023;
      const float v = (r < 8) ? p.c[r * 1024 + k] : p.c_ctx[k];
      sc[i] = silu_f(v);
    }
    __syncthreads();
    const int col = t & 31, kq = t >> 5;
    float acc[9];
#pragma unroll
    for (int r = 0; r < 9; ++r) acc[r] = 0.f;
    const float* W = p.ada_w + (size_t)layer * 1024 * 3072 + n0 + col;
#pragma unroll 4
    for (int k = kq * 128; k < kq * 128 + 128; k += 4) {
      const float w0 = W[(size_t)k * 3072], w1 = W[(size_t)(k + 1) * 3072], w2 = W[(size_t)(k + 2) * 3072], w3 = W[(size_t)(k + 3) * 3072];
#pragma unroll
      for (int r = 0; r < 9; ++r) {
        const f32x4 s4 = *(const f32x4*)(sc + r * 1024 + k);
        acc[r] += s4.x * w0 + s4.y * w1 + s4.z * w2 + s4.w * w3;
      }
    }
#pragma unroll
    for (int r = 0; r < 9; ++r) red[(kq * 9 + r) * 32 + col] = acc[r];
    __syncthreads();
    for (int i = t; i < 9 * 32; i += 256) {
      const int r = i >> 5, cc = i & 31;
      float v = 0.f;
#pragma unroll
      for (int q = 0; q < 8; ++q) v += red[(q * 9 + r) * 32 + cc];
      MOD[(size_t)(layer * 9 + r) * 3072 + n0 + cc] = v + p.ada_b[layer * 3072 + n0 + cc];
    }
  }
  float* RC = (float*)(p.ws + WS_ROPEC);
  float* RS = (float*)(p.ws + WS_ROPES);
  for (int i = blockIdx.x * 256 + t; i < 2048 * 16; i += gridDim.x * 256) {
    const int pos = i >> 4, a = (i >> 3) & 1, f = i & 7;
    const float coord = (float)(a == 0 ? (pos >> 6) : (pos & 63));
    const float inv = exp2f(-(float)f * 0.125f * 13.287712379549449f);
    const float ang = coord * inv;
    const float k = rintf(ang * 0.15915494309189535f);
    float rr = fmaf(-k, 6.28125f, ang);
    rr = fmaf(-k, 0.0019353071795864769f, rr);
    RC[i] = __cosf(rr);
    RS[i] = __sinf(rr);
  }
}

DI void transpose_item(const float* __restrict__ W, int K, int N, bf16_t* __restrict__ WT, const float* __restrict__ kscale, int item, float* tile) {
  const int t = tid_opaque();
  const int nblk = N >> 6, kb = item / nblk, nb = item % nblk, k0 = kb * 64, n0 = nb * 64;
  __syncthreads();
  {
    const int nn = t & 63, kk0 = t >> 6;
#pragma unroll
    for (int i = 0; i < 16; ++i) {
      const int kk = kk0 + 4 * i;
      float v = W[(size_t)(k0 + kk) * N + n0 + nn];
      if (kscale) v *= kscale[k0 + kk];
      tile[kk * 65 + nn] = v;
    }
  }
  __syncthreads();
  {
    const int n = t >> 2, kc = t & 3;
    float v[16];
#pragma unroll
    for (int j = 0; j < 16; ++j) v[j] = tile[(kc * 16 + j) * 65 + n];
    bf16_t* dst = WT + (size_t)(n0 + n) * K + k0 + kc * 16;
    *(u32x4*)dst = pack8(v);
    *(u32x4*)(dst + 8) = pack8(v + 8);
  }
}

DI void phase_norm(const Params& p, int layer, unsigned char* lds) {
  const int j = layer >> 1;
  bf16_t* WT = (bf16_t*)(p.ws + WS_WT);
  float* tile = (float*)lds;
  if ((layer & 1) == 0) {
    const int n1 = 16 * 49, n2 = n1 + 12 * 12, n3 = n2 + 4 * 16, n4 = n3 + 16 * 16;
    for (int it = blockIdx.x; it < n4; it += gridDim.x) {
      if (it < n1) transpose_item(p.ev_w_in + (size_t)j * D * EVEN_IN, D, EVEN_IN, (bf16_t*)((unsigned char*)WT + WT_EV_IN), nullptr, it, tile);
      else if (it < n2) transpose_item(p.ev_w_uq + (size_t)j * 768 * 768, 768, 768, (bf16_t*)((unsigned char*)WT + WT_EV_UQ), p.ev_q_norm + j * 768, it - n1, tile);
      else if (it < n3) transpose_item(p.ev_w_ukv + (size_t)j * 256 * 1024, 256, 1024, (bf16_t*)((unsigned char*)WT + WT_EV_UKV), p.ev_kv_norm + j * 256, it - n2, tile);
      else transpose_item(p.ev_w_out + (size_t)j * D * D, D, D, (bf16_t*)((unsigned char*)WT + WT_EV_OUT), nullptr, it - n3, tile);
    }
  } else {
    const int n1 = 16 * 64, n2 = n1 + 16 * 16;
    for (int it = blockIdx.x; it < n2; it += gridDim.x) {
      if (it < n1) transpose_item(p.od_w_in + (size_t)j * D * ODD_IN, D, ODD_IN, (bf16_t*)((unsigned char*)WT + WT_OD_IN), nullptr, it, tile);
      else transpose_item(p.od_w_out + (size_t)j * D * D, D, D, (bf16_t*)((unsigned char*)WT + WT_OD_OUT), nullptr, it - n1, tile);
    }
  }
  const int lane = tid_opaque() & 63, wv = tid_opaque() >> 6;
  const float* MOD = (const float*)(p.ws + WS_MOD);
  const float* xl = (layer == 0) ? p.x : p.out;
  const float* xc = (layer == 0) ? p.ctx : (const float*)(p.ws + WS_CX);
  bf16_t* H = (bf16_t*)(p.ws + (((layer & 1) == 0) ? WS_R1 : WS_OH));
  const float* g = p.norm_g + layer * D;
  const int wstride = gridDim.x * 4;
  for (int m0 = blockIdx.x * 4 + wv; m0 < NTOK; m0 += 3 * wstride) {
    f32x4 v[3][4];
    float ss[3];
#pragma unroll
    for (int u = 0; u < 3; ++u) {
      const int m = m0 + u * wstride;
      const int mc = m < NTOK ? m : m0;
      const float* xr = (mc < NLAT) ? xl + (size_t)mc * D : xc + (size_t)(mc - NLAT) * D;
#pragma unroll
      for (int q = 0; q < 4; ++q) v[u][q] = *(const f32x4*)(xr + 4 * lane + 256 * q);
    }
#pragma unroll
    for (int u = 0; u < 3; ++u) {
      float a = 0.f;
#pragma unroll
      for (int q = 0; q < 4; ++q) a += v[u][q].x * v[u][q].x + v[u][q].y * v[u][q].y + v[u][q].z * v[u][q].z + v[u][q].w * v[u][q].w;
      ss[u] = wave_sum(a);
    }
#pragma unroll
    for (int u = 0; u < 3; ++u) {
      const int m = m0 + u * wstride;
      if (m < NTOK) {
        const int r = (m < NLAT) ? (m >> 11) : 8;
        const float* shift = MOD + (size_t)(layer * 9 + r) * 3072;
        const float* scale = shift + 1024;
        const float rstd = rsqrtf(ss[u] * (1.f / D) + EPS);
#pragma unroll
        for (int q = 0; q < 4; ++q) {
          const int k = 4 * lane + 256 * q;
          const f32x4 gg = *(const f32x4*)(g + k), sc = *(const f32x4*)(scale + k), sh = *(const f32x4*)(shift + k);
          const float o0 = v[u][q].x * rstd * gg.x * (1.f + sc.x) + sh.x, o1 = v[u][q].y * rstd * gg.y * (1.f + sc.y) + sh.y;
          const float o2 = v[u][q].z * rstd * gg.z * (1.f + sc.z) + sh.z, o3 = v[u][q].w * rstd * gg.w * (1.f + sc.w) + sh.w;
          u32x2 o; o.x = pk2(o0, o1); o.y = pk2(o2, o3);
          *(u32x2*)(H + (size_t)m * D + k) = o;
        }
      }
    }
  }
}

constexpr int ROWSTAT_OFF = 67584, ROWSTAT2_OFF = ROWSTAT_OFF + 512;

template <int NFRAG, bool SUMSQ>
DI void gemm_mainloop(const bf16_t* __restrict__ A, int lda, const bf16_t* __restrict__ Bt, int K, int nvalid,
                      f32x4 (&acc)[4][NFRAG], unsigned char* lds) {
  constexpr int NBI = NFRAG;
  bf16_t* As = (bf16_t*)lds;
  bf16_t* Bs = As + 128 * 72;
  const int t = tid_opaque(), lane = t & 63, w = t >> 6, wr = w >> 1, wc = w & 1, fr = lane & 15, fq = lane >> 4;
  const int lc = t & 7, lr = t >> 3;
  const bf16_t* Ap = A + (size_t)lr * lda + lc * 8;
  const bf16_t* Bp = Bt + (size_t)lr * K + lc * 8;
  u32x4 ra[4], rb[NBI];
  float ssq[4] = {0.f, 0.f, 0.f, 0.f};
#pragma unroll
  for (int mi = 0; mi < 4; ++mi)
#pragma unroll
    for (int ni = 0; ni < NFRAG; ++ni) acc[mi][ni] = (f32x4){0.f, 0.f, 0.f, 0.f};
  const int nk = K >> 6;
#pragma unroll
  for (int i = 0; i < 4; ++i) ra[i] = *(const u32x4*)(Ap + (size_t)(32 * i) * lda);
#pragma unroll
  for (int i = 0; i < NBI; ++i) rb[i] = (lr + 32 * i < nvalid) ? *(const u32x4*)(Bp + (size_t)(32 * i) * K) : (u32x4){0u, 0u, 0u, 0u};
  for (int kt = 0; kt < nk; ++kt) {
    __syncthreads();
#pragma unroll
    for (int i = 0; i < 4; ++i) {
      *(u32x4*)(As + (lr + 32 * i) * 72 + lc * 8) = ra[i];
      if (SUMSQ) { float v[8]; unpack8(ra[i], v);
#pragma unroll
        for (int e = 0; e < 8; ++e) ssq[i] += v[e] * v[e]; }
    }
#pragma unroll
    for (int i = 0; i < NBI; ++i) *(u32x4*)(Bs + (lr + 32 * i) * 72 + lc * 8) = rb[i];
    __syncthreads();
    if (kt + 1 < nk) {
      const int ko = (kt + 1) * 64;
#pragma unroll
      for (int i = 0; i < 4; ++i) ra[i] = *(const u32x4*)(Ap + (size_t)(32 * i) * lda + ko);
#pragma unroll
      for (int i = 0; i < NBI; ++i) rb[i] = (lr + 32 * i < nvalid) ? *(const u32x4*)(Bp + (size_t)(32 * i) * K + ko) : (u32x4){0u, 0u, 0u, 0u};
    }
#pragma unroll
    for (int kk = 0; kk < 2; ++kk) {
      bf16x8 af[4], bfr[NFRAG];
#pragma unroll
      for (int mi = 0; mi < 4; ++mi) af[mi] = *(const bf16x8*)(As + (wr * 64 + mi * 16 + fr) * 72 + kk * 32 + fq * 8);
#pragma unroll
      for (int ni = 0; ni < NFRAG; ++ni) bfr[ni] = *(const bf16x8*)(Bs + (wc * NFRAG * 16 + ni * 16 + fr) * 72 + kk * 32 + fq * 8);
#pragma unroll
      for (int mi = 0; mi < 4; ++mi)
#pragma unroll
        for (int ni = 0; ni < NFRAG; ++ni) acc[mi][ni] = MFMA16(af[mi], bfr[ni], acc[mi][ni]);
    }
  }
  constexpr int CP = 32 * NFRAG + 4;
  float* Cs = (float*)lds;
  __syncthreads();
#pragma unroll
  for (int mi = 0; mi < 4; ++mi)
#pragma unroll
    for (int ni = 0; ni < NFRAG; ++ni)
#pragma unroll
      for (int jj = 0; jj < 4; ++jj) Cs[(wr * 64 + mi * 16 + fq * 4 + jj) * CP + wc * NFRAG * 16 + ni * 16 + fr] = acc[mi][ni][jj];
  if (SUMSQ) {
    float* rowstat = (float*)(lds + ROWSTAT_OFF);
#pragma unroll
    for (int i = 0; i < 4; ++i) {
      float s = ssq[i];
      s += __shfl_xor(s, 1); s += __shfl_xor(s, 2); s += __shfl_xor(s, 4);
      if (lc == 0) rowstat[lr + 32 * i] = rsqrtf(s / (float)K + EPS);
    }
  }
  __syncthreads();
}

DI void rope8(float* v, const float* pv, const float* RC, const float* RS, int pos, int a, int half) {
  const f32x4 c0 = *(const f32x4*)(RC + pos * 16 + a * 8), c1 = *(const f32x4*)(RC + pos * 16 + a * 8 + 4);
  const f32x4 s0 = *(const f32x4*)(RS + pos * 16 + a * 8), s1 = *(const f32x4*)(RS + pos * 16 + a * 8 + 4);
  const float cs[8] = {c0.x, c0.y, c0.z, c0.w, c1.x, c1.y, c1.z, c1.w};
  const float sn[8] = {s0.x, s0.y, s0.z, s0.w, s1.x, s1.y, s1.z, s1.w};
#pragma unroll
  for (int e = 0; e < 8; ++e) v[e] = (half == 0) ? (v[e] * cs[e] - pv[e] * sn[e]) : (v[e] * cs[e] + pv[e] * sn[e]);
}


DI void xcd_tile(int v, int MPX, int NT, int MC, int& mt, int& nt) {
  const int x = v & 7, L = v >> 3;
  const int c = L / (MC * NT), base = c * MC;
  const int rows = min(MC, MPX - base), rem = L - c * MC * NT;
  nt = rem / rows;
  mt = x * MPX + base + rem % rows;
}

struct TileDesc { const bf16_t* A; const bf16_t* B; int nvalid; };

template <int NFRAG>
DI void g_issue(u32x4 (&ra)[4], u32x4 (&rb)[NFRAG], const bf16_t* cA, const bf16_t* cB, int cnv, int lda, int K, int ko, int lr) {
#pragma unroll
  for (int i = 0; i < 4; ++i) ra[i] = *(const u32x4*)(cA + (size_t)(32 * i) * lda + ko);
#pragma unroll
  for (int i = 0; i < NFRAG; ++i) { const int ro = (lr + 32 * i < cnv) ? 32 * i : 0;
    rb[i] = *(const u32x4*)(cB + (size_t)ro * K + ko); }
}

constexpr int GP = 80;

template <int NFRAG, bool SUMSQ>
DI void g_write(const u32x4 (&ra)[4], const u32x4 (&rb)[NFRAG], float (&ssq)[4], bf16_t* As, bf16_t* Bs, int lr, int lc) {
#pragma unroll
  for (int i = 0; i < 4; ++i) {
    *(u32x4*)(As + (lr + 32 * i) * GP + lc * 8) = ra[i];
    if (SUMSQ) {
      ssq[i] = __builtin_amdgcn_fdot2_f32_bf16(__builtin_bit_cast(bf16v2_t, ra[i].x), __builtin_bit_cast(bf16v2_t, ra[i].x), ssq[i], false);
      ssq[i] = __builtin_amdgcn_fdot2_f32_bf16(__builtin_bit_cast(bf16v2_t, ra[i].y), __builtin_bit_cast(bf16v2_t, ra[i].y), ssq[i], false);
      ssq[i] = __builtin_amdgcn_fdot2_f32_bf16(__builtin_bit_cast(bf16v2_t, ra[i].z), __builtin_bit_cast(bf16v2_t, ra[i].z), ssq[i], false);
      ssq[i] = __builtin_amdgcn_fdot2_f32_bf16(__builtin_bit_cast(bf16v2_t, ra[i].w), __builtin_bit_cast(bf16v2_t, ra[i].w), ssq[i], false);
    }
  }
#pragma unroll
  for (int i = 0; i < NFRAG; ++i) *(u32x4*)(Bs + (lr + 32 * i) * GP + lc * 8) = rb[i];
}

template <int NFRAG>
DI void g_read(bf16x8 (&af)[2][4], bf16x8 (&bfr)[2][NFRAG], const bf16_t* As, const bf16_t* Bs, int wr, int wc, int fr, int fq) {
#pragma unroll
  for (int kk = 0; kk < 2; ++kk) {
#pragma unroll
    for (int mi = 0; mi < 4; ++mi) af[kk][mi] = *(const bf16x8*)(As + (wr * 64 + mi * 16 + fr) * GP + kk * 32 + fq * 8);
#pragma unroll
    for (int ni = 0; ni < NFRAG; ++ni) bfr[kk][ni] = *(const bf16x8*)(Bs + (wc * NFRAG * 16 + ni * 16 + fr) * GP + kk * 32 + fq * 8);
  }
}

template <int NFRAG>
DI void g_mma(f32x4 (&acc)[4][NFRAG], const bf16x8 (&af)[2][4], const bf16x8 (&bfr)[2][NFRAG]) {
#pragma unroll
  for (int kk = 0; kk < 2; ++kk)
#pragma unroll
    for (int mi = 0; mi < 4; ++mi)
#pragma unroll
      for (int ni = 0; ni < NFRAG; ++ni) acc[mi][ni] = MFMA16(af[kk][mi], bfr[kk][ni], acc[mi][ni]);
}

template <int NFRAG, bool SUMSQ, class OPS>
DI void gemm_stream(int ntiles, int lda, int K, const OPS& ops, unsigned char* lds, int rot = 0) {
  bf16_t* As = (bf16_t*)lds;
  bf16_t* Bs = As + 128 * GP;
  const int t = tid_opaque(), lane = t & 63, w = t >> 6, wr = w >> 1, wc = w & 1, fr = lane & 15, fq = lane >> 4;
  const int lc = t & 7, lr = t >> 3;
  const int nk = K >> 6;
  const int G = gridDim.x;
  const int vb = (int)((blockIdx.x + (unsigned)rot) % gridDim.x);
  int lt = vb, lk = 0;
  const bf16_t *cA = nullptr, *cB = nullptr; int cnv = 0;
  if (lt >= ntiles) return;
  { const TileDesc d = ops.tile(lt); cA = d.A + (size_t)lr * lda + lc * 8; cB = d.B + (size_t)lr * K + lc * 8; cnv = d.nvalid; }
  u32x4 ra[4], rb[NFRAG];
#define G_ADVANCE() do { ++lk; if (lk == nk) { lk = 0; lt += G; if (lt < ntiles) { const TileDesc d = ops.tile(lt); cA = d.A + (size_t)lr * lda + lc * 8; cB = d.B + (size_t)lr * K + lc * 8; cnv = d.nvalid; } } } while (0)
  g_issue<NFRAG>(ra, rb, cA, cB, cnv, lda, K, lk * 64, lr);
  G_ADVANCE();
#pragma unroll 1
  for (int tile = vb; tile < ntiles; tile += G) {
    f32x4 acc[4][NFRAG];
    float ssq[4] = {0.f, 0.f, 0.f, 0.f};
#pragma unroll
    for (int mi = 0; mi < 4; ++mi)
#pragma unroll
      for (int ni = 0; ni < NFRAG; ++ni) acc[mi][ni] = (f32x4){0.f, 0.f, 0.f, 0.f};
    __syncthreads();
    g_write<NFRAG, SUMSQ>(ra, rb, ssq, As, Bs, lr, lc);
    g_issue<NFRAG>(ra, rb, cA, cB, cnv, lda, K, lk * 64, lr);
    G_ADVANCE();
    __syncthreads();
#pragma unroll 1
    for (int kt = 0; kt < nk - 1; ++kt) {
      bf16x8 af[2][4], bfr[2][NFRAG];
      g_read<NFRAG>(af, bfr, As, Bs, wr, wc, fr, fq);
      __syncthreads();
      g_write<NFRAG, SUMSQ>(ra, rb, ssq, As, Bs, lr, lc);
      g_issue<NFRAG>(ra, rb, cA, cB, cnv, lda, K, lk * 64, lr);
      G_ADVANCE();
      g_mma<NFRAG>(acc, af, bfr);
      __syncthreads();
    }
    {
      bf16x8 af[2][4], bfr[2][NFRAG];
      g_read<NFRAG>(af, bfr, As, Bs, wr, wc, fr, fq);
      g_mma<NFRAG>(acc, af, bfr);
    }
#undef G_ADVANCE
    constexpr int CP = 32 * NFRAG + 4;
    float* Cs = (float*)lds;
    __syncthreads();
#pragma unroll
    for (int mi = 0; mi < 4; ++mi)
#pragma unroll
      for (int ni = 0; ni < NFRAG; ++ni)
#pragma unroll
        for (int jj = 0; jj < 4; ++jj) Cs[(wr * 64 + mi * 16 + fq * 4 + jj) * CP + wc * NFRAG * 16 + ni * 16 + fr] = acc[mi][ni][jj];
    if (SUMSQ) {
      float* rowstat = (float*)(lds + ROWSTAT_OFF);
#pragma unroll
      for (int i = 0; i < 4; ++i) {
        float sv = ssq[i];
        sv += __shfl_xor(sv, 1); sv += __shfl_xor(sv, 2); sv += __shfl_xor(sv, 4);
        if (lc == 0) rowstat[lr + 32 * i] = rsqrtf(sv / (float)K + EPS);
      }
    }
    __syncthreads();
    ops.epi(tile, lds);
  }
}


template <int NFRAG, class OPS>
DI void gemm_glds(int ntiles, int lda, int K, const OPS& ops, unsigned char* lds, int rot = 0) {
  const int t = tid_opaque(), lane = t & 63, w = t >> 6, wr = w >> 1, wc = w & 1, fr = lane & 15, fq = lane >> 4;
  const int nk = K >> 6;
  const int G = gridDim.x;
  const int vb = (int)((blockIdx.x + (unsigned)rot) % gridDim.x);
  const int srow = t >> 3, skc = (t & 7) ^ ((t >> 3) & 7);
  constexpr int STAGE = 32768, BOFF = 16384;
#pragma unroll 1
  for (int tile = vb; tile < ntiles; tile += G) {
    const TileDesc d = ops.tile(tile);
    const bf16_t* gA = d.A + (size_t)srow * lda + skc * 8;
    const bf16_t* gB = d.B + (size_t)srow * K + skc * 8;
    const int cnv = d.nvalid;
    f32x4 acc[4][NFRAG];
#pragma unroll
    for (int mi = 0; mi < 4; ++mi)
#pragma unroll
      for (int ni = 0; ni < NFRAG; ++ni) acc[mi][ni] = (f32x4){0.f, 0.f, 0.f, 0.f};
    __syncthreads();
#define GLDS_ISSUE(stg, ko) do { \
      _Pragma("unroll") for (int i = 0; i < 4; ++i) \
        __builtin_amdgcn_global_load_lds((const unsigned*)(gA + (size_t)(32 * i) * lda + (ko)), (__attribute__((address_space(3))) unsigned*)(lds + (stg) * STAGE + (i * 256 + t) * 16), 16, 0, 0); \
      _Pragma("unroll") for (int i = 0; i < NFRAG; ++i) { const int ro = (srow + 32 * i < cnv) ? 32 * i : 0; \
        __builtin_amdgcn_global_load_lds((const unsigned*)(gB + (size_t)ro * K + (ko)), (__attribute__((address_space(3))) unsigned*)(lds + (stg) * STAGE + BOFF + (i * 256 + t) * 16), 16, 0, 0); } \
    } while (0)
    GLDS_ISSUE(0, 0);
    asm volatile("s_waitcnt vmcnt(0)" ::: "memory");
    __syncthreads();
#pragma unroll 1
    for (int kt = 0; kt < nk; ++kt) {
      const int sg = kt & 1;
      if (kt + 1 < nk) GLDS_ISSUE(sg ^ 1, (kt + 1) * 64);
      const unsigned char* As = lds + sg * STAGE;
      const unsigned char* Bs = As + BOFF;
#pragma unroll
      for (int kk = 0; kk < 2; ++kk) {
        bf16x8 af[4], bfr[NFRAG];
        const int sw = ((kk * 4 + fq) ^ (fr & 7)) * 16;
#pragma unroll
        for (int mi = 0; mi < 4; ++mi) af[mi] = *(const bf16x8*)(As + (wr * 64 + mi * 16 + fr) * 128 + sw);
#pragma unroll
        for (int ni = 0; ni < NFRAG; ++ni) bfr[ni] = *(const bf16x8*)(Bs + (wc * NFRAG * 16 + ni * 16 + fr) * 128 + sw);
#pragma unroll
        for (int mi = 0; mi < 4; ++mi)
#pragma unroll
          for (int ni = 0; ni < NFRAG; ++ni) acc[mi][ni] = MFMA16(af[mi], bfr[ni], acc[mi][ni]);
      }
      asm volatile("s_waitcnt vmcnt(0)" ::: "memory");
      __syncthreads();
    }
#undef GLDS_ISSUE
    constexpr int CP = 32 * NFRAG + 4;
    float* Cs = (float*)lds;
#pragma unroll
    for (int mi = 0; mi < 4; ++mi)
#pragma unroll
      for (int ni = 0; ni < NFRAG; ++ni)
#pragma unroll
        for (int jj = 0; jj < 4; ++jj) Cs[(wr * 64 + mi * 16 + fq * 4 + jj) * CP + wc * NFRAG * 16 + ni * 16 + fr] = acc[mi][ni][jj];
    __syncthreads();
    ops.epi(tile, lds);
  }
}


template <int NFRAG, class OPS, bool SUMSQ = false, bool LDSEPI = false>
DI void gemm_glds2(int ntiles, int lda, int K, const OPS& ops, unsigned char* lds, int rot = 0) {
  const int t = tid_opaque(), lane = t & 63, w = t >> 6, wr = w >> 1, wc = w & 1, fr = lane & 15, fq = lane >> 4;
  const int nk = K >> 6;
  const int G = gridDim.x;
  const int vb = (int)((blockIdx.x + (unsigned)rot) % gridDim.x);
  const int srow = t >> 3, skc = (t & 7) ^ ((t >> 3) & 7);
  constexpr int STAGE = 32768, BOFF = 16384;
  int tile = vb;
  if (tile >= ntiles) return;
  const bf16_t *gA, *gB; int cnv;
  { const TileDesc d = ops.tile(tile); gA = d.A + (size_t)srow * lda + skc * 8; gB = d.B + (size_t)srow * K + skc * 8; cnv = d.nvalid; }
#define GLDS_ISSUE(stg, ko) do { \
    _Pragma("unroll") for (int i = 0; i < 4; ++i) \
      __builtin_amdgcn_global_load_lds((const unsigned*)(gA + (size_t)(32 * i) * lda + (ko)), (__attribute__((address_space(3))) unsigned*)(lds + (stg) * STAGE + (i * 256 + t) * 16), 16, 0, 0); \
    _Pragma("unroll") for (int i = 0; i < NFRAG; ++i) { const int ro = (srow + 32 * i < cnv) ? 32 * i : 0; \
      __builtin_amdgcn_global_load_lds((const unsigned*)(gB + (size_t)ro * K + (ko)), (__attribute__((address_space(3))) unsigned*)(lds + (stg) * STAGE + BOFF + (i * 256 + t) * 16), 16, 0, 0); } \
  } while (0)
  __syncthreads();
  GLDS_ISSUE(0, 0);
#pragma unroll 1
  for (;;) {
    f32x4 acc[4][NFRAG];
#pragma unroll
    for (int mi = 0; mi < 4; ++mi)
#pragma unroll
      for (int ni = 0; ni < NFRAG; ++ni) acc[mi][ni] = (f32x4){0.f, 0.f, 0.f, 0.f};
    float ssq[4] = {0.f, 0.f, 0.f, 0.f};
    asm volatile("s_waitcnt vmcnt(0)" ::: "memory");
    __syncthreads();
#pragma unroll 1
    for (int kt = 0; kt < nk; ++kt) {
      const int sg = kt & 1;
      const unsigned char* As = lds + sg * STAGE;
      const unsigned char* Bs = As + BOFF;
#pragma unroll
      for (int kk = 0; kk < 2; ++kk) {
        bf16x8 af[4], bfr[NFRAG];
        const int sw = ((kk * 4 + fq) ^ (fr & 7)) * 16;
#pragma unroll
        for (int mi = 0; mi < 4; ++mi) af[mi] = *(const bf16x8*)(As + (wr * 64 + mi * 16 + fr) * 128 + sw);
#pragma unroll
        for (int ni = 0; ni < NFRAG; ++ni) bfr[ni] = *(const bf16x8*)(Bs + (wc * NFRAG * 16 + ni * 16 + fr) * 128 + sw);
        if (SUMSQ) {
#pragma unroll
          for (int mi = 0; mi < 4; ++mi) {
            const u32x4 aw = __builtin_bit_cast(u32x4, af[mi]);
            ssq[mi] = __builtin_amdgcn_fdot2_f32_bf16(__builtin_bit_cast(bf16v2_t, aw.x), __builtin_bit_cast(bf16v2_t, aw.x), ssq[mi], false);
            ssq[mi] = __builtin_amdgcn_fdot2_f32_bf16(__builtin_bit_cast(bf16v2_t, aw.y), __builtin_bit_cast(bf16v2_t, aw.y), ssq[mi], false);
            ssq[mi] = __builtin_amdgcn_fdot2_f32_bf16(__builtin_bit_cast(bf16v2_t, aw.z), __builtin_bit_cast(bf16v2_t, aw.z), ssq[mi], false);
            ssq[mi] = __builtin_amdgcn_fdot2_f32_bf16(__builtin_bit_cast(bf16v2_t, aw.w), __builtin_bit_cast(bf16v2_t, aw.w), ssq[mi], false);
          }
        }
        if (kk == 0 && kt + 1 < nk) GLDS_ISSUE(sg ^ 1, (kt + 1) * 64);
#pragma unroll
        for (int mi = 0; mi < 4; ++mi)
#pragma unroll
          for (int ni = 0; ni < NFRAG; ++ni) acc[mi][ni] = MFMA16(af[mi], bfr[ni], acc[mi][ni]);
      }
      asm volatile("s_waitcnt vmcnt(0)" ::: "memory");
      __syncthreads();
    }
    constexpr int CP = 32 * NFRAG + 4;
    float* Cs = (float*)lds;
#pragma unroll
    for (int mi = 0; mi < 4; ++mi)
#pragma unroll
      for (int ni = 0; ni < NFRAG; ++ni)
#pragma unroll
        for (int jj = 0; jj < 4; ++jj) Cs[(wr * 64 + mi * 16 + fq * 4 + jj) * CP + wc * NFRAG * 16 + ni * 16 + fr] = acc[mi][ni][jj];
    if (SUMSQ) {
      float* rowstat = (float*)(lds + ROWSTAT_OFF);
#pragma unroll
      for (int mi = 0; mi < 4; ++mi) {
        float sv = ssq[mi];
        sv += __shfl_xor(sv, 16); sv += __shfl_xor(sv, 32);
        if (wc == 0 && fq == 0) rowstat[wr * 64 + mi * 16 + fr] = rsqrtf(sv / (float)K + EPS);
      }
    }
    __syncthreads();
    const int cur = tile;
    if (LDSEPI) {
      ops.epi_lds(cur, lds);
      __syncthreads();
      tile += G;
      const bool more = tile < ntiles;
      if (more) {
        const TileDesc d = ops.tile(tile); gA = d.A + (size_t)srow * lda + skc * 8; gB = d.B + (size_t)srow * K + skc * 8; cnv = d.nvalid;
        GLDS_ISSUE(0, 0);
      }
      if (!more) break;
    } else {
      float c[64];
      ops.epi_read(cur, lds, c);
      __syncthreads();
      tile += G;
      const bool more = tile < ntiles;
      if (more) {
        const TileDesc d = ops.tile(tile); gA = d.A + (size_t)srow * lda + skc * 8; gB = d.B + (size_t)srow * K + skc * 8; cnv = d.nvalid;
        GLDS_ISSUE(0, 0);
      }
      ops.epi_write(cur, c);
      if (!more) break;
    }
  }
#undef GLDS_ISSUE
}

struct EvWinOps2 {
  const Params* pp;
  DI void epi_lds(int, unsigned char*) const {}
  DI TileDesc tile(int id) const {
    int mt, nt; xcd_tile(id, 18, 25, 6, mt, nt);
    TileDesc d; d.A = (const bf16_t*)(pp->ws + WS_R1) + (size_t)mt * 128 * D; d.B = (const bf16_t*)(pp->ws + WS_WT + WT_EV_IN) + (size_t)nt * 128 * D; d.nvalid = EVEN_IN - nt * 128;
    return d;
  }
  DI void epi_read(int id, unsigned char* lds, float (&c)[64]) const {
    const int t = tid_opaque();
    const float* Cs = (const float*)lds;
#pragma unroll
    for (int it = 0; it < 8; ++it) {
      const int row = (t >> 4) + 16 * it, ch = t & 15;
      *(f32x4*)(c + it * 8) = *(const f32x4*)(Cs + row * 132 + ch * 8);
      *(f32x4*)(c + it * 8 + 4) = *(const f32x4*)(Cs + row * 132 + ch * 8 + 4);
    }
  }
  DI void epi_write(int id, const float (&c)[64]) const {
    int mt, nt; xcd_tile(id, 18, 25, 6, mt, nt);
    const int m0 = mt * 128, n0 = nt * 128;
    bf16_t* U1 = (bf16_t*)(pp->ws + WS_R2);
    bf16_t* U2 = (bf16_t*)(pp->ws + WS_U2);
    const int t = tid_opaque();
    const int ch = t & 15, col = n0 + ch * 8;
    if (col < EVEN_IN) {
#pragma unroll
      for (int it = 0; it < 8; ++it) {
        const int m = m0 + (t >> 4) + 16 * it;
        bf16_t* dst = (col < U1W) ? U1 + (size_t)m * U1W + col : U2 + (size_t)m * U2W + (col - U1W);
        st_wt((u32x4*)dst, pack8(c + it * 8));
      }
    }
  }
};

struct WoutOps2 {
  const Params* pp; int layer;
  DI void epi_lds(int, unsigned char*) const {}
  DI TileDesc tile(int id) const {
    const bool even = (layer & 1) == 0;
    int mt, nt; xcd_tile(id, (layer == 3) ? 16 : 18, 8, (layer == 3) ? 8 : 6, mt, nt);
    TileDesc d; d.A = (const bf16_t*)(pp->ws + (even ? WS_R2 : WS_OH)) + (size_t)mt * 128 * D;
    d.B = (const bf16_t*)(pp->ws + WS_WT + (even ? WT_EV_OUT : WT_OD_OUT)) + (size_t)nt * 128 * D; d.nvalid = 128;
    return d;
  }
  DI void epi_read(int id, unsigned char* lds, float (&c)[64]) const {
    const int t = tid_opaque();
    const float* Cs = (const float*)lds;
#pragma unroll
    for (int it = 0; it < 16; ++it) {
      const int row = (t >> 5) + 8 * it, c4 = t & 31;
      *(f32x4*)(c + it * 4) = *(const f32x4*)(Cs + row * 132 + c4 * 4);
    }
  }
  DI void epi_write(int id, const float (&c)[64]) const {
    const Params& p = *pp;
    int mt, nt; xcd_tile(id, (layer == 3) ? 16 : 18, 8, (layer == 3) ? 8 : 6, mt, nt);
    const int m0 = mt * 128, n0 = nt * 128;
    const float* MOD = (const float*)(p.ws + WS_MOD);
    float* CX = (float*)(p.ws + WS_CX);
    const int t = tid_opaque();
    const bool lat = m0 < NLAT;
    const int r = lat ? (m0 >> 11) : 8;
    const int n = n0 + (t & 31) * 4;
    const float* xin = (lat ? ((layer == 0 ? p.x : p.out) + (size_t)m0 * D) : ((layer == 0 ? p.ctx : CX) + (size_t)(m0 - NLAT) * D)) + n;
    float* xout = (lat ? (p.out + (size_t)m0 * D) : (CX + (size_t)(m0 - NLAT) * D)) + n;
    const f32x4 g = *(const f32x4*)(MOD + (size_t)(layer * 9 + r) * 3072 + 2048 + n);
#pragma unroll
    for (int half = 0; half < 2; ++half) {
      f32x4 xi[8];
#pragma unroll
      for (int q = 0; q < 8; ++q) xi[q] = *(const f32x4*)(xin + (size_t)((t >> 5) + 8 * (half * 8 + q)) * D);
#pragma unroll
      for (int q = 0; q < 8; ++q) {
        const int it = half * 8 + q;
        f32x4 o; o.x = xi[q].x + g.x * c[it * 4]; o.y = xi[q].y + g.y * c[it * 4 + 1]; o.z = xi[q].z + g.z * c[it * 4 + 2]; o.w = xi[q].w + g.w * c[it * 4 + 3];
        st_wt((f32x4*)(xout + (size_t)((t >> 5) + 8 * it) * D), o);
      }
    }
  }
};

struct EvWinOps {
  const Params* pp;
  DI TileDesc tile(int id) const {
    int mt, nt; xcd_tile(id, 18, 25, 6, mt, nt);
    TileDesc d; d.A = (const bf16_t*)(pp->ws + WS_R1) + (size_t)mt * 128 * D; d.B = (const bf16_t*)(pp->ws + WS_WT + WT_EV_IN) + (size_t)nt * 128 * D; d.nvalid = EVEN_IN - nt * 128;
    return d;
  }
  DI void epi(int id, unsigned char* lds) const {
    int mt, nt; xcd_tile(id, 18, 25, 6, mt, nt);
    const int m0 = mt * 128, n0 = nt * 128;
    bf16_t* U1 = (bf16_t*)(pp->ws + WS_R2);
    bf16_t* U2 = (bf16_t*)(pp->ws + WS_U2);
    const int t = tid_opaque();
    const float* Cs = (const float*)lds;
    for (int idx = t; idx < 128 * 16; idx += 256) {
      const int row = idx >> 4, ch = idx & 15, col = n0 + ch * 8;
      if (col < EVEN_IN) {
        float v[8];
        *(f32x4*)v = *(const f32x4*)(Cs + row * 132 + ch * 8);
        *(f32x4*)(v + 4) = *(const f32x4*)(Cs + row * 132 + ch * 8 + 4);
        const int m = m0 + row;
        bf16_t* dst = (col < U1W) ? U1 + (size_t)m * U1W + col : U2 + (size_t)m * U2W + (col - U1W);
        *(u32x4*)dst = pack8(v);
      }
    }
  }
};
DI void phase_ev_win(const Params& p, unsigned char* lds) {
  EvWinOps2 ops; ops.pp = &p;
  gemm_glds2<4>(144 * 25, D, D, ops, lds);
}

struct WoutOps {
  const Params* pp; int layer;
  DI TileDesc tile(int id) const {
    const bool even = (layer & 1) == 0;
    int mt, nt; xcd_tile(id, (layer == 3) ? 16 : 18, 8, (layer == 3) ? 8 : 6, mt, nt);
    TileDesc d; d.A = (const bf16_t*)(pp->ws + (even ? WS_R2 : WS_OH)) + (size_t)mt * 128 * D;
    d.B = (const bf16_t*)(pp->ws + WS_WT + (even ? WT_EV_OUT : WT_OD_OUT)) + (size_t)nt * 128 * D; d.nvalid = 128;
    return d;
  }
  DI void epi(int id, unsigned char* lds) const {
    const Params& p = *pp;
    int mt, nt; xcd_tile(id, (layer == 3) ? 16 : 18, 8, (layer == 3) ? 8 : 6, mt, nt);
    const int m0 = mt * 128, n0 = nt * 128;
    const float* MOD = (const float*)(p.ws + WS_MOD);
    float* CX = (float*)(p.ws + WS_CX);
    const int t = tid_opaque();
    const float* Cs = (const float*)lds;
    const bool lat = m0 < NLAT;
    const int r = lat ? (m0 >> 11) : 8;
    const float* gate = MOD + (size_t)(layer * 9 + r) * 3072 + 2048;
    const float* xin = lat ? ((layer == 0 ? p.x : p.out) + (size_t)m0 * D) : ((layer == 0 ? p.ctx : CX) + (size_t)(m0 - NLAT) * D);
    float* xout = lat ? (p.out + (size_t)m0 * D) : (CX + (size_t)(m0 - NLAT) * D);
    for (int idx = t; idx < 128 * 32; idx += 256) {
      const int row = idx >> 5, c4 = idx & 31, n = n0 + c4 * 4;
      const f32x4 a = *(const f32x4*)(Cs + row * 132 + c4 * 4);
      const f32x4 g = *(const f32x4*)(gate + n);
      const f32x4 xi = *(const f32x4*)(xin + (size_t)row * D + n);
      f32x4 o; o.x = xi.x + g.x * a.x; o.y = xi.y + g.y * a.y; o.z = xi.z + g.z * a.z; o.w = xi.w + g.w * a.w;
      *(f32x4*)(xout + (size_t)row * D + n) = o;
    }
  }
};
DI void phase_wout(const Params& p, int layer, unsigned char* lds) {
  WoutOps2 ops; ops.pp = &p; ops.layer = layer;
  gemm_glds2<4>(((layer == 3) ? 128 : 144) * 8, D, D, ops, lds);
}

DI void ev_q_tile(const Params& p, int j, int mt, int head, unsigned char* lds) {
  const bf16_t* U1 = (const bf16_t*)(p.ws + WS_R2);
  const bf16_t* WT = (const bf16_t*)(p.ws + WS_WT + WT_EV_UQ);
  bf16_t* QA = (bf16_t*)(p.ws + WS_R1 + R1_QA);
  const float* RC = (const float*)(p.ws + WS_ROPEC);
  const float* RS = (const float*)(p.ws + WS_ROPES);
  const int t = tid_opaque(), m0 = mt * 128;
  float* Cs = (float*)lds;
  float* rowstat = (float*)(lds + ROWSTAT_OFF);
  float* rowstat2 = (float*)(lds + ROWSTAT2_OFF);
#pragma unroll 1
  for (int it = 0; it < 4; ++it) {
    const int idx = t + 256 * it, row = idx >> 3, l8 = idx & 7;
    float ss = 0.f;
#pragma unroll
    for (int q = 0; q < 3; ++q) { const f32x4 v = *(const f32x4*)(Cs + row * 100 + l8 * 12 + q * 4); ss += v.x * v.x + v.y * v.y + v.z * v.z + v.w * v.w; }
    ss += __shfl_xor(ss, 1); ss += __shfl_xor(ss, 2); ss += __shfl_xor(ss, 4);
    const float rin = rowstat[row];
    const float rstd2 = rsqrtf(ss * rin * rin * (1.f / 96.f) + EPS);
    if (l8 == 0) rowstat2[row] = rin * rstd2;
  }
  __syncthreads();
  const float* qg = p.ev_q_gain + j * 96;
  int b, pos0; tok_bp(m0, b, pos0);
  const bool lat = m0 < NLAT;
  const float QS = 0.10206207261596575f * LOG2E;
  bf16_t* qdst = QA + ((size_t)(b * 8 + head) * KEYS + pos0) * 96;
  {
    const int ch = t & 7;
    const f32x4 g0 = *(const f32x4*)(qg + ch * 8), g1 = *(const f32x4*)(qg + ch * 8 + 4);
    const float gg[8] = {g0.x, g0.y, g0.z, g0.w, g1.x, g1.y, g1.z, g1.w};
#pragma unroll
    for (int it = 0; it < 4; ++it) {
      const int row = (t >> 3) + 32 * it;
      const float f = rowstat2[row] * QS;
      float v[8];
      *(f32x4*)v = *(const f32x4*)(Cs + row * 100 + ch * 8);
      *(f32x4*)(v + 4) = *(const f32x4*)(Cs + row * 100 + ch * 8 + 4);
#pragma unroll
      for (int e = 0; e < 8; ++e) v[e] *= f * gg[e];
      *(u32x4*)(qdst + (size_t)row * 96 + ch * 8) = pack8(v);
    }
  }
  {
    const int rc = t & 3, ch = 8 + rc, pch = ch ^ 1;
    const f32x4 g0 = *(const f32x4*)(qg + ch * 8), g1 = *(const f32x4*)(qg + ch * 8 + 4);
    const f32x4 h0 = *(const f32x4*)(qg + pch * 8), h1 = *(const f32x4*)(qg + pch * 8 + 4);
    const float gg[8] = {g0.x, g0.y, g0.z, g0.w, g1.x, g1.y, g1.z, g1.w};
    const float pg[8] = {h0.x, h0.y, h0.z, h0.w, h1.x, h1.y, h1.z, h1.w};
    f32x4 cs4[2][2], sn4[2][2];
    if (lat) {
#pragma unroll
      for (int it = 0; it < 2; ++it) {
        const int pos = pos0 + (t >> 2) + 64 * it;
        cs4[it][0] = *(const f32x4*)(RC + pos * 16 + (rc >> 1) * 8); cs4[it][1] = *(const f32x4*)(RC + pos * 16 + (rc >> 1) * 8 + 4);
        sn4[it][0] = *(const f32x4*)(RS + pos * 16 + (rc >> 1) * 8); sn4[it][1] = *(const f32x4*)(RS + pos * 16 + (rc >> 1) * 8 + 4);
      }
    }
#pragma unroll
    for (int it = 0; it < 2; ++it) {
      const int row = (t >> 2) + 64 * it;
      const float f = rowstat2[row];
      float v[8], pv[8];
      *(f32x4*)v = *(const f32x4*)(Cs + row * 100 + ch * 8);
      *(f32x4*)(v + 4) = *(const f32x4*)(Cs + row * 100 + ch * 8 + 4);
      *(f32x4*)pv = *(const f32x4*)(Cs + row * 100 + pch * 8);
      *(f32x4*)(pv + 4) = *(const f32x4*)(Cs + row * 100 + pch * 8 + 4);
#pragma unroll
      for (int e = 0; e < 8; ++e) { v[e] *= f * gg[e]; pv[e] *= f * pg[e]; }
      if (lat) {
        const float cs[8] = {cs4[it][0].x, cs4[it][0].y, cs4[it][0].z, cs4[it][0].w, cs4[it][1].x, cs4[it][1].y, cs4[it][1].z, cs4[it][1].w};
        const float sn[8] = {sn4[it][0].x, sn4[it][0].y, sn4[it][0].z, sn4[it][0].w, sn4[it][1].x, sn4[it][1].y, sn4[it][1].z, sn4[it][1].w};
#pragma unroll
        for (int e = 0; e < 8; ++e) v[e] = ((rc & 1) == 0) ? (v[e] * cs[e] - pv[e] * sn[e]) : (v[e] * cs[e] + pv[e] * sn[e]);
      }
#pragma unroll
      for (int e = 0; e < 8; ++e) v[e] *= QS;
      *(u32x4*)(qdst + (size_t)row * 96 + ch * 8) = pack8(v);
    }
  }
}

DI void ev_kv_tile(const Params& p, int j, int mt, int head, unsigned char* lds) {
  const bf16_t* U1 = (const bf16_t*)(p.ws + WS_R2);
  const bf16_t* WT = (const bf16_t*)(p.ws + WS_WT + WT_EV_UKV);
  bf16_t* KA = (bf16_t*)(p.ws + WS_R1 + R1_KA);
  bf16_t* VAT = (bf16_t*)(p.ws + WS_R1 + R1_VAT);
  const float* RC = (const float*)(p.ws + WS_ROPEC);
  const float* RS = (const float*)(p.ws + WS_ROPES);
  const int t = tid_opaque(), m0 = mt * 128;
  float* Cs = (float*)lds;
  float* rowstat = (float*)(lds + ROWSTAT_OFF);
  float* rowstat2 = (float*)(lds + ROWSTAT2_OFF);
  {
    const int l8 = t & 7;
    u32x2 kr[4];
#pragma unroll
    for (int it = 0; it < 4; ++it) kr[it] = *(const u32x2*)(U1 + (size_t)(m0 + (t >> 3) + 32 * it) * U1W + 1024 + l8 * 4);
#pragma unroll
    for (int it = 0; it < 4; ++it) {
      const int row = (t >> 3) + 32 * it;
      const float rin = rowstat[row];
      float ss = 0.f;
#pragma unroll
      for (int q = 0; q < 2; ++q) { const f32x4 v = *(const f32x4*)(Cs + row * 132 + l8 * 8 + q * 4); ss += v.x * v.x + v.y * v.y + v.z * v.z + v.w * v.w; }
      ss *= rin * rin;
      const float k0 = bflo(kr[it].x), k1 = bfhi(kr[it].x), k2 = bflo(kr[it].y), k3 = bfhi(kr[it].y);
      ss += k0 * k0 + k1 * k1 + k2 * k2 + k3 * k3;
      ss += __shfl_xor(ss, 1); ss += __shfl_xor(ss, 2); ss += __shfl_xor(ss, 4);
      if (l8 == 0) rowstat2[row] = rsqrtf(ss * (1.f / 96.f) + EPS);
    }
  }
  __syncthreads();
  const float* kg = p.ev_k_gain + j * 96;
  int b, pos0; tok_bp(m0, b, pos0);
  const bool lat = m0 < NLAT;
  bf16_t* kdst = KA + ((size_t)(b * 8 + head) * KEYS + pos0) * 96;
  {
    const int ch = t & 7;
    const f32x4 g0 = *(const f32x4*)(kg + ch * 8), g1 = *(const f32x4*)(kg + ch * 8 + 4);
    const float gg[8] = {g0.x, g0.y, g0.z, g0.w, g1.x, g1.y, g1.z, g1.w};
#pragma unroll
    for (int it = 0; it < 4; ++it) {
      const int row = (t >> 3) + 32 * it;
      const float f = rowstat[row] * rowstat2[row];
      float v[8];
      *(f32x4*)v = *(const f32x4*)(Cs + row * 132 + ch * 8);
      *(f32x4*)(v + 4) = *(const f32x4*)(Cs + row * 132 + ch * 8 + 4);
#pragma unroll
      for (int e = 0; e < 8; ++e) v[e] *= f * gg[e];
      *(u32x4*)(kdst + (size_t)row * 96 + ch * 8) = pack8(v);
    }
  }
  {
    const int rc = t & 3, prc = rc ^ 1;
    const f32x4 g0 = *(const f32x4*)(kg + 64 + rc * 8), g1 = *(const f32x4*)(kg + 64 + rc * 8 + 4);
    const f32x4 h0 = *(const f32x4*)(kg + 64 + prc * 8), h1 = *(const f32x4*)(kg + 64 + prc * 8 + 4);
    const float gg[8] = {g0.x, g0.y, g0.z, g0.w, g1.x, g1.y, g1.z, g1.w};
    const float pg[8] = {h0.x, h0.y, h0.z, h0.w, h1.x, h1.y, h1.z, h1.w};
    u32x4 own[2], par[2];
    f32x4 cs4[2][2], sn4[2][2];
#pragma unroll
    for (int it = 0; it < 2; ++it) {
      const int row = (t >> 2) + 64 * it;
      const bf16_t* krp = U1 + (size_t)(m0 + row) * U1W + 1024;
      own[it] = *(const u32x4*)(krp + rc * 8);
      par[it] = *(const u32x4*)(krp + prc * 8);
      if (lat) {
        const int pos = pos0 + row;
        cs4[it][0] = *(const f32x4*)(RC + pos * 16 + (rc >> 1) * 8); cs4[it][1] = *(const f32x4*)(RC + pos * 16 + (rc >> 1) * 8 + 4);
        sn4[it][0] = *(const f32x4*)(RS + pos * 16 + (rc >> 1) * 8); sn4[it][1] = *(const f32x4*)(RS + pos * 16 + (rc >> 1) * 8 + 4);
      }
    }
#pragma unroll
    for (int it = 0; it < 2; ++it) {
      const int row = (t >> 2) + 64 * it;
      const float rk = rowstat2[row];
      float v[8], pv[8];
      unpack8(own[it], v);
      unpack8(par[it], pv);
#pragma unroll
      for (int e = 0; e < 8; ++e) { v[e] *= rk * gg[e]; pv[e] *= rk * pg[e]; }
      if (lat) {
        const float cs[8] = {cs4[it][0].x, cs4[it][0].y, cs4[it][0].z, cs4[it][0].w, cs4[it][1].x, cs4[it][1].y, cs4[it][1].z, cs4[it][1].w};
        const float sn[8] = {sn4[it][0].x, sn4[it][0].y, sn4[it][0].z, sn4[it][0].w, sn4[it][1].x, sn4[it][1].y, sn4[it][1].z, sn4[it][1].w};
#pragma unroll
        for (int e = 0; e < 8; ++e) v[e] = ((rc & 1) == 0) ? (v[e] * cs[e] - pv[e] * sn[e]) : (v[e] * cs[e] + pv[e] * sn[e]);
      }
      *(u32x4*)(kdst + (size_t)row * 96 + 64 + rc * 8) = pack8(v);
    }
  }
#pragma unroll
  for (int it = 0; it < 4; ++it) {
    const int idx = t + 256 * it, rg = idx & 15, e = idx >> 4;
    float v[8];
#pragma unroll
    for (int q = 0; q < 8; ++q) v[q] = Cs[(rg * 8 + q) * 132 + 64 + e] * rowstat[rg * 8 + q];
    *(u32x4*)(VAT + ((size_t)(b * 8 + head) * 64 + e) * KEYS + pos0 + rg * 8) = pack8(v);
  }
}

struct EvQOps {
  const Params* pp; int j;
  DI TileDesc tile(int id) const {
    int mt, head; xcd_tile(id, 18, 8, 6, mt, head);
    TileDesc d; d.A = (const bf16_t*)(pp->ws + WS_R2) + (size_t)mt * 128 * U1W; d.B = (const bf16_t*)(pp->ws + WS_WT + WT_EV_UQ) + (size_t)(head * 96) * 768; d.nvalid = 96;
    return d;
  }
  DI void epi(int id, unsigned char* lds) const { int mt, head; xcd_tile(id, 18, 8, 6, mt, head); ev_q_tile(*pp, j, mt, head, lds); }
  DI void epi_lds(int id, unsigned char* lds) const { epi(id, lds); }
  DI void epi_read(int, unsigned char*, float (&)[64]) const {}
  DI void epi_write(int, const float (&)[64]) const {}
};
struct EvKvOps {
  const Params* pp; int j;
  DI TileDesc tile(int id) const {
    int mt, head; xcd_tile(id, 18, 8, 6, mt, head);
    TileDesc d; d.A = (const bf16_t*)(pp->ws + WS_R2) + (size_t)mt * 128 * U1W + 768; d.B = (const bf16_t*)(pp->ws + WS_WT + WT_EV_UKV) + (size_t)(head * 128) * 256; d.nvalid = 128;
    return d;
  }
  DI void epi(int id, unsigned char* lds) const { int mt, head; xcd_tile(id, 18, 8, 6, mt, head); ev_kv_tile(*pp, j, mt, head, lds); }
  DI void epi_lds(int id, unsigned char* lds) const { epi(id, lds); }
  DI void epi_read(int, unsigned char*, float (&)[64]) const {}
  DI void epi_write(int, const float (&)[64]) const {}
};

constexpr int GL_QT = 0, GL_KT = 9216, GL_ATT = 18432, GL_VT = 27648, GL_ST = 46080, GL_RS = 64512, GL_SEG = 72704;

DI float log_sigmoid_f(float x) { return fminf(x, 0.f) - __logf(1.f + __expf(-fabsf(x))); }

template <int DIR>
DI float gla_decay(const float (&gw)[16], float gb, unsigned char* lds, float (&bb)[16]) {
  const int t = tid_opaque(), d = t & 63, qd = t >> 6;
  const float* rs = (const float*)(lds + GL_RS);
  float* seg = (float*)(lds + GL_SEG);
  float ssum = 0.f;
#pragma unroll
  for (int i = 0; i < 16; ++i) {
    const int l = qd * 16 + i;
    float lg = gb;
#pragma unroll
    for (int q = 0; q < 4; ++q) {
      const f32x4 rv = *(const f32x4*)(rs + l * 32 + DIR * 16 + q * 4);
      lg += rv.x * gw[q * 4] + rv.y * gw[q * 4 + 1] + rv.z * gw[q * 4 + 2] + rv.w * gw[q * 4 + 3];
    }
    bb[i] = log_sigmoid_f(lg) * (1.f / 16.f);
    ssum += bb[i];
  }
  __syncthreads();
  seg[qd * 64 + d] = ssum;
  __syncthreads();
  const float s0 = seg[d], s1 = seg[64 + d], s2 = seg[128 + d], s3 = seg[192 + d];
  const float tot = s0 + s1 + s2 + s3;
  if (DIR == 0) {
    float off = (qd > 0 ? s0 : 0.f) + (qd > 1 ? s1 : 0.f) + (qd > 2 ? s2 : 0.f);
#pragma unroll
    for (int i = 0; i < 16; ++i) { off += bb[i]; bb[i] = off; }
  } else {
    float off = (qd < 3 ? s3 : 0.f) + (qd < 2 ? s2 : 0.f) + (qd < 1 ? s1 : 0.f);
#pragma unroll
    for (int i = 15; i >= 0; --i) { off += bb[i]; bb[i] = off; }
  }
  return tot;
}

DI int gla_base_row(int b, int c) { return (c < 32) ? b * SEQ + c * 64 : NLAT + b * CTXL + (c - 32) * 64; }
DI int gla_scan_pos(int c, int dir) { return dir == 0 ? ((c >= 32) ? c - 32 : 4 + c) : ((c >= 32) ? 3 - (c - 32) : 4 + (31 - c)); }

struct GlaRaw { u32x4 v[4]; u32x4 r; };
DI void gla_load_raw(GlaRaw& g, const bf16_t* U2, int base_m, int h) {
  const int t = tid_opaque();
  const bf16_t* vrow = U2 + (size_t)(base_m + (t & 63)) * U2W + U2_VB + h * 128 + (t >> 6) * 32;
#pragma unroll
  for (int i = 0; i < 4; ++i) g.v[i] = *(const u32x4*)(vrow + 8 * i);
  g.r = *(const u32x4*)(U2 + (size_t)(base_m + (t >> 2)) * U2W + U2_GLR + (t & 3) * 8);
}
DI void gla_stage_raw(const GlaRaw& g, unsigned char* lds) {
  const int t = tid_opaque();
  float* rs = (float*)(lds + GL_RS);
  bf16_t* vT = (bf16_t*)(lds + GL_VT);
  {
    const int l = t >> 2, q = t & 3;
    float v[8];
    unpack8(g.r, v);
    *(f32x4*)(rs + l * 32 + q * 8) = (f32x4){v[0], v[1], v[2], v[3]};
    *(f32x4*)(rs + l * 32 + q * 8 + 4) = (f32x4){v[4], v[5], v[6], v[7]};
  }
  {
    const int l = t & 63, e0 = (t >> 6) * 32;
#pragma unroll
    for (int i = 0; i < 4; ++i) {
      const unsigned w4[4] = {g.v[i].x, g.v[i].y, g.v[i].z, g.v[i].w};
#pragma unroll
      for (int q = 0; q < 4; ++q) {
        vT[(e0 + 8 * i + 2 * q) * 72 + l] = (bf16_t)(w4[q] & 0xffffu);
        vT[(e0 + 8 * i + 2 * q + 1) * 72 + l] = (bf16_t)(w4[q] >> 16);
      }
    }
  }
}
DI void gla_load_gate(const Params& p, int j, int h, int dir, int d, float (&gw)[16], float& gb) {
  const float* GW = p.ev_gate_w + ((size_t)(j * 2 + dir) * 16) * 256 + h * 64 + d;
#pragma unroll
  for (int r = 0; r < 16; ++r) gw[r] = GW[r * 256];
  gb = p.ev_gate_b[(j * 2 + dir) * 256 + h * 64 + d];
}

DI void gla_g1_item(const Params& p, int j, int item, unsigned char* lds) {
  const int b = item / (4 * NCHUNK), h = (item / NCHUNK) & 3, c = item % NCHUNK;
  const bf16_t* U2 = (const bf16_t*)(p.ws + WS_U2);
  bf16_t* KVST = (bf16_t*)(p.ws + WS_KVST);
  float* DEC = (float*)(p.ws + WS_DEC);
  const int t = tid_opaque(), d = t & 63, qd = t >> 6, lane = t & 63, w = t >> 6, r = lane & 31, hh = lane >> 5;
  const int base_m = gla_base_row(b, c);
  GlaRaw raw; gla_load_raw(raw, U2, base_m, h);
  bf16_t k16[16];
#pragma unroll
  for (int i = 0; i < 16; ++i) k16[i] = U2[(size_t)(base_m + qd * 16 + i) * U2W + U2_KB + h * 64 + d];
  float gw0[16], gw1[16], gb0, gb1;
  gla_load_gate(p, j, h, 0, d, gw0, gb0);
  gla_load_gate(p, j, h, 1, d, gw1, gb1);
  __syncthreads();
  gla_stage_raw(raw, lds);
  __syncthreads();
  const float* rs = (const float*)(lds + GL_RS);
  float* seg0 = (float*)(lds + GL_SEG);
  float* seg1 = (float*)(lds + GL_ATT);
  float b0[16], b1[16];
  float sum0 = 0.f, sum1 = 0.f;
#pragma unroll
  for (int i = 0; i < 16; ++i) {
    const int l = qd * 16 + i;
    float l0 = gb0, l1 = gb1;
#pragma unroll
    for (int q = 0; q < 4; ++q) {
      const f32x4 r0 = *(const f32x4*)(rs + l * 32 + q * 4), r1 = *(const f32x4*)(rs + l * 32 + 16 + q * 4);
      l0 += r0.x * gw0[q * 4] + r0.y * gw0[q * 4 + 1] + r0.z * gw0[q * 4 + 2] + r0.w * gw0[q * 4 + 3];
      l1 += r1.x * gw1[q * 4] + r1.y * gw1[q * 4 + 1] + r1.z * gw1[q * 4 + 2] + r1.w * gw1[q * 4 + 3];
    }
    b0[i] = log_sigmoid_f(l0) * (1.f / 16.f); sum0 += b0[i];
    b1[i] = log_sigmoid_f(l1) * (1.f / 16.f); sum1 += b1[i];
  }
  seg0[qd * 64 + d] = sum0;
  seg1[qd * 64 + d] = sum1;
  __syncthreads();
  float tot0, tot1;
  {
    const float s0 = seg0[d], s1 = seg0[64 + d], s2 = seg0[128 + d], s3 = seg0[192 + d];
    tot0 = s0 + s1 + s2 + s3;
    float off = (qd > 0 ? s0 : 0.f) + (qd > 1 ? s1 : 0.f) + (qd > 2 ? s2 : 0.f);
#pragma unroll
    for (int i = 0; i < 16; ++i) { off += b0[i]; b0[i] = off; }
  }
  {
    const float s0 = seg1[d], s1 = seg1[64 + d], s2 = seg1[128 + d], s3 = seg1[192 + d];
    tot1 = s0 + s1 + s2 + s3;
    float off = (qd < 3 ? s3 : 0.f) + (qd < 2 ? s2 : 0.f) + (qd < 1 ? s1 : 0.f);
#pragma unroll
    for (int i = 15; i >= 0; --i) { off += b1[i]; b1[i] = off; }
  }
  bf16_t* kdT0 = (bf16_t*)(lds + GL_QT);
  bf16_t* kdT1 = (bf16_t*)(lds + GL_KT);
  const bf16_t* vT = (const bf16_t*)(lds + GL_VT);
#pragma unroll
  for (int i = 0; i < 16; ++i) {
    const float kv = bf2f(k16[i]);
    kdT0[d * 72 + qd * 16 + i] = f2bf(kv * __expf(tot0 - b0[i]));
    kdT1[d * 72 + qd * 16 + i] = f2bf(kv * __expf(tot1 - b1[i]));
  }
  const int chain0 = (b * 4 + h) * 2, sp0 = gla_scan_pos(c, 0), sp1 = gla_scan_pos(c, 1);
  if (qd == 0) DEC[(size_t)(chain0 * NCHUNK + sp0) * 64 + d] = __expf(tot0);
  if (qd == 1) DEC[(size_t)((chain0 + 1) * NCHUNK + sp1) * 64 + d] = __expf(tot1);
  __syncthreads();
  f32x16 acc[2][2];
#pragma unroll
  for (int dir = 0; dir < 2; ++dir)
#pragma unroll
    for (int x = 0; x < 2; ++x)
#pragma unroll
      for (int i = 0; i < 16; ++i) acc[dir][x][i] = 0.f;
#pragma unroll
  for (int s4 = 0; s4 < 4; ++s4) {
    const bf16x8 bq = *(const bf16x8*)(vT + (32 * w + r) * 72 + 16 * s4 + 8 * hh);
#pragma unroll
    for (int x = 0; x < 2; ++x) {
      const bf16x8 a0 = *(const bf16x8*)(kdT0 + (32 * x + r) * 72 + 16 * s4 + 8 * hh);
      const bf16x8 a1 = *(const bf16x8*)(kdT1 + (32 * x + r) * 72 + 16 * s4 + 8 * hh);
      acc[0][x] = MFMA32(a0, bq, acc[0][x]);
      acc[1][x] = MFMA32(a1, bq, acc[1][x]);
    }
  }
#pragma unroll
  for (int dir = 0; dir < 2; ++dir) {
    bf16_t* dst = KVST + (size_t)((chain0 + dir) * NCHUNK + (dir == 0 ? sp0 : sp1)) * 8192 + (32 * w + r) * 64;
#pragma unroll
    for (int x = 0; x < 2; ++x)
#pragma unroll
      for (int g = 0; g < 4; ++g) {
        u32x2 o; o.x = pk2(acc[dir][x][4 * g], acc[dir][x][4 * g + 1]); o.y = pk2(acc[dir][x][4 * g + 2], acc[dir][x][4 * g + 3]);
        *(u32x2*)(dst + 32 * x + 8 * g + 4 * hh) = o;
      }
  }
}

DI void gla_scan_item(const Params& p, int item) {
  bf16_t* KVST = (bf16_t*)(p.ws + WS_KVST);
  const float* DEC = (const float*)(p.ws + WS_DEC);
  const int idx = item * 256 + tid_opaque();
  const int chain = idx >> 11, off = (idx & 2047) * 4, d = off & 63;
  float S[4] = {0.f, 0.f, 0.f, 0.f};
#pragma unroll 1
  for (int sp0 = 0; sp0 < NCHUNK; sp0 += 6) {
    u32x2 kv[6]; f32x4 dc[6];
#pragma unroll
    for (int q = 0; q < 6; ++q) {
      kv[q] = *(const u32x2*)(KVST + (size_t)(chain * NCHUNK + sp0 + q) * 8192 + off);
      dc[q] = *(const f32x4*)(DEC + (size_t)(chain * NCHUNK + sp0 + q) * 64 + d);
    }
#pragma unroll
    for (int q = 0; q < 6; ++q) {
      u32x2 o; o.x = pk2(S[0], S[1]); o.y = pk2(S[2], S[3]);
      *(u32x2*)(KVST + (size_t)(chain * NCHUNK + sp0 + q) * 8192 + off) = o;
      S[0] = S[0] * dc[q].x + bflo(kv[q].x); S[1] = S[1] * dc[q].y + bfhi(kv[q].x); S[2] = S[2] * dc[q].z + bflo(kv[q].y); S[3] = S[3] * dc[q].w + bfhi(kv[q].y);
    }
  }
}

template <int DIR>
DI void gla_g3_dir(const float (&gw)[16], float gb, const float (&qreg)[16], const float (&kreg)[16], f32x16 (&o)[2], unsigned char* lds) {
  const int t = tid_opaque(), d = t & 63, qd = t >> 6, lane = t & 63, w = t >> 6, r = lane & 31, hh = lane >> 5;
  bf16_t* qt = (bf16_t*)(lds + GL_QT);
  bf16_t* kt = (bf16_t*)(lds + GL_KT);
  bf16_t* att = (bf16_t*)(lds + GL_ATT);
  const bf16_t* vT = (const bf16_t*)(lds + GL_VT);
  const bf16_t* ST = (const bf16_t*)(lds + GL_ST);
  const int lb = w >> 1, eb0 = 2 * (w & 1);
  float bb[16];
  (void)gla_decay<DIR>(gw, gb, lds, bb);
#pragma unroll
  for (int i = 0; i < 16; ++i) {
    const int l = qd * 16 + i;
    qt[l * 72 + d] = f2bf(qreg[i] * __expf(bb[i]));
    kt[l * 72 + d] = f2bf(kreg[i] * __expf(-bb[i]));
  }
  __syncthreads();
  {
    const int mb = w & 1;
    f32x16 a;
#pragma unroll
    for (int i = 0; i < 16; ++i) a[i] = 0.f;
#pragma unroll
    for (int s = 0; s < 4; ++s) {
      const bf16x8 fa = *(const bf16x8*)(qt + (32 * lb + r) * 72 + 16 * s + 8 * hh);
      const bf16x8 fb = *(const bf16x8*)(kt + (32 * mb + r) * 72 + 16 * s + 8 * hh);
      a = MFMA32(fa, fb, a);
    }
    const int mcol = 32 * mb + r;
#pragma unroll
    for (int i = 0; i < 16; ++i) {
      const int l = 32 * lb + crow(i, hh);
      const bool keep = (DIR == 0) ? (mcol <= l) : (mcol >= l);
      att[l * 72 + mcol] = f2bf(keep ? a[i] : 0.f);
    }
  }
  __syncthreads();
#pragma unroll
  for (int s = 0; s < 4; ++s) {
    const bf16x8 a1 = *(const bf16x8*)(att + (32 * lb + r) * 72 + 16 * s + 8 * hh);
    const bf16x8 a2 = *(const bf16x8*)(qt + (32 * lb + r) * 72 + 16 * s + 8 * hh);
#pragma unroll
    for (int x = 0; x < 2; ++x) {
      const bf16x8 b1 = *(const bf16x8*)(vT + (32 * (eb0 + x) + r) * 72 + 16 * s + 8 * hh);
      const bf16x8 b2 = *(const bf16x8*)(ST + (32 * (eb0 + x) + r) * 72 + 16 * s + 8 * hh);
      o[x] = MFMA32(a1, b1, o[x]);
      o[x] = MFMA32(a2, b2, o[x]);
    }
  }
  __syncthreads();
}

DI void gla_g3_item(const Params& p, int j, int item, unsigned char* lds) {
  const int b = item / (4 * NCHUNK), h = (item / NCHUNK) & 3, c = item % NCHUNK;
  const bf16_t* U2 = (const bf16_t*)(p.ws + WS_U2);
  const bf16_t* KVST = (const bf16_t*)(p.ws + WS_KVST);
  bf16_t* MIX = (bf16_t*)(p.ws + WS_R2);
  const int t = tid_opaque(), d = t & 63, qd = t >> 6, lane = t & 63, w = t >> 6, r = lane & 31, hh = lane >> 5;
  const int base_m = gla_base_row(b, c);
  const int chain0 = (b * 4 + h) * 2;
  GlaRaw raw; gla_load_raw(raw, U2, base_m, h);
  bf16_t k16[16], q16[16];
#pragma unroll
  for (int i = 0; i < 16; ++i) {
    const bf16_t* row = U2 + (size_t)(base_m + qd * 16 + i) * U2W + h * 64 + d;
    k16[i] = row[U2_KB]; q16[i] = row[U2_QB];
  }
  float gw0[16], gw1[16], gb0, gb1;
  gla_load_gate(p, j, h, 0, d, gw0, gb0);
  gla_load_gate(p, j, h, 1, d, gw1, gb1);
  u32x4 st[4];
  {
    const bf16_t* src = KVST + (size_t)(chain0 * NCHUNK + gla_scan_pos(c, 0)) * 8192;
#pragma unroll
    for (int q = 0; q < 4; ++q) st[q] = *(const u32x4*)(src + (size_t)(t + 256 * q) * 8);
  }
  __syncthreads();
  gla_stage_raw(raw, lds);
  bf16_t* STl = (bf16_t*)(lds + GL_ST);
#pragma unroll
  for (int q = 0; q < 4; ++q) { const int ci = t + 256 * q; *(u32x4*)(STl + (ci >> 3) * 72 + (ci & 7) * 8) = st[q]; }
  {
    const bf16_t* src = KVST + (size_t)((chain0 + 1) * NCHUNK + gla_scan_pos(c, 1)) * 8192;
#pragma unroll
    for (int q = 0; q < 4; ++q) st[q] = *(const u32x4*)(src + (size_t)(t + 256 * q) * 8);
  }
  float kreg[16], qreg[16];
#pragma unroll
  for (int i = 0; i < 16; ++i) { kreg[i] = bf2f(k16[i]); qreg[i] = bf2f(q16[i]) * 0.125f; }
  __syncthreads();
  const int lb = w >> 1, eb0 = 2 * (w & 1);
  f32x16 o[2];
#pragma unroll
  for (int x = 0; x < 2; ++x)
#pragma unroll
    for (int i = 0; i < 16; ++i) o[x][i] = 0.f;
  gla_g3_dir<0>(gw0, gb0, qreg, kreg, o, lds);
#pragma unroll
  for (int q = 0; q < 4; ++q) { const int ci = t + 256 * q; *(u32x4*)(STl + (ci >> 3) * 72 + (ci & 7) * 8) = st[q]; }
  const int erow = t >> 2, epart = t & 3;
  const int em = base_m + erow;
  u32x4 zb[4];
  {
    const bf16_t* zp = U2 + (size_t)em * U2W + U2_ZB + h * 128 + epart * 32;
#pragma unroll
    for (int q = 0; q < 4; ++q) zb[q] = *(const u32x4*)(zp + q * 8);
  }
  gla_g3_dir<1>(gw1, gb1, qreg, kreg, o, lds);
  float* ob = (float*)lds;
#pragma unroll
  for (int x = 0; x < 2; ++x)
#pragma unroll
    for (int i = 0; i < 16; ++i) ob[(32 * lb + crow(i, hh)) * 132 + 32 * (eb0 + x) + r] = o[x][i];
  __syncthreads();
  {
    float v[32];
    float ss = 0.f;
#pragma unroll
    for (int q = 0; q < 8; ++q) { *(f32x4*)(v + 4 * q) = *(const f32x4*)(ob + erow * 132 + epart * 32 + q * 4); }
#pragma unroll
    for (int e = 0; e < 32; ++e) ss += v[e] * v[e];
    ss += __shfl_xor(ss, 1); ss += __shfl_xor(ss, 2);
    const float rstd = rsqrtf(ss * (1.f / 128.f) + EPS);
    const float* gn = p.ev_gla_norm + j * 512 + h * 128 + epart * 32;
    bf16_t* dst = MIX + (size_t)em * D + 512 + h * 128 + epart * 32;
#pragma unroll
    for (int q = 0; q < 4; ++q) {
      float z[8], ov[8];
      unpack8(zb[q], z);
#pragma unroll
      for (int e = 0; e < 8; ++e) ov[e] = v[q * 8 + e] * rstd * gn[q * 8 + e] * silu_f(z[e]);
      *(u32x4*)(dst + q * 8) = pack8(ov);
    }
  }
}

template <int DQK, int MODE>
DI void attn_tile(const bf16_t* Ks, const bf16_t* Vs, const bf16x8 (&qf)[DQK / 16], f32x16 (&o)[2], float& mx, float& lsum,
                  int r, int hh, const float* rpbs, int ridx, int qc) {
  constexpr int KP = DQK + 8, VP = 72;
  f32x16 s[2];
#pragma unroll
  for (int kb = 0; kb < 2; ++kb) {
#pragma unroll
    for (int i = 0; i < 16; ++i) s[kb][i] = 0.f;
#pragma unroll
    for (int jj = 0; jj < DQK / 16; ++jj) {
      const bf16x8 a = *(const bf16x8*)(Ks + (32 * kb + r) * KP + 16 * jj + 8 * hh);
      s[kb] = MFMA32(a, qf[jj], s[kb]);
    }
  }
  if (MODE == 1) {
    const int cs = min(max(qc - 8, 0), 48);
    const int u = 4 * hh - cs;
    const float* bp = rpbs + (ridx * 31 + 4 * hh - qc + 15);
#pragma unroll
    for (int kb = 0; kb < 2; ++kb)
#pragma unroll
      for (int i = 0; i < 16; ++i) {
        const int c = 32 * kb + (i & 3) + 8 * (i >> 2);
        const bool valid = (unsigned)(u + c) < 16u;
        s[kb][i] = valid ? (s[kb][i] + bp[c]) : -INFINITY;
      }
  }
  float tmax = s[0][0];
#pragma unroll
  for (int kb = 0; kb < 2; ++kb)
#pragma unroll
    for (int i = 0; i < 16; ++i) tmax = fmaxf(tmax, s[kb][i]);
  tmax = fmaxf(tmax, __shfl_xor(tmax, 32));
  if (__builtin_amdgcn_ballot_w64(tmax > mx) != 0ull) {
    const float mnew = fmaxf(mx, tmax);
    const float alpha = exp2_fast(mx - mnew);
    mx = mnew;
    lsum *= alpha;
#pragma unroll
    for (int x = 0; x < 2; ++x)
#pragma unroll
      for (int i = 0; i < 16; ++i) o[x][i] *= alpha;
  }
  float psum = 0.f;
#pragma unroll
  for (int kb = 0; kb < 2; ++kb)
#pragma unroll
    for (int i = 0; i < 16; ++i) { s[kb][i] = exp2_fast(s[kb][i] - mx); psum += s[kb][i]; }
  lsum += psum;
#pragma unroll
  for (int kb = 0; kb < 2; ++kb)
#pragma unroll
    for (int sx = 0; sx < 2; ++sx) {
      u32x4 pk;
      pk.x = pk2(s[kb][8 * sx + 0], s[kb][8 * sx + 1]); pk.y = pk2(s[kb][8 * sx + 2], s[kb][8 * sx + 3]);
      pk.z = pk2(s[kb][8 * sx + 4], s[kb][8 * sx + 5]); pk.w = pk2(s[kb][8 * sx + 6], s[kb][8 * sx + 7]);
      const bf16x8 pf = __builtin_bit_cast(bf16x8, pk);
#pragma unroll
      for (int eb = 0; eb < 2; ++eb) {
        const bf16_t* vp = Vs + (32 * eb + r) * VP + 32 * kb + 16 * sx + 4 * hh;
        const s16x4 lo = *(const s16x4*)vp, hi = *(const s16x4*)(vp + 8);
        const bf16x8 vf = __builtin_shufflevector(lo, hi, 0, 1, 2, 3, 4, 5, 6, 7);
        o[eb] = MFMA32(vf, pf, o[eb]);
      }
    }
}

template <int DQK>
DI void attn_load_tile(const bf16_t* kg, const bf16_t* vg, u32x4 (&rk)[DQK / 32], u32x4 (&rv)[2]) {
  const int t = tid_opaque();
#pragma unroll
  for (int i = 0; i < DQK / 32; ++i) rk[i] = *(const u32x4*)(kg + (size_t)(t + 256 * i) * 8);
#pragma unroll
  for (int i = 0; i < 2; ++i) { const int ci = t + 256 * i, e = ci >> 3, cc = ci & 7; rv[i] = *(const u32x4*)(vg + (size_t)e * KEYS + cc * 8); }
}
template <int DQK>
DI void attn_store_tile(bf16_t* Ks, bf16_t* Vs, const u32x4 (&rk)[DQK / 32], const u32x4 (&rv)[2]) {
  constexpr int KP = DQK + 8, CPR = DQK / 8;
  const int t = tid_opaque();
#pragma unroll
  for (int i = 0; i < DQK / 32; ++i) { const int ci = t + 256 * i, row = ci / CPR, cc = ci % CPR; *(u32x4*)(Ks + row * KP + cc * 8) = rk[i]; }
#pragma unroll
  for (int i = 0; i < 2; ++i) { const int ci = t + 256 * i, e = ci >> 3, cc = ci & 7; *(u32x4*)(Vs + e * 72 + cc * 8) = rv[i]; }
}

constexpr int AT_KS = 0, AT_VS = 13312, AT_BUF = 22528  , AT_RPB = 45056, AT_QS = 47104;

DI void attn_write_out(const f32x16 (&o)[2], float lsum, const bf16_t* zrow, bf16_t* orow, int hh) {
  const float ltot = lsum + __shfl_xor(lsum, 32);
  const float inv = 1.f / ltot;
#pragma unroll
  for (int eb = 0; eb < 2; ++eb)
#pragma unroll
    for (int g = 0; g < 4; ++g) {
      const int e = 32 * eb + 8 * g + 4 * hh;
      const u32x2 zz = *(const u32x2*)(zrow + e);
      const float v0 = o[eb][4 * g + 0] * inv * silu_f(bflo(zz.x)), v1 = o[eb][4 * g + 1] * inv * silu_f(bfhi(zz.x));
      const float v2 = o[eb][4 * g + 2] * inv * silu_f(bflo(zz.y)), v3 = o[eb][4 * g + 3] * inv * silu_f(bfhi(zz.y));
      u32x2 ov; ov.x = pk2(v0, v1); ov.y = pk2(v2, v3);
      *(u32x2*)(orow + e) = ov;
    }
}

template <int DQK, int NH>
DI void attn_dense_item(const bf16_t* Q, const bf16_t* K, const bf16_t* VT, const bf16_t* Z, int zstride, bf16_t* MIX,
                        int b, int head, int qp0, int k_lo, int ntiles, unsigned char* lds) {
  const int t = tid_opaque(), lane = t & 63, w = t >> 6, r = lane & 31, hh = lane >> 5;
  bf16_t* Ks = (bf16_t*)(lds + AT_KS);
  bf16_t* Vs = (bf16_t*)(lds + AT_VS);
  const size_t bh = (size_t)(b * NH + head);
  const int qpos = qp0 + 32 * w + r;
  bf16x8 qf[DQK / 16];
#pragma unroll
  for (int jj = 0; jj < DQK / 16; ++jj) qf[jj] = *(const bf16x8*)(Q + (bh * KEYS + qpos) * DQK + 16 * jj + 8 * hh);
  f32x16 o[2];
#pragma unroll
  for (int x = 0; x < 2; ++x)
#pragma unroll
    for (int i = 0; i < 16; ++i) o[x][i] = 0.f;
  float mx = -1e30f, lsum = 0.f;
  const bf16_t* kbase = K + (bh * KEYS + k_lo) * DQK;
  const bf16_t* vbase = VT + bh * 64 * KEYS + k_lo;
  u32x4 rk[DQK / 32], rv[2];
  attn_load_tile<DQK>(kbase, vbase, rk, rv);
  for (int tt = 0; tt < ntiles; ++tt) {
    __syncthreads();
    attn_store_tile<DQK>(Ks, Vs, rk, rv);
    __syncthreads();
    if (tt + 1 < ntiles) attn_load_tile<DQK>(kbase + (size_t)(tt + 1) * 64 * DQK, vbase + (tt + 1) * 64, rk, rv);
    attn_tile<DQK, 0>(Ks, Vs, qf, o, mx, lsum, r, hh, nullptr, 0, 0);
  }
  const int m = (qpos < SEQ) ? b * SEQ + qpos : NLAT + b * CTXL + (qpos - SEQ);
  attn_write_out(o, lsum, Z + (size_t)m * zstride + head * 64, MIX + (size_t)m * D + head * 64, hh);
}


template <int DQK, int MODE, bool PARK>
DI void attn_tile2(const bf16_t* Ks, const bf16_t* Vs, const bf16x8 (&qfA)[DQK / 16], const bf16x8 (&qfB)[DQK / 16], const bf16_t* QsB, f32x16 (&o)[2][2], float (&mx)[2], float (&lsum)[2], int r, int hh,
                const float* rpbs, int ridx, int qcA) {
  constexpr int KP = DQK + 8, VP = 72;
  f32x16 s[2][2];
#pragma unroll
  for (int kb = 0; kb < 2; ++kb) {
#pragma unroll
    for (int g = 0; g < 2; ++g)
#pragma unroll
      for (int i = 0; i < 16; ++i) s[g][kb][i] = 0.f;
#pragma unroll
    for (int jj = 0; jj < DQK / 16; ++jj) {
      const bf16x8 a = *(const bf16x8*)(Ks + (32 * kb + r) * KP + 16 * jj + 8 * hh);
      const bf16x8 qb = PARK ? *(const bf16x8*)(QsB + 16 * jj) : qfB[jj];
      s[0][kb] = MFMA32(a, qfA[jj], s[0][kb]);
      s[1][kb] = MFMA32(a, qb, s[1][kb]);
    }
  }
#pragma unroll
  for (int g = 0; g < 2; ++g) {
    if (MODE == 1) {
      const int qc = qcA + 32 * g;
      const int cs = min(max(qc - 8, 0), 48);
      const int u = 4 * hh - cs;
      const float* bp = rpbs + (ridx * 31 + 4 * hh - qc + 15);
#pragma unroll
      for (int kb = 0; kb < 2; ++kb)
#pragma unroll
        for (int i = 0; i < 16; ++i) {
          const int c = 32 * kb + (i & 3) + 8 * (i >> 2);
          const bool valid = (unsigned)(u + c) < 16u;
          s[g][kb][i] = valid ? (s[g][kb][i] + bp[c]) : -INFINITY;
          if ((i & 3) == 3) __builtin_amdgcn_sched_barrier(0);
        }
    }
    float tmax = s[g][0][0];
#pragma unroll
    for (int kb = 0; kb < 2; ++kb)
#pragma unroll
      for (int i = 0; i < 16; ++i) tmax = fmaxf(tmax, s[g][kb][i]);
    tmax = fmaxf(tmax, __shfl_xor(tmax, 32));
    if (__builtin_amdgcn_ballot_w64(tmax > mx[g]) != 0ull) {
      const float mnew = fmaxf(mx[g], tmax);
      const float alpha = exp2_fast(mx[g] - mnew);
      mx[g] = mnew;
      lsum[g] *= alpha;
#pragma unroll
      for (int x = 0; x < 2; ++x)
#pragma unroll
        for (int i = 0; i < 16; ++i) o[g][x][i] *= alpha;
    }
    float psum = 0.f;
#pragma unroll
    for (int kb = 0; kb < 2; ++kb)
#pragma unroll
      for (int i = 0; i < 16; ++i) { s[g][kb][i] = exp2_fast(s[g][kb][i] - mx[g]); psum += s[g][kb][i]; }
    lsum[g] += psum;
#pragma unroll
    for (int kb = 0; kb < 2; ++kb)
#pragma unroll
      for (int sx = 0; sx < 2; ++sx) {
        u32x4 pk;
        pk.x = pk2(s[g][kb][8 * sx + 0], s[g][kb][8 * sx + 1]); pk.y = pk2(s[g][kb][8 * sx + 2], s[g][kb][8 * sx + 3]);
        pk.z = pk2(s[g][kb][8 * sx + 4], s[g][kb][8 * sx + 5]); pk.w = pk2(s[g][kb][8 * sx + 6], s[g][kb][8 * sx + 7]);
        const bf16x8 pf = __builtin_bit_cast(bf16x8, pk);
#pragma unroll
        for (int eb = 0; eb < 2; ++eb) {
          const bf16_t* vp = Vs + (32 * eb + r) * VP + 32 * kb + 16 * sx + 4 * hh;
          const s16x4 lo = *(const s16x4*)vp, hi = *(const s16x4*)(vp + 8);
          const bf16x8 vf = __builtin_shufflevector(lo, hi, 0, 1, 2, 3, 4, 5, 6, 7);
          o[g][eb] = MFMA32(vf, pf, o[g][eb]);
        }
      }
  }
}

template <int DQK, int NH>
DI void attn_dense_item2(const bf16_t* Q, const bf16_t* K, const bf16_t* VT, const bf16_t* Z, int zstride, bf16_t* MIX,
                         int b, int head, int qp0, int k_lo, int ntiles, unsigned char* lds) {
  const int t = tid_opaque(), lane = t & 63, w = t >> 6, r = lane & 31, hh = lane >> 5;
  bf16_t* Ks = (bf16_t*)(lds + AT_KS);
  bf16_t* Vs = (bf16_t*)(lds + AT_VS);
  const size_t bh = (size_t)(b * NH + head);
  const int qpos0 = qp0 + 64 * w + r;
  bf16x8 qfA[DQK / 16];
  bf16_t* QsB = (bf16_t*)(lds + AT_QS) + (32 * w + r) * (DQK + 8) + 8 * hh;
  __syncthreads();
#pragma unroll
  for (int jj = 0; jj < DQK / 16; ++jj) {
    qfA[jj] = *(const bf16x8*)(Q + (bh * KEYS + qpos0) * DQK + 16 * jj + 8 * hh);
    *(bf16x8*)(QsB + 16 * jj) = *(const bf16x8*)(Q + (bh * KEYS + qpos0 + 32) * DQK + 16 * jj + 8 * hh);
  }
  f32x16 o[2][2];
#pragma unroll
  for (int g = 0; g < 2; ++g)
#pragma unroll
    for (int x = 0; x < 2; ++x)
#pragma unroll
      for (int i = 0; i < 16; ++i) o[g][x][i] = 0.f;
  float mx[2] = {-1e30f, -1e30f}, lsum[2] = {0.f, 0.f};
  const bf16_t* kbase = K + (bh * KEYS + k_lo) * DQK;
  const bf16_t* vbase = VT + bh * 64 * KEYS + k_lo;
  u32x4 rk[DQK / 32], rv[2];
  attn_load_tile<DQK>(kbase, vbase, rk, rv);
  attn_store_tile<DQK>(Ks, Vs, rk, rv);
  if (ntiles > 1) attn_load_tile<DQK>(kbase + (size_t)64 * DQK, vbase + 64, rk, rv);
  __syncthreads();
#pragma unroll 1
  for (int tt = 0; tt < ntiles; ++tt) {
    const int bo = (tt & 1) * (AT_BUF / 2);
    attn_tile2<DQK, 0, true>(Ks + bo, Vs + bo, qfA, qfA, QsB, o, mx, lsum, r, hh, nullptr, 0, 0);
    if (tt + 1 < ntiles) {
      const int bn = ((tt + 1) & 1) * (AT_BUF / 2);
      attn_store_tile<DQK>(Ks + bn, Vs + bn, rk, rv);
      if (tt + 2 < ntiles) attn_load_tile<DQK>(kbase + (size_t)(tt + 2) * 64 * DQK, vbase + (tt + 2) * 64, rk, rv);
    }
    __syncthreads();
  }
#pragma unroll
  for (int g = 0; g < 2; ++g) {
    const int qpos = qpos0 + 32 * g;
    const int m = (qpos < SEQ) ? b * SEQ + qpos : NLAT + b * CTXL + (qpos - SEQ);
    attn_write_out(o[g], lsum[g], Z + (size_t)m * zstride + head * 64, MIX + (size_t)m * D + head * 64, hh);
  }
}

DI void natten_item(const Params& p, int j, int item, unsigned char* lds) {
  const int b = item >> 8, head = (item >> 4) & 15, rp = item & 15;
  const bf16_t* Q = (const bf16_t*)(p.ws + WS_QC);
  const bf16_t* K = (const bf16_t*)(p.ws + WS_KC);
  const bf16_t* VT = (const bf16_t*)(p.ws + WS_VCT);
  const bf16_t* Z = (const bf16_t*)(p.ws + WS_ZC);
  bf16_t* MIX = (bf16_t*)(p.ws + WS_OH);
  const int t = tid_opaque(), lane = t & 63, w = t >> 6, r = lane & 31, hh = lane >> 5;
  bf16_t* Ks = (bf16_t*)(lds + AT_KS);
  bf16_t* Vs = (bf16_t*)(lds + AT_VS);
  float* rpbs = (float*)(lds + AT_RPB);
  const size_t bh = (size_t)(b * 16 + head);
  const int r0 = 2 * rp, qrow = r0 + (w >> 1), qc = 32 * (w & 1) + r, qpos = qrow * 64 + qc;
  const int ra = min(max(r0 - 4, 0), 24), rb = min(max(r0 + 1 - 4, 0), 24) + 7;
  const int nlat = rb - ra + 1, ntiles = nlat + 4;
  const int my_rs = min(max(qrow - 4, 0), 24);
  __syncthreads();
  for (int i = t; i < 15 * 31; i += 256) rpbs[i] = p.od_rpb[((size_t)(j * 16 + head)) * 465 + i] * LOG2E;
  bf16x8 qf[4];
#pragma unroll
  for (int jj = 0; jj < 4; ++jj) qf[jj] = *(const bf16x8*)(Q + (bh * KEYS + qpos) * 64 + 16 * jj + 8 * hh);
  f32x16 o[2];
#pragma unroll
  for (int x = 0; x < 2; ++x)
#pragma unroll
    for (int i = 0; i < 16; ++i) o[x][i] = 0.f;
  float mx = -1e30f, lsum = 0.f;
  const bf16_t* kb0 = K + bh * KEYS * 64;
  const bf16_t* vb0 = VT + bh * 64 * KEYS;
  u32x4 rk[2], rv[2];
  attn_load_tile<64>(kb0 + (size_t)(ra * 64) * 64, vb0 + ra * 64, rk, rv);
  for (int tt = 0; tt < ntiles; ++tt) {
    __syncthreads();
    attn_store_tile<64>(Ks, Vs, rk, rv);
    __syncthreads();
    if (tt + 1 < ntiles) {
      const int key0 = (tt + 1 < nlat) ? (ra + tt + 1) * 64 : SEQ + (tt + 1 - nlat) * 64;
      attn_load_tile<64>(kb0 + (size_t)key0 * 64, vb0 + key0, rk, rv);
    }
    if (tt < nlat) {
      const int kr = ra + tt;
      if (kr >= my_rs && kr < my_rs + 8) attn_tile<64, 1>(Ks, Vs, qf, o, mx, lsum, r, hh, rpbs, kr - qrow + 7, qc);
    } else {
      attn_tile<64, 0>(Ks, Vs, qf, o, mx, lsum, r, hh, nullptr, 0, 0);
    }
  }
  const int m = b * SEQ + qpos;
  attn_write_out(o, lsum, Z + (size_t)m * D + head * 64, MIX + (size_t)m * D + head * 64, hh);
}


DI void natten_item2(const Params& p, int j, int item, unsigned char* lds) {
  const int b = item >> 7, head = (item >> 3) & 15, rq = item & 7;
  const bf16_t* Q = (const bf16_t*)(p.ws + WS_QC);
  const bf16_t* K = (const bf16_t*)(p.ws + WS_KC);
  const bf16_t* VT = (const bf16_t*)(p.ws + WS_VCT);
  const bf16_t* Z = (const bf16_t*)(p.ws + WS_ZC);
  bf16_t* MIX = (bf16_t*)(p.ws + WS_OH);
  const int t = tid_opaque(), lane = t & 63, w = t >> 6, r = lane & 31, hh = lane >> 5;
  bf16_t* Ks = (bf16_t*)(lds + AT_KS);
  bf16_t* Vs = (bf16_t*)(lds + AT_VS);
  float* rpbs = (float*)(lds + AT_RPB);
  const size_t bh = (size_t)(b * 16 + head);
  const int r0 = 4 * rq, qrow = r0 + w, qpos0 = qrow * 64 + r;
  const int ra = min(max(r0 - 4, 0), 24), rb = min(max(r0 + 3 - 4, 0), 24) + 7;
  const int nlat = rb - ra + 1, ntiles = nlat + 4;
  const int my_rs = min(max(qrow - 4, 0), 24);
  __syncthreads();
  for (int i = t; i < 15 * 31; i += 256) rpbs[i] = p.od_rpb[((size_t)(j * 16 + head)) * 465 + i] * LOG2E;
  bf16x8 qfA[4];
  bf16_t* QsB = (bf16_t*)(lds + AT_QS) + (32 * w + r) * 72 + 8 * hh;
#pragma unroll
  for (int jj = 0; jj < 4; ++jj) {
    qfA[jj] = *(const bf16x8*)(Q + (bh * KEYS + qpos0) * 64 + 16 * jj + 8 * hh);
    *(bf16x8*)(QsB + 16 * jj) = *(const bf16x8*)(Q + (bh * KEYS + qpos0 + 32) * 64 + 16 * jj + 8 * hh);
  }
  f32x16 o[2][2];
#pragma unroll
  for (int g = 0; g < 2; ++g)
#pragma unroll
    for (int x = 0; x < 2; ++x)
#pragma unroll
      for (int i = 0; i < 16; ++i) o[g][x][i] = 0.f;
  float mx[2] = {-1e30f, -1e30f}, lsum[2] = {0.f, 0.f};
  const bf16_t* kb0 = K + bh * KEYS * 64;
  const bf16_t* vb0 = VT + bh * 64 * KEYS;
  u32x4 rk[2], rv[2];
#define NAT_KEY0(tq) (((tq) < nlat) ? (ra + (tq)) * 64 : SEQ + ((tq) - nlat) * 64)
  attn_load_tile<64>(kb0 + (size_t)(ra * 64) * 64, vb0 + ra * 64, rk, rv);
  attn_store_tile<64>(Ks, Vs, rk, rv);
  { const int k1 = NAT_KEY0(1); attn_load_tile<64>(kb0 + (size_t)k1 * 64, vb0 + k1, rk, rv); }
  __syncthreads();
#pragma unroll 1
  for (int tt = 0; tt < ntiles; ++tt) {
    const int bo = (tt & 1) * (AT_BUF / 2);
    if (tt < nlat) {
      const int kr = ra + tt;
      if (kr >= my_rs && kr < my_rs + 8) attn_tile2<64, 1, true>(Ks + bo, Vs + bo, qfA, qfA, QsB, o, mx, lsum, r, hh, rpbs, kr - qrow + 7, r);
    } else {
      attn_tile2<64, 0, true>(Ks + bo, Vs + bo, qfA, qfA, QsB, o, mx, lsum, r, hh, nullptr, 0, 0);
    }
    if (tt + 1 < ntiles) {
      const int bn = ((tt + 1) & 1) * (AT_BUF / 2);
      attn_store_tile<64>(Ks + bn, Vs + bn, rk, rv);
      if (tt + 2 < ntiles) { const int k2 = NAT_KEY0(tt + 2); attn_load_tile<64>(kb0 + (size_t)k2 * 64, vb0 + k2, rk, rv); }
    }
    __syncthreads();
  }
#undef NAT_KEY0
#pragma unroll
  for (int g = 0; g < 2; ++g) {
    const int m = b * SEQ + qpos0 + 32 * g;
    attn_write_out(o[g], lsum[g], Z + (size_t)m * D + head * 64, MIX + (size_t)m * D + head * 64, hh);
  }
}

DI void od_win_tile(const Params& p, int j, int mt, int nt, unsigned char* lds) {
  const bf16_t* H = (const bf16_t*)(p.ws + WS_OH);
  const bf16_t* WT = (const bf16_t*)(p.ws + WS_WT + WT_OD_IN);
  const int t = tid_opaque(), m0 = mt * 128, n0 = nt * 128;
  const float* Cs = (const float*)lds;
  const int type = n0 >> 10, hh0 = (n0 & 1023) >> 6;
  int b, pos0; tok_bp(m0, b, pos0);
  if (type < 2) {
    bf16_t* dstb = (bf16_t*)(p.ws + (type == 0 ? WS_QC : WS_KC));
    const float* gain = (type == 0 ? p.od_q_gain : p.od_k_gain) + j * 64;
    const float sc = (type == 0) ? 0.125f * LOG2E : 1.f;
#pragma unroll 1
    for (int it = 0; it < 8; ++it) {
      const int idx = t + 256 * it, l8 = idx & 7, hsel = (idx >> 3) & 1, row = idx >> 4;
      float v[8];
      *(f32x4*)v = *(const f32x4*)(Cs + row * 132 + hsel * 64 + l8 * 8);
      *(f32x4*)(v + 4) = *(const f32x4*)(Cs + row * 132 + hsel * 64 + l8 * 8 + 4);
      float ss = 0.f;
#pragma unroll
      for (int e = 0; e < 8; ++e) ss += v[e] * v[e];
      ss += __shfl_xor(ss, 1); ss += __shfl_xor(ss, 2); ss += __shfl_xor(ss, 4);
      const float rstd = rsqrtf(ss * (1.f / 64.f) + EPS) * sc;
#pragma unroll
      for (int e = 0; e < 8; ++e) v[e] *= rstd * gain[l8 * 8 + e];
      *(u32x4*)(dstb + ((size_t)(b * 16 + hh0 + hsel) * KEYS + pos0 + row) * 64 + l8 * 8) = pack8(v);
    }
  } else if (type == 2) {
    bf16_t* VCT = (bf16_t*)(p.ws + WS_VCT);
#pragma unroll 1
    for (int it = 0; it < 8; ++it) {
      const int idx = t + 256 * it, rg = idx & 15, cc = idx >> 4, head = hh0 + (cc >> 6), e = cc & 63;
      float v[8];
#pragma unroll
      for (int q = 0; q < 8; ++q) v[q] = Cs[(rg * 8 + q) * 132 + cc];
      *(u32x4*)(VCT + ((size_t)(b * 16 + head) * 64 + e) * KEYS + pos0 + rg * 8) = pack8(v);
    }
  } else {
    bf16_t* ZC = (bf16_t*)(p.ws + WS_ZC);
#pragma unroll 1
    for (int it = 0; it < 8; ++it) {
      const int idx = t + 256 * it, row = idx >> 4, ch = idx & 15;
      float v[8];
      *(f32x4*)v = *(const f32x4*)(Cs + row * 132 + ch * 8);
      *(f32x4*)(v + 4) = *(const f32x4*)(Cs + row * 132 + ch * 8 + 4);
      *(u32x4*)(ZC + (size_t)(m0 + row) * D + (n0 - 3072) + ch * 8) = pack8(v);
    }
  }
}


struct OdWinOps {
  const Params* pp; int j; int layer;
  DI void map(int id, int& mt, int& nt) const {
    xcd_tile(id, 18, 32, 6, mt, nt);
  }
  DI TileDesc tile(int id) const {
    int mt, nt; map(id, mt, nt);
    TileDesc d; d.A = (const bf16_t*)(pp->ws + WS_OH) + (size_t)mt * 128 * D; d.B = (const bf16_t*)(pp->ws + WS_WT + WT_OD_IN) + (size_t)nt * 128 * D; d.nvalid = 128;
    return d;
  }
  DI void epi(int id, unsigned char* lds) const { int mt, nt; map(id, mt, nt); od_win_tile(*pp, j, mt, nt, lds); }
};


struct OdWinOps2 {
  const Params* pp; int j; int layer;
  DI void epi_lds(int, unsigned char*) const {}
  DI TileDesc tile(int id) const {
    int mt, nt; xcd_tile(id, 18, 32, 6, mt, nt);
    TileDesc d; d.A = (const bf16_t*)(pp->ws + WS_OH) + (size_t)mt * 128 * D; d.B = (const bf16_t*)(pp->ws + WS_WT + WT_OD_IN) + (size_t)nt * 128 * D; d.nvalid = 128;
    return d;
  }
  DI void epi_read(int id, unsigned char* lds, float (&c)[64]) const {
    int mt, nt; xcd_tile(id, 18, 32, 6, mt, nt);
    const int type = nt >> 3;
    const int t = tid_opaque();
    const float* Cs = (const float*)lds;
    if (type == 2) {
      const int rg = t & 15;
#pragma unroll
      for (int it = 0; it < 8; ++it) {
        const int cc = (t >> 4) + 16 * it;
#pragma unroll
        for (int q = 0; q < 8; ++q) c[it * 8 + q] = Cs[(rg * 8 + q) * 132 + cc];
      }
    } else {
      const int off = (type < 2) ? ((t >> 3) & 1) * 64 + (t & 7) * 8 : (t & 15) * 8;
#pragma unroll
      for (int it = 0; it < 8; ++it) {
        const int row = (t >> 4) + 16 * it;
        *(f32x4*)(c + it * 8) = *(const f32x4*)(Cs + row * 132 + off);
        *(f32x4*)(c + it * 8 + 4) = *(const f32x4*)(Cs + row * 132 + off + 4);
      }
    }
  }
  DI void epi_write(int id, const float (&c)[64]) const {
    const Params& p = *pp;
    int mt, nt; xcd_tile(id, 18, 32, 6, mt, nt);
    const int m0 = mt * 128, n0 = nt * 128;
    const int t = tid_opaque();
    const int type = n0 >> 10, hh0 = (n0 & 1023) >> 6;
    int b, pos0; tok_bp(m0, b, pos0);
    if (type < 2) {
      bf16_t* dstb = (bf16_t*)(p.ws + (type == 0 ? WS_QC : WS_KC));
      const int l8 = t & 7, hsel = (t >> 3) & 1;
      const float* gain = (type == 0 ? p.od_q_gain : p.od_k_gain) + j * 64 + l8 * 8;
      const f32x4 g0 = *(const f32x4*)gain, g1 = *(const f32x4*)(gain + 4);
      const float gg[8] = {g0.x, g0.y, g0.z, g0.w, g1.x, g1.y, g1.z, g1.w};
      const float sc = (type == 0) ? 0.125f * LOG2E : 1.f;
#pragma unroll
      for (int it = 0; it < 8; ++it) {
        const int row = (t >> 4) + 16 * it;
        float v[8];
        float ss = 0.f;
#pragma unroll
        for (int e = 0; e < 8; ++e) { v[e] = c[it * 8 + e]; ss += v[e] * v[e]; }
        ss += __shfl_xor(ss, 1); ss += __shfl_xor(ss, 2); ss += __shfl_xor(ss, 4);
        const float rstd = rsqrtf(ss * (1.f / 64.f) + EPS) * sc;
#pragma unroll
        for (int e = 0; e < 8; ++e) v[e] *= rstd * gg[e];
        st_wt((u32x4*)(dstb + ((size_t)(b * 16 + hh0 + hsel) * KEYS + pos0 + row) * 64 + l8 * 8), pack8(v));
      }
    } else if (type == 2) {
      bf16_t* VCT = (bf16_t*)(p.ws + WS_VCT);
      const int rg = t & 15;
#pragma unroll
      for (int it = 0; it < 8; ++it) {
        const int cc = (t >> 4) + 16 * it, head = hh0 + (cc >> 6), e = cc & 63;
        st_wt((u32x4*)(VCT + ((size_t)(b * 16 + head) * 64 + e) * KEYS + pos0 + rg * 8), pack8(c + it * 8));
      }
    } else {
      bf16_t* ZC = (bf16_t*)(p.ws + WS_ZC);
      const int ch = t & 15;
#pragma unroll
      for (int it = 0; it < 8; ++it) {
        const int row = (t >> 4) + 16 * it;
        st_wt((u32x4*)(ZC + (size_t)(m0 + row) * D + (n0 - 3072) + ch * 8), pack8(c + it * 8));
      }
    }
  }
};

__global__ void __launch_bounds__(256, 2) fwd_megakernel(Params p) {
  extern __shared__ __attribute__((aligned(16))) unsigned char smem[];
  cg::grid_group grid = cg::this_grid();
  unsigned char* lds = smem;
  volatile LAS unsigned* stw = (volatile LAS unsigned*)(smem + LDS_MAIN);
  if (__builtin_amdgcn_workitem_id_x() < 4) stw[__builtin_amdgcn_workitem_id_x()] = 0u;
  __syncthreads();
  const XcdBarrier xbar = xcd_barrier_post((unsigned*)(p.ws + WS_BAR), stw);
  if (p.ws == nullptr) grid.sync();

  for (int rep = 0; rep < NREP(5); ++rep) phase_setup(p, lds);
  GSYNC();

  for (int layer = 0; layer < 4; ++layer) {
    const int j = layer >> 1;
    for (int rep = 0; rep < NREP(4); ++rep) phase_norm(p, layer, lds);
    GSYNC();
    if ((layer & 1) == 0) {
      for (int rep = 0; rep < NREP(0); ++rep) phase_ev_win(p, lds);
      GSYNC();
      for (int rep = 0; rep < NREP(2); ++rep) {
        { EvQOps ops; ops.pp = &p; ops.j = j; gemm_glds2<3, EvQOps, true, true>(1152, U1W, 768, ops, lds); }
        { EvKvOps ops; ops.pp = &p; ops.j = j; gemm_glds2<4, EvKvOps, true, true>(1152, U1W, 256, ops, lds, 128); }
        for (int id = (blockIdx.x + 256) % gridDim.x; id < 1152; id += gridDim.x) gla_g1_item(p, j, id, lds);
      }
      GSYNC();
      {
        const bf16_t* QA = (const bf16_t*)(p.ws + WS_R1 + R1_QA);
        const bf16_t* KA = (const bf16_t*)(p.ws + WS_R1 + R1_KA);
        const bf16_t* VAT = (const bf16_t*)(p.ws + WS_R1 + R1_VAT);
        const bf16_t* U2 = (const bf16_t*)(p.ws + WS_U2);
        bf16_t* MIX = (bf16_t*)(p.ws + WS_R2);
        for (int rep = 0; rep < NREP(1); ++rep)
        for (int id = blockIdx.x; id < (rep == 0 ? 512 + 512 : 512); id += gridDim.x) {
          if (id < 512) {
            const int qb = id & 7, head = (id >> 3) & 7, b = id >> 6;
            attn_dense_item2<96, 8>(QA, KA, VAT, U2 + U2_ZA, U2W, MIX, b, head, qb * 256, 0, KEYS / 64, lds);
          } else {
            gla_scan_item(p, id - 512);
          }
        }
      }
      GSYNC();
      {
        const bf16_t* QA = (const bf16_t*)(p.ws + WS_R1 + R1_QA);
        const bf16_t* KA = (const bf16_t*)(p.ws + WS_R1 + R1_KA);
        const bf16_t* VAT = (const bf16_t*)(p.ws + WS_R1 + R1_VAT);
        const bf16_t* U2 = (const bf16_t*)(p.ws + WS_U2);
        bf16_t* MIX = (bf16_t*)(p.ws + WS_R2);
        for (int rep = 0; rep < NREP(3); ++rep)
        for (int id = blockIdx.x; id < 1152 + 64; id += gridDim.x) {
          if (id < 1152) gla_g3_item(p, j, id, lds);
          else {
            const int i2 = id - 1152, head = i2 & 7, b = i2 >> 3;
            attn_dense_item2<96, 8>(QA, KA, VAT, U2 + U2_ZA, U2W, MIX, b, head, SEQ, SEQ, CTXL / 64, lds);
          }
        }
      }
      GSYNC();
    } else {
      for (int rep = 0; rep < NREP(0); ++rep) {
        OdWinOps2 ops; ops.pp = &p; ops.j = j; ops.layer = layer;
        gemm_glds2<4>(144 * 32, D, D, ops, lds);
      }
      GSYNC();
      {
        const int nctx = (layer == 3) ? 0 : 128;
        const bf16_t* QC = (const bf16_t*)(p.ws + WS_QC);
        const bf16_t* KC = (const bf16_t*)(p.ws + WS_KC);
        const bf16_t* VCT = (const bf16_t*)(p.ws + WS_VCT);
        const bf16_t* ZC = (const bf16_t*)(p.ws + WS_ZC);
        bf16_t* MIX = (bf16_t*)(p.ws + WS_OH);
        for (int rep = 0; rep < NREP(1); ++rep)
        for (int id = blockIdx.x; id < 1024 + nctx; id += gridDim.x) {
          if (id < 1024) natten_item2(p, j, id, lds);
          else {
            const int i2 = id - 1024, head = i2 & 15, b = i2 >> 4;
            attn_dense_item2<64, 16>(QC, KC, VCT, ZC, D, MIX, b, head, SEQ, SEQ, CTXL / 64, lds);
          }
        }
      }
      GSYNC();
    }
    phase_wout(p, layer, lds);
    if (layer < 3) GSYNC();
  }
}

extern "C" void kernel_launch(void* const* d_in, const int* in_sizes, int n_in, void* d_out, int out_size, void* d_ws, size_t ws_size,
                              hipStream_t stream) {
  static int grid_blocks = 0;
  if (!grid_blocks) {
    int dev = 0, cus = 0, per_cu = 0;
    hipGetDevice(&dev);
    hipDeviceGetAttribute(&cus, hipDeviceAttributeMultiprocessorCount, dev);
    hipFuncSetAttribute((const void*)fwd_megakernel, hipFuncAttributeMaxDynamicSharedMemorySize, LDS_BYTES);
    hipOccupancyMaxActiveBlocksPerMultiprocessor(&per_cu, (const void*)fwd_megakernel, 256, LDS_BYTES);
    if (per_cu < 1) per_cu = 1;
    if (per_cu > 2) per_cu = 2;
    grid_blocks = cus * per_cu;
    if (ws_size < WS_NEED) fprintf(stderr, "kernel_launch: workspace too small: %zu < %zu\n", ws_size, (size_t)WS_NEED);
  }
  Params p{};
  const float** pp = (const float**)&p;
  for (int i = 0; i < 23; ++i) pp[i] = (const float*)d_in[i];
  p.out = (float*)d_out;
  p.ws = (unsigned char*)d_ws;
  hipMemsetAsync((unsigned char*)d_ws + WS_BAR, 0, BAR_BYTES, stream);
  void* args[] = {&p};
  hipError_t e = hipLaunchCooperativeKernel((const void*)fwd_megakernel, dim3(grid_blocks), dim3(256), args, LDS_BYTES, stream);
  if (e != hipSuccess) fprintf(stderr, "cooperative launch failed: %s (grid %d)\n", hipGetErrorString(e), grid_blocks);
}
```

```cpp
#include <hip/hip_runtime.h>
#include <hip/hip_cooperative_groups.h>
#include <stdint.h>
#include <stdio.h>
namespace cg = cooperative_groups;
#ifndef PHM
#define PHM 0xffff
#endif
#ifndef DBLM
#define DBLM 0
#endif
#define GSYNC() do { xcd_barrier(xbar); if (NREP(6) == 2) xcd_barrier(xbar); } while (0)
#define NREP(k) (((DBLM >> (k)) & 1) ? 2 : 1)

#define DI __device__ __forceinline__
typedef unsigned short bf16_t;
typedef short bf16x8 __attribute__((ext_vector_type(8)));
typedef short s16x4 __attribute__((ext_vector_type(4)));
typedef float f32x4 __attribute__((ext_vector_type(4)));
typedef float f32x16 __attribute__((ext_vector_type(16)));
typedef unsigned u32x4 __attribute__((ext_vector_type(4)));
typedef unsigned u32x2 __attribute__((ext_vector_type(2)));

constexpr int D = 1024, NB = 8, SEQ = 2048, CTXL = 256, NLAT = NB * SEQ, NCTX = NB * CTXL, NTOK = NLAT + NCTX, KEYS = SEQ + CTXL;
constexpr int EVEN_IN = 3136, ODD_IN = 4096;
constexpr int U1W = 1056, U2W = 2080;
constexpr int U2_ZA = 0, U2_QB = 512, U2_KB = 768, U2_VB = 1024, U2_GLR = 1536, U2_ZB = 1568;
constexpr float EPS = 1e-6f;
constexpr float LOG2E = 1.4426950408889634f;
constexpr int NCHUNK = 36;

constexpr size_t WS_WT = 0;
constexpr size_t WT_EV_IN = 0, WT_EV_UQ = (size_t)EVEN_IN * D * 2, WT_EV_UKV = WT_EV_UQ + (size_t)768 * 768 * 2,
                 WT_EV_OUT = WT_EV_UKV + (size_t)1024 * 256 * 2;
constexpr size_t WT_OD_IN = 0, WT_OD_OUT = (size_t)ODD_IN * D * 2;
constexpr size_t WT_BYTES = (size_t)ODD_IN * D * 2 + (size_t)D * D * 2;
constexpr size_t WS_MOD = WS_WT + WT_BYTES;
constexpr size_t WS_ROPEC = WS_MOD + 4 * 9 * 3072 * 4;
constexpr size_t WS_ROPES = WS_ROPEC + 2048 * 16 * 4;
constexpr size_t WS_DEC = WS_ROPES + 2048 * 16 * 4;
constexpr size_t WS_CX = WS_DEC + 64 * 36 * 64 * 4;
constexpr size_t WS_R1 = WS_CX + (size_t)NCTX * D * 4;
constexpr size_t R1_QA = 0, R1_KA = (size_t)NB * 8 * KEYS * 96 * 2, R1_VAT = 2 * R1_KA;
constexpr size_t R1_BYTES = 2 * R1_KA + (size_t)NB * 8 * 64 * KEYS * 2;
constexpr size_t WS_R2 = WS_R1 + R1_BYTES;
constexpr size_t R2_BYTES = (size_t)NTOK * U1W * 2;
constexpr size_t WS_U2 = WS_R2 + R2_BYTES;
constexpr size_t U2_BYTES = (size_t)NTOK * U2W * 2;
constexpr size_t WS_KVST = WS_U2 + U2_BYTES;
constexpr size_t KVST_BYTES = (size_t)64 * 36 * 8192 * 2;
constexpr size_t WS_END_EVEN = WS_KVST + KVST_BYTES;
constexpr size_t WS_OH = WS_R1;
constexpr size_t OH_BYTES = (size_t)NTOK * D * 2;
constexpr size_t WS_QC = WS_OH + OH_BYTES;
constexpr size_t QC_BYTES = (size_t)NB * 16 * KEYS * 64 * 2;
constexpr size_t WS_KC = WS_QC + QC_BYTES, WS_VCT = WS_KC + QC_BYTES, WS_ZC = WS_VCT + QC_BYTES;
constexpr size_t WS_END_ODD = WS_ZC + OH_BYTES;
constexpr size_t WS_BAR = ((WS_END_EVEN > WS_END_ODD ? WS_END_EVEN : WS_END_ODD) + 255) / 256 * 256;
constexpr size_t BAR_BYTES = 16384;
constexpr size_t WS_NEED = WS_BAR + BAR_BYTES;

constexpr int LDS_MAIN = 73728;
constexpr int LDS_BYTES = LDS_MAIN + 16;

struct Params {
  const float *x, *c, *ctx, *c_ctx, *norm_g, *ada_w, *ada_b, *ev_w_in, *ev_q_norm, *ev_w_uq, *ev_kv_norm, *ev_w_ukv,
      *ev_q_gain, *ev_k_gain, *ev_gate_w, *ev_gate_b, *ev_gla_norm, *ev_w_out, *od_w_in, *od_q_gain, *od_k_gain, *od_rpb, *od_w_out;
  float* out;
  unsigned char* ws;
};

typedef __bf16 bf16v2_t __attribute__((ext_vector_type(2)));
typedef float f32x2_t __attribute__((ext_vector_type(2)));
DI unsigned pk2(float lo, float hi) { f32x2_t f = {lo, hi}; bf16v2_t b = __builtin_convertvector(f, bf16v2_t); return __builtin_bit_cast(unsigned, b); }
DI bf16_t f2bf(float x) { return (bf16_t)(pk2(x, 0.f) & 0xffffu); }
DI float bf2f(bf16_t b) { return __uint_as_float((unsigned)b << 16); }
DI float bflo(unsigned u) { return __uint_as_float(u << 16); }
DI float bfhi(unsigned u) { return __uint_as_float(u & 0xffff0000u); }
DI u32x4 pack8(const float* v) { u32x4 o; o.x = pk2(v[0], v[1]); o.y = pk2(v[2], v[3]); o.z = pk2(v[4], v[5]); o.w = pk2(v[6], v[7]); return o; }
DI void unpack8(u32x4 u, float* v) { v[0] = bflo(u.x); v[1] = bfhi(u.x); v[2] = bflo(u.y); v[3] = bfhi(u.y); v[4] = bflo(u.z); v[5] = bfhi(u.z); v[6] = bflo(u.w); v[7] = bfhi(u.w); }
DI float wave_sum(float v) {
#pragma unroll
  for (int o = 32; o; o >>= 1) v += __shfl_xor(v, o);
  return v;
}
DI int tid_opaque() { int t = __builtin_amdgcn_workitem_id_x(); asm volatile("" : "+v"(t)); return t; }
DI float silu_f(float z) { return z / (1.f + __expf(-z)); }
DI float exp2_fast(float x) { return __builtin_amdgcn_exp2f(x); }
DI int crow(int i, int h) { return (i & 3) + 8 * (i >> 2) + 4 * h; }
#define MFMA32(a, b, c) __builtin_amdgcn_mfma_f32_32x32x16_bf16((a), (b), (c), 0, 0, 0)
#define MFMA16(a, b, c) __builtin_amdgcn_mfma_f32_16x16x32_bf16((a), (b), (c), 0, 0, 0)


#define XB_TMO      128
#define XB_XCNT(j)  (256  + 64 * (j))
#define XB_XSUB(j)  (1280 + 64 * (j))
#define XB_XGEN(j)  (2304 + 64 * (j))
#define XB_TOP      3328
#define XB_TOPGEN   3392
#define XCD_BAR_WORDS 3456
#define XB_SPIN_CAP (1u << 18)
#define LAS __attribute__((address_space(3)))
DI unsigned xb_ld(unsigned* p) { return __hip_atomic_load(p, __ATOMIC_RELAXED, __HIP_MEMORY_SCOPE_AGENT); }
DI unsigned xb_add(unsigned* p, unsigned v) { return __hip_atomic_fetch_add(p, v, __ATOMIC_RELAXED, __HIP_MEMORY_SCOPE_AGENT); }
DI unsigned xb_xcc_id() { return (unsigned)__builtin_amdgcn_s_getreg((3 << 11) | 20) & 0xFu; }
#define XB_SPIN(cond, bar) do { unsigned _sp = 0; while (cond) { __builtin_amdgcn_s_sleep(8);     \
    if ((++_sp & 255u) == 0u) { if (xb_ld(&(bar)[XB_TMO])) break; if (_sp > XB_SPIN_CAP) { atomicAdd(&(bar)[XB_TMO], 1u); break; } } } } while (0)
struct XcdBarrier { unsigned* bar; unsigned x; volatile LAS unsigned* st; };
DI XcdBarrier xcd_barrier_post(unsigned* bar, volatile LAS unsigned* st) {
  XcdBarrier b; b.bar = bar; b.x = xb_xcc_id(); b.st = st;
  if (__builtin_amdgcn_workitem_id_x() == 0) (void)xb_add(&bar[XB_XCNT(b.x)], 1u);
  return b;
}
DI void xcd_barrier_complete(unsigned* bar, unsigned x, unsigned& nloc, unsigned& nx) {
  const unsigned G = gridDim.x * gridDim.y * gridDim.z;
  unsigned sum, cnt, mine, sp = 0u;
  for (;;) {
    sum = 0u; cnt = 0u; mine = 0u;
#pragma unroll
    for (unsigned j = 0; j < 16; ++j) { const unsigned c = xb_ld(&bar[XB_XCNT(j)]); sum += c; cnt += (c > 0u) ? 1u : 0u; mine = (j == x) ? c : mine; }
    if (sum == G) break;
    __builtin_amdgcn_s_sleep(1);
    if ((++sp & 255u) == 0u) { if (xb_ld(&bar[XB_TMO])) break; if (sp > XB_SPIN_CAP) { atomicAdd(&bar[XB_TMO], 1u); break; } }
  }
  nloc = mine > 0u ? mine : 1u; nx = cnt > 0u ? cnt : 1u;
}
DI void xcd_barrier(const XcdBarrier& b) {
  asm volatile("s_waitcnt vmcnt(0)" ::: "memory");
  __syncthreads();
  if (__builtin_amdgcn_workitem_id_x() == 0) {
    unsigned* bar = b.bar;
    const unsigned bx = xb_xcc_id();
    __builtin_amdgcn_s_waitcnt(0);
    unsigned nloc = b.st[0], nx = b.st[1];
    if (nloc == 0u) { xcd_barrier_complete(bar, bx, nloc, nx); b.st[0] = nloc; b.st[1] = nx; }
    const unsigned old = xb_add(&bar[XB_XSUB(bx)], 1u);
    const unsigned gen = old / nloc;
    if (old + 1u == (gen + 1u) * nloc) {
      __builtin_amdgcn_fence(__ATOMIC_RELEASE, "agent");
      asm volatile("s_waitcnt vmcnt(0)" ::: "memory");
      const unsigned og = xb_add(&bar[XB_TOP], 1u);
      const unsigned tg = og / nx;
      if (og + 1u == (tg + 1u) * nx) xb_add(&bar[XB_TOPGEN], 1u);
      else XB_SPIN(xb_ld(&bar[XB_TOPGEN]) == tg, bar);
      __builtin_amdgcn_fence(__ATOMIC_ACQUIRE, "agent");
      xb_add(&bar[XB_XGEN(bx)], 1u);
      asm volatile("s_waitcnt vmcnt(0)" ::: "memory");
    } else {
      XB_SPIN(xb_ld(&bar[XB_XGEN(bx)]) == gen, bar);
      __builtin_amdgcn_fence(__ATOMIC_ACQUIRE, "agent");
      asm volatile("s_waitcnt vmcnt(0)" ::: "memory");
    }
  }
  __syncthreads();
}

DI void tok_bp(int m, int& b, int& pos) {
  if (m < NLAT) { b = m >> 11; pos = m & 2047; } else { int mm = m - NLAT; b = mm >> 8; pos = SEQ + (mm & 255); }
}

DI void phase_setup(const Params& p, unsigned char* lds) {
  const int t = tid_opaque();
  float* MOD = (float*)(p.ws + WS_MOD);
  for (int item = blockIdx.x; item < 384; item += gridDim.x) {
    const int layer = item / 96, n0 = (item % 96) * 32;
    float* sc = (float*)lds;
    float* red = sc + 9 * 1024;
    __syncthreads();
    for (int i = t; i < 9 * 1024; i += 256) {
      const int r = i >> 10, k = i & 1023;
      const float v = (r < 8) ? p.c[r * 1024 + k] : p.c_ctx[k];
      sc[i] = silu_f(v);
    }
    __syncthreads();
    const int col = t & 31, kq = t >> 5;
    float acc[9];
#pragma unroll
    for (int r = 0; r < 9; ++r) acc[r] = 0.f;
    const float* W = p.ada_w + (size_t)layer * 1024 * 3072 + n0 + col;
#pragma unroll 4
    for (int k = kq * 128; k < kq * 128 + 128; k += 4) {
      const float w0 = W[(size_t)k * 3072], w1 = W[(size_t)(k + 1) * 3072], w2 = W[(size_t)(k + 2) * 3072], w3 = W[(size_t)(k + 3) * 3072];
#pragma unroll
      for (int r = 0; r < 9; ++r) {
        const f32x4 s4 = *(const f32x4*)(sc + r * 1024 + k);
        acc[r] += s4.x * w0 + s4.y * w1 + s4.z * w2 + s4.w * w3;
      }
    }
#pragma unroll
    for (int r = 0; r < 9; ++r) red[(kq * 9 + r) * 32 + col] = acc[r];
    __syncthreads();
    for (int i = t; i < 9 * 32; i += 256) {
      const int r = i >> 5, cc = i & 31;
      float v = 0.f;
#pragma unroll
      for (int q = 0; q < 8; ++q) v += red[(q * 9 + r) * 32 + cc];
      MOD[(size_t)(layer * 9 + r) * 3072 + n0 + cc] = v + p.ada_b[layer * 3072 + n0 + cc];
    }
  }
  float* RC = (float*)(p.ws + WS_ROPEC);
  float* RS = (float*)(p.ws + WS_ROPES);
  for (int i = blockIdx.x * 256 + t; i < 2048 * 16; i += gridDim.x * 256) {
    const int pos = i >> 4, a = (i >> 3) & 1, f = i & 7;
    const float coord = (float)(a == 0 ? (pos >> 6) : (pos & 63));
    const float inv = exp2f(-(float)f * 0.125f * 13.287712379549449f);
    const float ang = coord * inv;
    const float k = rintf(ang * 0.15915494309189535f);
    float rr = fmaf(-k, 6.28125f, ang);
    rr = fmaf(-k, 0.0019353071795864769f, rr);
    RC[i] = __cosf(rr);
    RS[i] = __sinf(rr);
  }
}

DI void transpose_item(const float* __restrict__ W, int K, int N, bf16_t* __restrict__ WT, const float* __restrict__ kscale, int item, float* tile) {
  const int t = tid_opaque();
  const int nblk = N >> 6, kb = item / nblk, nb = item % nblk, k0 = kb * 64, n0 = nb * 64;
  __syncthreads();
  {
    const int nn = t & 63, kk0 = t >> 6;
#pragma unroll
    for (int i = 0; i < 16; ++i) {
      const int kk = kk0 + 4 * i;
      float v = W[(size_t)(k0 + kk) * N + n0 + nn];
      if (kscale) v *= kscale[k0 + kk];
      tile[kk * 65 + nn] = v;
    }
  }
  __syncthreads();
  {
    const int n = t >> 2, kc = t & 3;
    float v[16];
#pragma unroll
    for (int j = 0; j < 16; ++j) v[j] = tile[(kc * 16 + j) * 65 + n];
    bf16_t* dst = WT + (size_t)(n0 + n) * K + k0 + kc * 16;
    *(u32x4*)dst = pack8(v);
    *(u32x4*)(dst + 8) = pack8(v + 8);
  }
}

DI void phase_norm(const Params& p, int layer, unsigned char* lds) {
  const int j = layer >> 1;
  bf16_t* WT = (bf16_t*)(p.ws + WS_WT);
  float* tile = (float*)lds;
  if ((layer & 1) == 0) {
    const int n1 = 16 * 49, n2 = n1 + 12 * 12, n3 = n2 + 4 * 16, n4 = n3 + 16 * 16;
    for (int it = blockIdx.x; it < n4; it += gridDim.x) {
      if (it < n1) transpose_item(p.ev_w_in + (size_t)j * D * EVEN_IN, D, EVEN_IN, (bf16_t*)((unsigned char*)WT + WT_EV_IN), nullptr, it, tile);
      else if (it < n2) transpose_item(p.ev_w_uq + (size_t)j * 768 * 768, 768, 768, (bf16_t*)((unsigned char*)WT + WT_EV_UQ), p.ev_q_norm + j * 768, it - n1, tile);
      else if (it < n3) transpose_item(p.ev_w_ukv + (size_t)j * 256 * 1024, 256, 1024, (bf16_t*)((unsigned char*)WT + WT_EV_UKV), p.ev_kv_norm + j * 256, it - n2, tile);
      else transpose_item(p.ev_w_out + (size_t)j * D * D, D, D, (bf16_t*)((unsigned char*)WT + WT_EV_OUT), nullptr, it - n3, tile);
    }
  } else {
    const int n1 = 16 * 64, n2 = n1 + 16 * 16;
    for (int it = blockIdx.x; it < n2; it += gridDim.x) {
      if (it < n1) transpose_item(p.od_w_in + (size_t)j * D * ODD_IN, D, ODD_IN, (bf16_t*)((unsigned char*)WT + WT_OD_IN), nullptr, it, tile);
      else transpose_item(p.od_w_out + (size_t)j * D * D, D, D, (bf16_t*)((unsigned char*)WT + WT_OD_OUT), nullptr, it - n1, tile);
    }
  }
  const int lane = tid_opaque() & 63, wv = tid_opaque() >> 6;
  const float* MOD = (const float*)(p.ws + WS_MOD);
  const float* xl = (layer == 0) ? p.x : p.out;
  const float* xc = (layer == 0) ? p.ctx : (const float*)(p.ws + WS_CX);
  bf16_t* H = (bf16_t*)(p.ws + (((layer & 1) == 0) ? WS_R1 : WS_OH));
  const float* g = p.norm_g + layer * D;
  const int wstride = gridDim.x * 4;
  for (int m0 = blockIdx.x * 4 + wv; m0 < NTOK; m0 += 3 * wstride) {
    f32x4 v[3][4];
    float ss[3];
#pragma unroll
    for (int u = 0; u < 3; ++u) {
      const int m = m0 + u * wstride;
      const int mc = m < NTOK ? m : m0;
      const float* xr = (mc < NLAT) ? xl + (size_t)mc * D : xc + (size_t)(mc - NLAT) * D;
#pragma unroll
      for (int q = 0; q < 4; ++q) v[u][q] = *(const f32x4*)(xr + 4 * lane + 256 * q);
    }
#pragma unroll
    for (int u = 0; u < 3; ++u) {
      float a = 0.f;
#pragma unroll
      for (int q = 0; q < 4; ++q) a += v[u][q].x * v[u][q].x + v[u][q].y * v[u][q].y + v[u][q].z * v[u][q].z + v[u][q].w * v[u][q].w;
      ss[u] = wave_sum(a);
    }
#pragma unroll
    for (int u = 0; u < 3; ++u) {
      const int m = m0 + u * wstride;
      if (m < NTOK) {
        const int r = (m < NLAT) ? (m >> 11) : 8;
        const float* shift = MOD + (size_t)(layer * 9 + r) * 3072;
        const float* scale = shift + 1024;
        const float rstd = rsqrtf(ss[u] * (1.f / D) + EPS);
#pragma unroll
        for (int q = 0; q < 4; ++q) {
          const int k = 4 * lane + 256 * q;
          const f32x4 gg = *(const f32x4*)(g + k), sc = *(const f32x4*)(scale + k), sh = *(const f32x4*)(shift + k);
          const float o0 = v[u][q].x * rstd * gg.x * (1.f + sc.x) + sh.x, o1 = v[u][q].y * rstd * gg.y * (1.f + sc.y) + sh.y;
          const float o2 = v[u][q].z * rstd * gg.z * (1.f + sc.z) + sh.z, o3 = v[u][q].w * rstd * gg.w * (1.f + sc.w) + sh.w;
          u32x2 o; o.x = pk2(o0, o1); o.y = pk2(o2, o3);
          *(u32x2*)(H + (size_t)m * D + k) = o;
        }
      }
    }
  }
}

constexpr int ROWSTAT_OFF = 67584, ROWSTAT2_OFF = ROWSTAT_OFF + 512;

template <int NFRAG, bool SUMSQ>
DI void gemm_mainloop(const bf16_t* __restrict__ A, int lda, const bf16_t* __restrict__ Bt, int K, int nvalid,
                      f32x4 (&acc)[4][NFRAG], unsigned char* lds) {
  constexpr int NBI = NFRAG;
  bf16_t* As = (bf16_t*)lds;
  bf16_t* Bs = As + 128 * 72;
  const int t = tid_opaque(), lane = t & 63, w = t >> 6, wr = w >> 1, wc = w & 1, fr = lane & 15, fq = lane >> 4;
  const int lc = t & 7, lr = t >> 3;
  const bf16_t* Ap = A + (size_t)lr * lda + lc * 8;
  const bf16_t* Bp = Bt + (size_t)lr * K + lc * 8;
  u32x4 ra[4], rb[NBI];
  float ssq[4] = {0.f, 0.f, 0.f, 0.f};
#pragma unroll
  for (int mi = 0; mi < 4; ++mi)
#pragma unroll
    for (int ni = 0; ni < NFRAG; ++ni) acc[mi][ni] = (f32x4){0.f, 0.f, 0.f, 0.f};
  const int nk = K >> 6;
#pragma unroll
  for (int i = 0; i < 4; ++i) ra[i] = *(const u32x4*)(Ap + (size_t)(32 * i) * lda);
#pragma unroll
  for (int i = 0; i < NBI; ++i) rb[i] = (lr + 32 * i < nvalid) ? *(const u32x4*)(Bp + (size_t)(32 * i) * K) : (u32x4){0u, 0u, 0u, 0u};
  for (int kt = 0; kt < nk; ++kt) {
    __syncthreads();
#pragma unroll
    for (int i = 0; i < 4; ++i) {
      *(u32x4*)(As + (lr + 32 * i) * 72 + lc * 8) = ra[i];
      if (SUMSQ) { float v[8]; unpack8(ra[i], v);
#pragma unroll
        for (int e = 0; e < 8; ++e) ssq[i] += v[e] * v[e]; }
    }
#pragma unroll
    for (int i = 0; i < NBI; ++i) *(u32x4*)(Bs + (lr + 32 * i) * 72 + lc * 8) = rb[i];
    __syncthreads();
    if (kt + 1 < nk) {
      const int ko = (kt + 1) * 64;
#pragma unroll
      for (int i = 0; i < 4; ++i) ra[i] = *(const u32x4*)(Ap + (size_t)(32 * i) * lda + ko);
#pragma unroll
      for (int i = 0; i < NBI; ++i) rb[i] = (lr + 32 * i < nvalid) ? *(const u32x4*)(Bp + (size_t)(32 * i) * K + ko) : (u32x4){0u, 0u, 0u, 0u};
    }
#pragma unroll
    for (int kk = 0; kk < 2; ++kk) {
      bf16x8 af[4], bfr[NFRAG];
#pragma unroll
      for (int mi = 0; mi < 4; ++mi) af[mi] = *(const bf16x8*)(As + (wr * 64 + mi * 16 + fr) * 72 + kk * 32 + fq * 8);
#pragma unroll
      for (int ni = 0; ni < NFRAG; ++ni) bfr[ni] = *(const bf16x8*)(Bs + (wc * NFRAG * 16 + ni * 16 + fr) * 72 + kk * 32 + fq * 8);
#pragma unroll
      for (int mi = 0; mi < 4; ++mi)
#pragma unroll
        for (int ni = 0; ni < NFRAG; ++ni) acc[mi][ni] = MFMA16(af[mi], bfr[ni], acc[mi][ni]);
    }
  }
  constexpr int CP = 32 * NFRAG + 4;
  float* Cs = (float*)lds;
  __syncthreads();
#pragma unroll
  for (int mi = 0; mi < 4; ++mi)
#pragma unroll
    for (int ni = 0; ni < NFRAG; ++ni)
#pragma unroll
      for (int jj = 0; jj < 4; ++jj) Cs[(wr * 64 + mi * 16 + fq * 4 + jj) * CP + wc * NFRAG * 16 + ni * 16 + fr] = acc[mi][ni][jj];
  if (SUMSQ) {
    float* rowstat = (float*)(lds + ROWSTAT_OFF);
#pragma unroll
    for (int i = 0; i < 4; ++i) {
      float s = ssq[i];
      s += __shfl_xor(s, 1); s += __shfl_xor(s, 2); s += __shfl_xor(s, 4);
      if (lc == 0) rowstat[lr + 32 * i] = rsqrtf(s / (float)K + EPS);
    }
  }
  __syncthreads();
}

DI void rope8(float* v, const float* pv, const float* RC, const float* RS, int pos, int a, int half) {
  const f32x4 c0 = *(const f32x4*)(RC + pos * 16 + a * 8), c1 = *(const f32x4*)(RC + pos * 16 + a * 8 + 4);
  const f32x4 s0 = *(const f32x4*)(RS + pos * 16 + a * 8), s1 = *(const f32x4*)(RS + pos * 16 + a * 8 + 4);
  const float cs[8] = {c0.x, c0.y, c0.z, c0.w, c1.x, c1.y, c1.z, c1.w};
  const float sn[8] = {s0.x, s0.y, s0.z, s0.w, s1.x, s1.y, s1.z, s1.w};
#pragma unroll
  for (int e = 0; e < 8; ++e) v[e] = (half == 0) ? (v[e] * cs[e] - pv[e] * sn[e]) : (v[e] * cs[e] + pv[e] * sn[e]);
}


DI void xcd_tile(int v, int MPX, int NT, int MC, int& mt, int& nt) {
  const int x = v & 7, L = v >> 3;
  const int c = L / (MC * NT), base = c * MC;
  const int rows = min(MC, MPX - base), rem = L - c * MC * NT;
  nt = rem / rows;
  mt = x * MPX + base + rem % rows;
}

struct TileDesc { const bf16_t* A; const bf16_t* B; int nvalid; };

template <int NFRAG>
DI void g_issue(u32x4 (&ra)[4], u32x4 (&rb)[NFRAG], const bf16_t* cA, const bf16_t* cB, int cnv, int lda, int K, int ko, int lr) {
#pragma unroll
  for (int i = 0; i < 4; ++i) ra[i] = *(const u32x4*)(cA + (size_t)(32 * i) * lda + ko);
#pragma unroll
  for (int i = 0; i < NFRAG; ++i) { const int ro = (lr + 32 * i < cnv) ? 32 * i : 0;
    rb[i] = *(const u32x4*)(cB + (size_t)ro * K + ko); }
}

constexpr int GP = 80;

template <int NFRAG, bool SUMSQ>
DI void g_write(const u32x4 (&ra)[4], const u32x4 (&rb)[NFRAG], float (&ssq)[4], bf16_t* As, bf16_t* Bs, int lr, int lc) {
#pragma unroll
  for (int i = 0; i < 4; ++i) {
    *(u32x4*)(As + (lr + 32 * i) * GP + lc * 8) = ra[i];
    if (SUMSQ) {
      ssq[i] = __builtin_amdgcn_fdot2_f32_bf16(__builtin_bit_cast(bf16v2_t, ra[i].x), __builtin_bit_cast(bf16v2_t, ra[i].x), ssq[i], false);
      ssq[i] = __builtin_amdgcn_fdot2_f32_bf16(__builtin_bit_cast(bf16v2_t, ra[i].y), __builtin_bit_cast(bf16v2_t, ra[i].y), ssq[i], false);
      ssq[i] = __builtin_amdgcn_fdot2_f32_bf16(__builtin_bit_cast(bf16v2_t, ra[i].z), __builtin_bit_cast(bf16v2_t, ra[i].z), ssq[i], false);
      ssq[i] = __builtin_amdgcn_fdot2_f32_bf16(__builtin_bit_cast(bf16v2_t, ra[i].w), __builtin_bit_cast(bf16v2_t, ra[i].w), ssq[i], false);
    }
  }
#pragma unroll
  for (int i = 0; i < NFRAG; ++i) *(u32x4*)(Bs + (lr + 32 * i) * GP + lc * 8) = rb[i];
}

template <int NFRAG>
DI void g_read(bf16x8 (&af)[2][4], bf16x8 (&bfr)[2][NFRAG], const bf16_t* As, const bf16_t* Bs, int wr, int wc, int fr, int fq) {
#pragma unroll
  for (int kk = 0; kk < 2; ++kk) {
#pragma unroll
    for (int mi = 0; mi < 4; ++mi) af[kk][mi] = *(const bf16x8*)(As + (wr * 64 + mi * 16 + fr) * GP + kk * 32 + fq * 8);
#pragma unroll
    for (int ni = 0; ni < NFRAG; ++ni) bfr[kk][ni] = *(const bf16x8*)(Bs + (wc * NFRAG * 16 + ni * 16 + fr) * GP + kk * 32 + fq * 8);
  }
}

template <int NFRAG>
DI void g_mma(f32x4 (&acc)[4][NFRAG], const bf16x8 (&af)[2][4], const bf16x8 (&bfr)[2][NFRAG]) {
#pragma unroll
  for (int kk = 0; kk < 2; ++kk)
#pragma unroll
    for (int mi = 0; mi < 4; ++mi)
#pragma unroll
      for (int ni = 0; ni < NFRAG; ++ni) acc[mi][ni] = MFMA16(af[kk][mi], bfr[kk][ni], acc[mi][ni]);
}

template <int NFRAG, bool SUMSQ, class OPS>
DI void gemm_stream(int ntiles, int lda, int K, const OPS& ops, unsigned char* lds, int rot = 0) {
  bf16_t* As = (bf16_t*)lds;
  bf16_t* Bs = As + 128 * GP;
  const int t = tid_opaque(), lane = t & 63, w = t >> 6, wr = w >> 1, wc = w & 1, fr = lane & 15, fq = lane >> 4;
  const int lc = t & 7, lr = t >> 3;
  const int nk = K >> 6;
  const int G = gridDim.x;
  const int vb = (int)((blockIdx.x + (unsigned)rot) % gridDim.x);
  int lt = vb, lk = 0;
  const bf16_t *cA = nullptr, *cB = nullptr; int cnv = 0;
  if (lt >= ntiles) return;
  { const TileDesc d = ops.tile(lt); cA = d.A + (size_t)lr * lda + lc * 8; cB = d.B + (size_t)lr * K + lc * 8; cnv = d.nvalid; }
  u32x4 ra[4], rb[NFRAG];
#define G_ADVANCE() do { ++lk; if (lk == nk) { lk = 0; lt += G; if (lt < ntiles) { const TileDesc d = ops.tile(lt); cA = d.A + (size_t)lr * lda + lc * 8; cB = d.B + (size_t)lr * K + lc * 8; cnv = d.nvalid; } } } while (0)
  g_issue<NFRAG>(ra, rb, cA, cB, cnv, lda, K, lk * 64, lr);
  G_ADVANCE();
#pragma unroll 1
  for (int tile = vb; tile < ntiles; tile += G) {
    f32x4 acc[4][NFRAG];
    float ssq[4] = {0.f, 0.f, 0.f, 0.f};
#pragma unroll
    for (int mi = 0; mi < 4; ++mi)
#pragma unroll
      for (int ni = 0; ni < NFRAG; ++ni) acc[mi][ni] = (f32x4){0.f, 0.f, 0.f, 0.f};
    __syncthreads();
    g_write<NFRAG, SUMSQ>(ra, rb, ssq, As, Bs, lr, lc);
    g_issue<NFRAG>(ra, rb, cA, cB, cnv, lda, K, lk * 64, lr);
    G_ADVANCE();
    __syncthreads();
#pragma unroll 1
    for (int kt = 0; kt < nk - 1; ++kt) {
      bf16x8 af[2][4], bfr[2][NFRAG];
      g_read<NFRAG>(af, bfr, As, Bs, wr, wc, fr, fq);
      __syncthreads();
      g_write<NFRAG, SUMSQ>(ra, rb, ssq, As, Bs, lr, lc);
      g_issue<NFRAG>(ra, rb, cA, cB, cnv, lda, K, lk * 64, lr);
      G_ADVANCE();
      g_mma<NFRAG>(acc, af, bfr);
      __syncthreads();
    }
    {
      bf16x8 af[2][4], bfr[2][NFRAG];
      g_read<NFRAG>(af, bfr, As, Bs, wr, wc, fr, fq);
      g_mma<NFRAG>(acc, af, bfr);
    }
#undef G_ADVANCE
    constexpr int CP = 32 * NFRAG + 4;
    float* Cs = (float*)lds;
    __syncthreads();
#pragma unroll
    for (int mi = 0; mi < 4; ++mi)
#pragma unroll
      for (int ni = 0; ni < NFRAG; ++ni)
#pragma unroll
        for (int jj = 0; jj < 4; ++jj) Cs[(wr * 64 + mi * 16 + fq * 4 + jj) * CP + wc * NFRAG * 16 + ni * 16 + fr] = acc[mi][ni][jj];
    if (SUMSQ) {
      float* rowstat = (float*)(lds + ROWSTAT_OFF);
#pragma unroll
      for (int i = 0; i < 4; ++i) {
        float sv = ssq[i];
        sv += __shfl_xor(sv, 1); sv += __shfl_xor(sv, 2); sv += __shfl_xor(sv, 4);
        if (lc == 0) rowstat[lr + 32 * i] = rsqrtf(sv / (float)K + EPS);
      }
    }
    __syncthreads();
    ops.epi(tile, lds);
  }
}


template <int NFRAG, class OPS>
DI void gemm_glds(int ntiles, int lda, int K, const OPS& ops, unsigned char* lds, int rot = 0) {
  const int t = tid_opaque(), lane = t & 63, w = t >> 6, wr = w >> 1, wc = w & 1, fr = lane & 15, fq = lane >> 4;
  const int nk = K >> 6;
  const int G = gridDim.x;
  const int vb = (int)((blockIdx.x + (unsigned)rot) % gridDim.x);
  const int srow = t >> 3, skc = (t & 7) ^ ((t >> 3) & 7);
  constexpr int STAGE = 32768, BOFF = 16384;
#pragma unroll 1
  for (int tile = vb; tile < ntiles; tile += G) {
    const TileDesc d = ops.tile(tile);
    const bf16_t* gA = d.A + (size_t)srow * lda + skc * 8;
    const bf16_t* gB = d.B + (size_t)srow * K + skc * 8;
    const int cnv = d.nvalid;
    f32x4 acc[4][NFRAG];
#pragma unroll
    for (int mi = 0; mi < 4; ++mi)
#pragma unroll
      for (int ni = 0; ni < NFRAG; ++ni) acc[mi][ni] = (f32x4){0.f, 0.f, 0.f, 0.f};
    __syncthreads();
#define GLDS_ISSUE(stg, ko) do { \
      _Pragma("unroll") for (int i = 0; i < 4; ++i) \
        __builtin_amdgcn_global_load_lds((const unsigned*)(gA + (size_t)(32 * i) * lda + (ko)), (__attribute__((address_space(3))) unsigned*)(lds + (stg) * STAGE + (i * 256 + t) * 16), 16, 0, 0); \
      _Pragma("unroll") for (int i = 0; i < NFRAG; ++i) { const int ro = (srow + 32 * i < cnv) ? 32 * i : 0; \
        __builtin_amdgcn_global_load_lds((const unsigned*)(gB + (size_t)ro * K + (ko)), (__attribute__((address_space(3))) unsigned*)(lds + (stg) * STAGE + BOFF + (i * 256 + t) * 16), 16, 0, 0); } \
    } while (0)
    GLDS_ISSUE(0, 0);
    asm volatile("s_waitcnt vmcnt(0)" ::: "memory");
    __syncthreads();
#pragma unroll 1
    for (int kt = 0; kt < nk; ++kt) {
      const int sg = kt & 1;
      if (kt + 1 < nk) GLDS_ISSUE(sg ^ 1, (kt + 1) * 64);
      const unsigned char* As = lds + sg * STAGE;
      const unsigned char* Bs = As + BOFF;
#pragma unroll
      for (int kk = 0; kk < 2; ++kk) {
        bf16x8 af[4], bfr[NFRAG];
        const int sw = ((kk * 4 + fq) ^ (fr & 7)) * 16;
#pragma unroll
        for (int mi = 0; mi < 4; ++mi) af[mi] = *(const bf16x8*)(As + (wr * 64 + mi * 16 + fr) * 128 + sw);
#pragma unroll
        for (int ni = 0; ni < NFRAG; ++ni) bfr[ni] = *(const bf16x8*)(Bs + (wc * NFRAG * 16 + ni * 16 + fr) * 128 + sw);
#pragma unroll
        for (int mi = 0; mi < 4; ++mi)
#pragma unroll
          for (int ni = 0; ni < NFRAG; ++ni) acc[mi][ni] = MFMA16(af[mi], bfr[ni], acc[mi][ni]);
      }
      asm volatile("s_waitcnt vmcnt(0)" ::: "memory");
      __syncthreads();
    }
#undef GLDS_ISSUE
    constexpr int CP = 32 * NFRAG + 4;
    float* Cs = (float*)lds;
#pragma unroll
    for (int mi = 0; mi < 4; ++mi)
#pragma unroll
      for (int ni = 0; ni < NFRAG; ++ni)
#pragma unroll
        for (int jj = 0; jj < 4; ++jj) Cs[(wr * 64 + mi * 16 + fq * 4 + jj) * CP + wc * NFRAG * 16 + ni * 16 + fr] = acc[mi][ni][jj];
    __syncthreads();
    ops.epi(tile, lds);
  }
}


template <int NFRAG, class OPS, bool SUMSQ = false, bool LDSEPI = false>
DI void gemm_glds2(int ntiles, int lda, int K, const OPS& ops, unsigned char* lds, int rot = 0) {
  const int t = tid_opaque(), lane = t & 63, w = t >> 6, wr = w >> 1, wc = w & 1, fr = lane & 15, fq = lane >> 4;
  const int nk = K >> 6;
  const int G = gridDim.x;
  const int vb = (int)((blockIdx.x + (unsigned)rot) % gridDim.x);
  const int srow = t >> 3, skc = (t & 7) ^ ((t >> 3) & 7);
  constexpr int STAGE = 32768, BOFF = 16384;
  int tile = vb;
  if (tile >= ntiles) return;
  const bf16_t *gA, *gB; int cnv;
  { const TileDesc d = ops.tile(tile); gA = d.A + (size_t)srow * lda + skc * 8; gB = d.B + (size_t)srow * K + skc * 8; cnv = d.nvalid; }
#define GLDS_ISSUE(stg, ko) do { \
    _Pragma("unroll") for (int i = 0; i < 4; ++i) \
      __builtin_amdgcn_global_load_lds((const unsigned*)(gA + (size_t)(32 * i) * lda + (ko)), (__attribute__((address_space(3))) unsigned*)(lds + (stg) * STAGE + (i * 256 + t) * 16), 16, 0, 0); \
    _Pragma("unroll") for (int i = 0; i < NFRAG; ++i) { const int ro = (srow + 32 * i < cnv) ? 32 * i : 0; \
      __builtin_amdgcn_global_load_lds((const unsigned*)(gB + (size_t)ro * K + (ko)), (__attribute__((address_space(3))) unsigned*)(lds + (stg) * STAGE + BOFF + (i * 256 + t) * 16), 16, 0, 0); } \
  } while (0)
  __syncthreads();
  GLDS_ISSUE(0, 0);
#pragma unroll 1
  for (;;) {
    f32x4 acc[4][NFRAG];
#pragma unroll
    for (int mi = 0; mi < 4; ++mi)
#pragma unroll
      for (int ni = 0; ni < NFRAG; ++ni) acc[mi][ni] = (f32x4){0.f, 0.f, 0.f, 0.f};
    float ssq[4] = {0.f, 0.f, 0.f, 0.f};
    asm volatile("s_waitcnt vmcnt(0)" ::: "memory");
    __syncthreads();
#pragma unroll 1
    for (int kt = 0; kt < nk; ++kt) {
      const int sg = kt & 1;
      const unsigned char* As = lds + sg * STAGE;
      const unsigned char* Bs = As + BOFF;
#pragma unroll
      for (int kk = 0; kk < 2; ++kk) {
        bf16x8 af[4], bfr[NFRAG];
        const int sw = ((kk * 4 + fq) ^ (fr & 7)) * 16;
#pragma unroll
        for (int mi = 0; mi < 4; ++mi) af[mi] = *(const bf16x8*)(As + (wr * 64 + mi * 16 + fr) * 128 + sw);
#pragma unroll
        for (int ni = 0; ni < NFRAG; ++ni) bfr[ni] = *(const bf16x8*)(Bs + (wc * NFRAG * 16 + ni * 16 + fr) * 128 + sw);
        if (SUMSQ) {
#pragma unroll
          for (int mi = 0; mi < 4; ++mi) {
            const u32x4 aw = __builtin_bit_cast(u32x4, af[mi]);
            ssq[mi] = __builtin_amdgcn_fdot2_f32_bf16(__builtin_bit_cast(bf16v2_t, aw.x), __builtin_bit_cast(bf16v2_t, aw.x), ssq[mi], false);
            ssq[mi] = __builtin_amdgcn_fdot2_f32_bf16(__builtin_bit_cast(bf16v2_t, aw.y), __builtin_bit_cast(bf16v2_t, aw.y), ssq[mi], false);
            ssq[mi] = __builtin_amdgcn_fdot2_f32_bf16(__builtin_bit_cast(bf16v2_t, aw.z), __builtin_bit_cast(bf16v2_t, aw.z), ssq[mi], false);
            ssq[mi] = __builtin_amdgcn_fdot2_f32_bf16(__builtin_bit_cast(bf16v2_t, aw.w), __builtin_bit_cast(bf16v2_t, aw.w), ssq[mi], false);
          }
        }
        if (kk == 0 && kt + 1 < nk) GLDS_ISSUE(sg ^ 1, (kt + 1) * 64);
#pragma unroll
        for (int mi = 0; mi < 4; ++mi)
#pragma unroll
          for (int ni = 0; ni < NFRAG; ++ni) acc[mi][ni] = MFMA16(af[mi], bfr[ni], acc[mi][ni]);
      }
      asm volatile("s_waitcnt vmcnt(0)" ::: "memory");
      __syncthreads();
    }
    constexpr int CP = 32 * NFRAG + 4;
    float* Cs = (float*)lds;
#pragma unroll
    for (int mi = 0; mi < 4; ++mi)
#pragma unroll
      for (int ni = 0; ni < NFRAG; ++ni)
#pragma unroll
        for (int jj = 0; jj < 4; ++jj) Cs[(wr * 64 + mi * 16 + fq * 4 + jj) * CP + wc * NFRAG * 16 + ni * 16 + fr] = acc[mi][ni][jj];
    if (SUMSQ) {
      float* rowstat = (float*)(lds + ROWSTAT_OFF);
#pragma unroll
      for (int mi = 0; mi < 4; ++mi) {
        float sv = ssq[mi];
        sv += __shfl_xor(sv, 16); sv += __shfl_xor(sv, 32);
        if (wc == 0 && fq == 0) rowstat[wr * 64 + mi * 16 + fr] = rsqrtf(sv / (float)K + EPS);
      }
    }
    __syncthreads();
    const int cur = tile;
    if (LDSEPI) {
      ops.epi_lds(cur, lds);
      __syncthreads();
      tile += G;
      const bool more = tile < ntiles;
      if (more) {
        const TileDesc d = ops.tile(tile); gA = d.A + (size_t)srow * lda + skc * 8; gB = d.B + (size_t)srow * K + skc * 8; cnv = d.nvalid;
        GLDS_ISSUE(0, 0);
      }
      if (!more) break;
    } else {
      float c[64];
      ops.epi_read(cur, lds, c);
      __syncthreads();
      tile += G;
      const bool more = tile < ntiles;
      if (more) {
        const TileDesc d = ops.tile(tile); gA = d.A + (size_t)srow * lda + skc * 8; gB = d.B + (size_t)srow * K + skc * 8; cnv = d.nvalid;
        GLDS_ISSUE(0, 0);
      }
      ops.epi_write(cur, c);
      if (!more) break;
    }
  }
#undef GLDS_ISSUE
}

struct EvWinOps2 {
  const Params* pp;
  DI void epi_lds(int, unsigned char*) const {}
  DI TileDesc tile(int id) const {
    int mt, nt; xcd_tile(id, 18, 25, 6, mt, nt);
    TileDesc d; d.A = (const bf16_t*)(pp->ws + WS_R1) + (size_t)mt * 128 * D; d.B = (const bf16_t*)(pp->ws + WS_WT + WT_EV_IN) + (size_t)nt * 128 * D; d.nvalid = EVEN_IN - nt * 128;
    return d;
  }
  DI void epi_read(int id, unsigned char* lds, float (&c)[64]) const {
    const int t = tid_opaque();
    const float* Cs = (const float*)lds;
#pragma unroll
    for (int it = 0; it < 8; ++it) {
      const int row = (t >> 4) + 16 * it, ch = t & 15;
      *(f32x4*)(c + it * 8) = *(const f32x4*)(Cs + row * 132 + ch * 8);
      *(f32x4*)(c + it * 8 + 4) = *(const f32x4*)(Cs + row * 132 + ch * 8 + 4);
    }
  }
  DI void epi_write(int id, const float (&c)[64]) const {
    int mt, nt; xcd_tile(id, 18, 25, 6, mt, nt);
    const int m0 = mt * 128, n0 = nt * 128;
    bf16_t* U1 = (bf16_t*)(pp->ws + WS_R2);
    bf16_t* U2 = (bf16_t*)(pp->ws + WS_U2);
    const int t = tid_opaque();
    const int ch = t & 15, col = n0 + ch * 8;
    if (col < EVEN_IN) {
#pragma unroll
      for (int it = 0; it < 8; ++it) {
        const int m = m0 + (t >> 4) + 16 * it;
        bf16_t* dst = (col < U1W) ? U1 + (size_t)m * U1W + col : U2 + (size_t)m * U2W + (col - U1W);
        *(u32x4*)dst = pack8(c + it * 8);
      }
    }
  }
};

struct WoutOps2 {
  const Params* pp; int layer;
  DI void epi_lds(int, unsigned char*) const {}
  DI TileDesc tile(int id) const {
    const bool even = (layer & 1) == 0;
    int mt, nt; xcd_tile(id, (layer == 3) ? 16 : 18, 8, (layer == 3) ? 8 : 6, mt, nt);
    TileDesc d; d.A = (const bf16_t*)(pp->ws + (even ? WS_R2 : WS_OH)) + (size_t)mt * 128 * D;
    d.B = (const bf16_t*)(pp->ws + WS_WT + (even ? WT_EV_OUT : WT_OD_OUT)) + (size_t)nt * 128 * D; d.nvalid = 128;
    return d;
  }
  DI void epi_read(int id, unsigned char* lds, float (&c)[64]) const {
    const int t = tid_opaque();
    const float* Cs = (const float*)lds;
#pragma unroll
    for (int it = 0; it < 16; ++it) {
      const int row = (t >> 5) + 8 * it, c4 = t & 31;
      *(f32x4*)(c + it * 4) = *(const f32x4*)(Cs + row * 132 + c4 * 4);
    }
  }
  DI void epi_write(int id, const float (&c)[64]) const {
    const Params& p = *pp;
    int mt, nt; xcd_tile(id, (layer == 3) ? 16 : 18, 8, (layer == 3) ? 8 : 6, mt, nt);
    const int m0 = mt * 128, n0 = nt * 128;
    const float* MOD = (const float*)(p.ws + WS_MOD);
    float* CX = (float*)(p.ws + WS_CX);
    const int t = tid_opaque();
    const bool lat = m0 < NLAT;
    const int r = lat ? (m0 >> 11) : 8;
    const int n = n0 + (t & 31) * 4;
    const float* xin = (lat ? ((layer == 0 ? p.x : p.out) + (size_t)m0 * D) : ((layer == 0 ? p.ctx : CX) + (size_t)(m0 - NLAT) * D)) + n;
    float* xout = (lat ? (p.out + (size_t)m0 * D) : (CX + (size_t)(m0 - NLAT) * D)) + n;
    const f32x4 g = *(const f32x4*)(MOD + (size_t)(layer * 9 + r) * 3072 + 2048 + n);
#pragma unroll
    for (int half = 0; half < 2; ++half) {
      f32x4 xi[8];
#pragma unroll
      for (int q = 0; q < 8; ++q) xi[q] = *(const f32x4*)(xin + (size_t)((t >> 5) + 8 * (half * 8 + q)) * D);
#pragma unroll
      for (int q = 0; q < 8; ++q) {
        const int it = half * 8 + q;
        f32x4 o; o.x = xi[q].x + g.x * c[it * 4]; o.y = xi[q].y + g.y * c[it * 4 + 1]; o.z = xi[q].z + g.z * c[it * 4 + 2]; o.w = xi[q].w + g.w * c[it * 4 + 3];
        *(f32x4*)(xout + (size_t)((t >> 5) + 8 * it) * D) = o;
      }
    }
  }
};

struct EvWinOps {
  const Params* pp;
  DI TileDesc tile(int id) const {
    int mt, nt; xcd_tile(id, 18, 25, 6, mt, nt);
    TileDesc d; d.A = (const bf16_t*)(pp->ws + WS_R1) + (size_t)mt * 128 * D; d.B = (const bf16_t*)(pp->ws + WS_WT + WT_EV_IN) + (size_t)nt * 128 * D; d.nvalid = EVEN_IN - nt * 128;
    return d;
  }
  DI void epi(int id, unsigned char* lds) const {
    int mt, nt; xcd_tile(id, 18, 25, 6, mt, nt);
    const int m0 = mt * 128, n0 = nt * 128;
    bf16_t* U1 = (bf16_t*)(pp->ws + WS_R2);
    bf16_t* U2 = (bf16_t*)(pp->ws + WS_U2);
    const int t = tid_opaque();
    const float* Cs = (const float*)lds;
    for (int idx = t; idx < 128 * 16; idx += 256) {
      const int row = idx >> 4, ch = idx & 15, col = n0 + ch * 8;
      if (col < EVEN_IN) {
        float v[8];
        *(f32x4*)v = *(const f32x4*)(Cs + row * 132 + ch * 8);
        *(f32x4*)(v + 4) = *(const f32x4*)(Cs + row * 132 + ch * 8 + 4);
        const int m = m0 + row;
        bf16_t* dst = (col < U1W) ? U1 + (size_t)m * U1W + col : U2 + (size_t)m * U2W + (col - U1W);
        *(u32x4*)dst = pack8(v);
      }
    }
  }
};
DI void phase_ev_win(const Params& p, unsigned char* lds) {
  EvWinOps2 ops; ops.pp = &p;
  gemm_glds2<4>(144 * 25, D, D, ops, lds);
}

struct WoutOps {
  const Params* pp; int layer;
  DI TileDesc tile(int id) const {
    const bool even = (layer & 1) == 0;
    int mt, nt; xcd_tile(id, (layer == 3) ? 16 : 18, 8, (layer == 3) ? 8 : 6, mt, nt);
    TileDesc d; d.A = (const bf16_t*)(pp->ws + (even ? WS_R2 : WS_OH)) + (size_t)mt * 128 * D;
    d.B = (const bf16_t*)(pp->ws + WS_WT + (even ? WT_EV_OUT : WT_OD_OUT)) + (size_t)nt * 128 * D; d.nvalid = 128;
    return d;
  }
  DI void epi(int id, unsigned char* lds) const {
    const Params& p = *pp;
    int mt, nt; xcd_tile(id, (layer == 3) ? 16 : 18, 8, (layer == 3) ? 8 : 6, mt, nt);
    const int m0 = mt * 128, n0 = nt * 128;
    const float* MOD = (const float*)(p.ws + WS_MOD);
    float* CX = (float*)(p.ws + WS_CX);
    const int t = tid_opaque();
    const float* Cs = (const float*)lds;
    const bool lat = m0 < NLAT;
    const int r = lat ? (m0 >> 11) : 8;
    const float* gate = MOD + (size_t)(layer * 9 + r) * 3072 + 2048;
    const float* xin = lat ? ((layer == 0 ? p.x : p.out) + (size_t)m0 * D) : ((layer == 0 ? p.ctx : CX) + (size_t)(m0 - NLAT) * D);
    float* xout = lat ? (p.out + (size_t)m0 * D) : (CX + (size_t)(m0 - NLAT) * D);
    for (int idx = t; idx < 128 * 32; idx += 256) {
      const int row = idx >> 5, c4 = idx & 31, n = n0 + c4 * 4;
      const f32x4 a = *(const f32x4*)(Cs + row * 132 + c4 * 4);
      const f32x4 g = *(const f32x4*)(gate + n);
      const f32x4 xi = *(const f32x4*)(xin + (size_t)row * D + n);
      f32x4 o; o.x = xi.x + g.x * a.x; o.y = xi.y + g.y * a.y; o.z = xi.z + g.z * a.z; o.w = xi.w + g.w * a.w;
      *(f32x4*)(xout + (size_t)row * D + n) = o;
    }
  }
};
DI void phase_wout(const Params& p, int layer, unsigned char* lds) {
  WoutOps2 ops; ops.pp = &p; ops.layer = layer;
  gemm_glds2<4>(((layer == 3) ? 128 : 144) * 8, D, D, ops, lds);
}

DI void ev_q_tile(const Params& p, int j, int mt, int head, unsigned char* lds) {
  const bf16_t* U1 = (const bf16_t*)(p.ws + WS_R2);
  const bf16_t* WT = (const bf16_t*)(p.ws + WS_WT + WT_EV_UQ);
  bf16_t* QA = (bf16_t*)(p.ws + WS_R1 + R1_QA);
  const float* RC = (const float*)(p.ws + WS_ROPEC);
  const float* RS = (const float*)(p.ws + WS_ROPES);
  const int t = tid_opaque(), m0 = mt * 128;
  float* Cs = (float*)lds;
  float* rowstat = (float*)(lds + ROWSTAT_OFF);
  float* rowstat2 = (float*)(lds + ROWSTAT2_OFF);
#pragma unroll 1
  for (int it = 0; it < 4; ++it) {
    const int idx = t + 256 * it, row = idx >> 3, l8 = idx & 7;
    float ss = 0.f;
#pragma unroll
    for (int q = 0; q < 3; ++q) { const f32x4 v = *(const f32x4*)(Cs + row * 100 + l8 * 12 + q * 4); ss += v.x * v.x + v.y * v.y + v.z * v.z + v.w * v.w; }
    ss += __shfl_xor(ss, 1); ss += __shfl_xor(ss, 2); ss += __shfl_xor(ss, 4);
    const float rin = rowstat[row];
    const float rstd2 = rsqrtf(ss * rin * rin * (1.f / 96.f) + EPS);
    if (l8 == 0) rowstat2[row] = rin * rstd2;
  }
  __syncthreads();
  const float* qg = p.ev_q_gain + j * 96;
  int b, pos0; tok_bp(m0, b, pos0);
  const bool lat = m0 < NLAT;
  const float QS = 0.10206207261596575f * LOG2E;
  bf16_t* qdst = QA + ((size_t)(b * 8 + head) * KEYS + pos0) * 96;
  {
    const int ch = t & 7;
    const f32x4 g0 = *(const f32x4*)(qg + ch * 8), g1 = *(const f32x4*)(qg + ch * 8 + 4);
    const float gg[8] = {g0.x, g0.y, g0.z, g0.w, g1.x, g1.y, g1.z, g1.w};
#pragma unroll
    for (int it = 0; it < 4; ++it) {
      const int row = (t >> 3) + 32 * it;
      const float f = rowstat2[row] * QS;
      float v[8];
      *(f32x4*)v = *(const f32x4*)(Cs + row * 100 + ch * 8);
      *(f32x4*)(v + 4) = *(const f32x4*)(Cs + row * 100 + ch * 8 + 4);
#pragma unroll
      for (int e = 0; e < 8; ++e) v[e] *= f * gg[e];
      *(u32x4*)(qdst + (size_t)row * 96 + ch * 8) = pack8(v);
    }
  }
  {
    const int rc = t & 3, ch = 8 + rc, pch = ch ^ 1;
    const f32x4 g0 = *(const f32x4*)(qg + ch * 8), g1 = *(const f32x4*)(qg + ch * 8 + 4);
    const f32x4 h0 = *(const f32x4*)(qg + pch * 8), h1 = *(const f32x4*)(qg + pch * 8 + 4);
    const float gg[8] = {g0.x, g0.y, g0.z, g0.w, g1.x, g1.y, g1.z, g1.w};
    const float pg[8] = {h0.x, h0.y, h0.z, h0.w, h1.x, h1.y, h1.z, h1.w};
    f32x4 cs4[2][2], sn4[2][2];
    if (lat) {
#pragma unroll
      for (int it = 0; it < 2; ++it) {
        const int pos = pos0 + (t >> 2) + 64 * it;
        cs4[it][0] = *(const f32x4*)(RC + pos * 16 + (rc >> 1) * 8); cs4[it][1] = *(const f32x4*)(RC + pos * 16 + (rc >> 1) * 8 + 4);
        sn4[it][0] = *(const f32x4*)(RS + pos * 16 + (rc >> 1) * 8); sn4[it][1] = *(const f32x4*)(RS + pos * 16 + (rc >> 1) * 8 + 4);
      }
    }
#pragma unroll
    for (int it = 0; it < 2; ++it) {
      const int row = (t >> 2) + 64 * it;
      const float f = rowstat2[row];
      float v[8], pv[8];
      *(f32x4*)v = *(const f32x4*)(Cs + row * 100 + ch * 8);
      *(f32x4*)(v + 4) = *(const f32x4*)(Cs + row * 100 + ch * 8 + 4);
      *(f32x4*)pv = *(const f32x4*)(Cs + row * 100 + pch * 8);
      *(f32x4*)(pv + 4) = *(const f32x4*)(Cs + row * 100 + pch * 8 + 4);
#pragma unroll
      for (int e = 0; e < 8; ++e) { v[e] *= f * gg[e]; pv[e] *= f * pg[e]; }
      if (lat) {
        const float cs[8] = {cs4[it][0].x, cs4[it][0].y, cs4[it][0].z, cs4[it][0].w, cs4[it][1].x, cs4[it][1].y, cs4[it][1].z, cs4[it][1].w};
        const float sn[8] = {sn4[it][0].x, sn4[it][0].y, sn4[it][0].z, sn4[it][0].w, sn4[it][1].x, sn4[it][1].y, sn4[it][1].z, sn4[it][1].w};
#pragma unroll
        for (int e = 0; e < 8; ++e) v[e] = ((rc & 1) == 0) ? (v[e] * cs[e] - pv[e] * sn[e]) : (v[e] * cs[e] + pv[e] * sn[e]);
      }
#pragma unroll
      for (int e = 0; e < 8; ++e) v[e] *= QS;
      *(u32x4*)(qdst + (size_t)row * 96 + ch * 8) = pack8(v);
    }
  }
}

DI void ev_kv_tile(const Params& p, int j, int mt, int head, unsigned char* lds) {
  const bf16_t* U1 = (const bf16_t*)(p.ws + WS_R2);
  const bf16_t* WT = (const bf16_t*)(p.ws + WS_WT + WT_EV_UKV);
  bf16_t* KA = (bf16_t*)(p.ws + WS_R1 + R1_KA);
  bf16_t* VAT = (bf16_t*)(p.ws + WS_R1 + R1_VAT);
  const float* RC = (const float*)(p.ws + WS_ROPEC);
  const float* RS = (const float*)(p.ws + WS_ROPES);
  const int t = tid_opaque(), m0 = mt * 128;
  float* Cs = (float*)lds;
  float* rowstat = (float*)(lds + ROWSTAT_OFF);
  float* rowstat2 = (float*)(lds + ROWSTAT2_OFF);
  {
    const int l8 = t & 7;
    u32x2 kr[4];
#pragma unroll
    for (int it = 0; it < 4; ++it) kr[it] = *(const u32x2*)(U1 + (size_t)(m0 + (t >> 3) + 32 * it) * U1W + 1024 + l8 * 4);
#pragma unroll
    for (int it = 0; it < 4; ++it) {
      const int row = (t >> 3) + 32 * it;
      const float rin = rowstat[row];
      float ss = 0.f;
#pragma unroll
      for (int q = 0; q < 2; ++q) { const f32x4 v = *(const f32x4*)(Cs + row * 132 + l8 * 8 + q * 4); ss += v.x * v.x + v.y * v.y + v.z * v.z + v.w * v.w; }
      ss *= rin * rin;
      const float k0 = bflo(kr[it].x), k1 = bfhi(kr[it].x), k2 = bflo(kr[it].y), k3 = bfhi(kr[it].y);
      ss += k0 * k0 + k1 * k1 + k2 * k2 + k3 * k3;
      ss += __shfl_xor(ss, 1); ss += __shfl_xor(ss, 2); ss += __shfl_xor(ss, 4);
      if (l8 == 0) rowstat2[row] = rsqrtf(ss * (1.f / 96.f) + EPS);
    }
  }
  __syncthreads();
  const float* kg = p.ev_k_gain + j * 96;
  int b, pos0; tok_bp(m0, b, pos0);
  const bool lat = m0 < NLAT;
  bf16_t* kdst = KA + ((size_t)(b * 8 + head) * KEYS + pos0) * 96;
  {
    const int ch = t & 7;
    const f32x4 g0 = *(const f32x4*)(kg + ch * 8), g1 = *(const f32x4*)(kg + ch * 8 + 4);
    const float gg[8] = {g0.x, g0.y, g0.z, g0.w, g1.x, g1.y, g1.z, g1.w};
#pragma unroll
    for (int it = 0; it < 4; ++it) {
      const int row = (t >> 3) + 32 * it;
      const float f = rowstat[row] * rowstat2[row];
      float v[8];
      *(f32x4*)v = *(const f32x4*)(Cs + row * 132 + ch * 8);
      *(f32x4*)(v + 4) = *(const f32x4*)(Cs + row * 132 + ch * 8 + 4);
#pragma unroll
      for (int e = 0; e < 8; ++e) v[e] *= f * gg[e];
      *(u32x4*)(kdst + (size_t)row * 96 + ch * 8) = pack8(v);
    }
  }
  {
    const int rc = t & 3, prc = rc ^ 1;
    const f32x4 g0 = *(const f32x4*)(kg + 64 + rc * 8), g1 = *(const f32x4*)(kg + 64 + rc * 8 + 4);
    const f32x4 h0 = *(const f32x4*)(kg + 64 + prc * 8), h1 = *(const f32x4*)(kg + 64 + prc * 8 + 4);
    const float gg[8] = {g0.x, g0.y, g0.z, g0.w, g1.x, g1.y, g1.z, g1.w};
    const float pg[8] = {h0.x, h0.y, h0.z, h0.w, h1.x, h1.y, h1.z, h1.w};
    u32x4 own[2], par[2];
    f32x4 cs4[2][2], sn4[2][2];
#pragma unroll
    for (int it = 0; it < 2; ++it) {
      const int row = (t >> 2) + 64 * it;
      const bf16_t* krp = U1 + (size_t)(m0 + row) * U1W + 1024;
      own[it] = *(const u32x4*)(krp + rc * 8);
      par[it] = *(const u32x4*)(krp + prc * 8);
      if (lat) {
        const int pos = pos0 + row;
        cs4[it][0] = *(const f32x4*)(RC + pos * 16 + (rc >> 1) * 8); cs4[it][1] = *(const f32x4*)(RC + pos * 16 + (rc >> 1) * 8 + 4);
        sn4[it][0] = *(const f32x4*)(RS + pos * 16 + (rc >> 1) * 8); sn4[it][1] = *(const f32x4*)(RS + pos * 16 + (rc >> 1) * 8 + 4);
      }
    }
#pragma unroll
    for (int it = 0; it < 2; ++it) {
      const int row = (t >> 2) + 64 * it;
      const float rk = rowstat2[row];
      float v[8], pv[8];
      unpack8(own[it], v);
      unpack8(par[it], pv);
#pragma unroll
      for (int e = 0; e < 8; ++e) { v[e] *= rk * gg[e]; pv[e] *= rk * pg[e]; }
      if (lat) {
        const float cs[8] = {cs4[it][0].x, cs4[it][0].y, cs4[it][0].z, cs4[it][0].w, cs4[it][1].x, cs4[it][1].y, cs4[it][1].z, cs4[it][1].w};
        const float sn[8] = {sn4[it][0].x, sn4[it][0].y, sn4[it][0].z, sn4[it][0].w, sn4[it][1].x, sn4[it][1].y, sn4[it][1].z, sn4[it][1].w};
#pragma unroll
        for (int e = 0; e < 8; ++e) v[e] = ((rc & 1) == 0) ? (v[e] * cs[e] - pv[e] * sn[e]) : (v[e] * cs[e] + pv[e] * sn[e]);
      }
      *(u32x4*)(kdst + (size_t)row * 96 + 64 + rc * 8) = pack8(v);
    }
  }
#pragma unroll
  for (int it = 0; it < 4; ++it) {
    const int idx = t + 256 * it, rg = idx & 15, e = idx >> 4;
    float v[8];
#pragma unroll
    for (int q = 0; q < 8; ++q) v[q] = Cs[(rg * 8 + q) * 132 + 64 + e] * rowstat[rg * 8 + q];
    *(u32x4*)(VAT + ((size_t)(b * 8 + head) * 64 + e) * KEYS + pos0 + rg * 8) = pack8(v);
  }
}

struct EvQOps {
  const Params* pp; int j;
  DI TileDesc tile(int id) const {
    int mt, head; xcd_tile(id, 18, 8, 6, mt, head);
    TileDesc d; d.A = (const bf16_t*)(pp->ws + WS_R2) + (size_t)mt * 128 * U1W; d.B = (const bf16_t*)(pp->ws + WS_WT + WT_EV_UQ) + (size_t)(head * 96) * 768; d.nvalid = 96;
    return d;
  }
  DI void epi(int id, unsigned char* lds) const { int mt, head; xcd_tile(id, 18, 8, 6, mt, head); ev_q_tile(*pp, j, mt, head, lds); }
  DI void epi_lds(int id, unsigned char* lds) const { epi(id, lds); }
  DI void epi_read(int, unsigned char*, float (&)[64]) const {}
  DI void epi_write(int, const float (&)[64]) const {}
};
struct EvKvOps {
  const Params* pp; int j;
  DI TileDesc tile(int id) const {
    int mt, head; xcd_tile(id, 18, 8, 6, mt, head);
    TileDesc d; d.A = (const bf16_t*)(pp->ws + WS_R2) + (size_t)mt * 128 * U1W + 768; d.B = (const bf16_t*)(pp->ws + WS_WT + WT_EV_UKV) + (size_t)(head * 128) * 256; d.nvalid = 128;
    return d;
  }
  DI void epi(int id, unsigned char* lds) const { int mt, head; xcd_tile(id, 18, 8, 6, mt, head); ev_kv_tile(*pp, j, mt, head, lds); }
  DI void epi_lds(int id, unsigned char* lds) const { epi(id, lds); }
  DI void epi_read(int, unsigned char*, float (&)[64]) const {}
  DI void epi_write(int, const float (&)[64]) const {}
};

constexpr int GL_QT = 0, GL_KT = 9216, GL_ATT = 18432, GL_VT = 27648, GL_ST = 46080, GL_RS = 64512, GL_SEG = 72704;

DI float log_sigmoid_f(float x) { return fminf(x, 0.f) - __logf(1.f + __expf(-fabsf(x))); }

template <int DIR>
DI float gla_decay(const float (&gw)[16], float gb, unsigned char* lds, float (&bb)[16]) {
  const int t = tid_opaque(), d = t & 63, qd = t >> 6;
  const float* rs = (const float*)(lds + GL_RS);
  float* seg = (float*)(lds + GL_SEG);
  float ssum = 0.f;
#pragma unroll
  for (int i = 0; i < 16; ++i) {
    const int l = qd * 16 + i;
    float lg = gb;
#pragma unroll
    for (int q = 0; q < 4; ++q) {
      const f32x4 rv = *(const f32x4*)(rs + l * 32 + DIR * 16 + q * 4);
      lg += rv.x * gw[q * 4] + rv.y * gw[q * 4 + 1] + rv.z * gw[q * 4 + 2] + rv.w * gw[q * 4 + 3];
    }
    bb[i] = log_sigmoid_f(lg) * (1.f / 16.f);
    ssum += bb[i];
  }
  __syncthreads();
  seg[qd * 64 + d] = ssum;
  __syncthreads();
  const float s0 = seg[d], s1 = seg[64 + d], s2 = seg[128 + d], s3 = seg[192 + d];
  const float tot = s0 + s1 + s2 + s3;
  if (DIR == 0) {
    float off = (qd > 0 ? s0 : 0.f) + (qd > 1 ? s1 : 0.f) + (qd > 2 ? s2 : 0.f);
#pragma unroll
    for (int i = 0; i < 16; ++i) { off += bb[i]; bb[i] = off; }
  } else {
    float off = (qd < 3 ? s3 : 0.f) + (qd < 2 ? s2 : 0.f) + (qd < 1 ? s1 : 0.f);
#pragma unroll
    for (int i = 15; i >= 0; --i) { off += bb[i]; bb[i] = off; }
  }
  return tot;
}

DI int gla_base_row(int b, int c) { return (c < 32) ? b * SEQ + c * 64 : NLAT + b * CTXL + (c - 32) * 64; }
DI int gla_scan_pos(int c, int dir) { return dir == 0 ? ((c >= 32) ? c - 32 : 4 + c) : ((c >= 32) ? 3 - (c - 32) : 4 + (31 - c)); }

struct GlaRaw { u32x4 v[4]; u32x4 r; };
DI void gla_load_raw(GlaRaw& g, const bf16_t* U2, int base_m, int h) {
  const int t = tid_opaque();
  const bf16_t* vrow = U2 + (size_t)(base_m + (t & 63)) * U2W + U2_VB + h * 128 + (t >> 6) * 32;
#pragma unroll
  for (int i = 0; i < 4; ++i) g.v[i] = *(const u32x4*)(vrow + 8 * i);
  g.r = *(const u32x4*)(U2 + (size_t)(base_m + (t >> 2)) * U2W + U2_GLR + (t & 3) * 8);
}
DI void gla_stage_raw(const GlaRaw& g, unsigned char* lds) {
  const int t = tid_opaque();
  float* rs = (float*)(lds + GL_RS);
  bf16_t* vT = (bf16_t*)(lds + GL_VT);
  {
    const int l = t >> 2, q = t & 3;
    float v[8];
    unpack8(g.r, v);
    *(f32x4*)(rs + l * 32 + q * 8) = (f32x4){v[0], v[1], v[2], v[3]};
    *(f32x4*)(rs + l * 32 + q * 8 + 4) = (f32x4){v[4], v[5], v[6], v[7]};
  }
  {
    const int l = t & 63, e0 = (t >> 6) * 32;
#pragma unroll
    for (int i = 0; i < 4; ++i) {
      const unsigned w4[4] = {g.v[i].x, g.v[i].y, g.v[i].z, g.v[i].w};
#pragma unroll
      for (int q = 0; q < 4; ++q) {
        vT[(e0 + 8 * i + 2 * q) * 72 + l] = (bf16_t)(w4[q] & 0xffffu);
        vT[(e0 + 8 * i + 2 * q + 1) * 72 + l] = (bf16_t)(w4[q] >> 16);
      }
    }
  }
}
DI void gla_load_gate(const Params& p, int j, int h, int dir, int d, float (&gw)[16], float& gb) {
  const float* GW = p.ev_gate_w + ((size_t)(j * 2 + dir) * 16) * 256 + h * 64 + d;
#pragma unroll
  for (int r = 0; r < 16; ++r) gw[r] = GW[r * 256];
  gb = p.ev_gate_b[(j * 2 + dir) * 256 + h * 64 + d];
}

DI void gla_g1_item(const Params& p, int j, int item, unsigned char* lds) {
  const int b = item / (4 * NCHUNK), h = (item / NCHUNK) & 3, c = item % NCHUNK;
  const bf16_t* U2 = (const bf16_t*)(p.ws + WS_U2);
  bf16_t* KVST = (bf16_t*)(p.ws + WS_KVST);
  float* DEC = (float*)(p.ws + WS_DEC);
  const int t = tid_opaque(), d = t & 63, qd = t >> 6, lane = t & 63, w = t >> 6, r = lane & 31, hh = lane >> 5;
  const int base_m = gla_base_row(b, c);
  GlaRaw raw; gla_load_raw(raw, U2, base_m, h);
  bf16_t k16[16];
#pragma unroll
  for (int i = 0; i < 16; ++i) k16[i] = U2[(size_t)(base_m + qd * 16 + i) * U2W + U2_KB + h * 64 + d];
  float gw0[16], gw1[16], gb0, gb1;
  gla_load_gate(p, j, h, 0, d, gw0, gb0);
  gla_load_gate(p, j, h, 1, d, gw1, gb1);
  __syncthreads();
  gla_stage_raw(raw, lds);
  __syncthreads();
  const float* rs = (const float*)(lds + GL_RS);
  float* seg0 = (float*)(lds + GL_SEG);
  float* seg1 = (float*)(lds + GL_ATT);
  float b0[16], b1[16];
  float sum0 = 0.f, sum1 = 0.f;
#pragma unroll
  for (int i = 0; i < 16; ++i) {
    const int l = qd * 16 + i;
    float l0 = gb0, l1 = gb1;
#pragma unroll
    for (int q = 0; q < 4; ++q) {
      const f32x4 r0 = *(const f32x4*)(rs + l * 32 + q * 4), r1 = *(const f32x4*)(rs + l * 32 + 16 + q * 4);
      l0 += r0.x * gw0[q * 4] + r0.y * gw0[q * 4 + 1] + r0.z * gw0[q * 4 + 2] + r0.w * gw0[q * 4 + 3];
      l1 += r1.x * gw1[q * 4] + r1.y * gw1[q * 4 + 1] + r1.z * gw1[q * 4 + 2] + r1.w * gw1[q * 4 + 3];
    }
    b0[i] = log_sigmoid_f(l0) * (1.f / 16.f); sum0 += b0[i];
    b1[i] = log_sigmoid_f(l1) * (1.f / 16.f); sum1 += b1[i];
  }
  seg0[qd * 64 + d] = sum0;
  seg1[qd * 64 + d] = sum1;
  __syncthreads();
  float tot0, tot1;
  {
    const float s0 = seg0[d], s1 = seg0[64 + d], s2 = seg0[128 + d], s3 = seg0[192 + d];
    tot0 = s0 + s1 + s2 + s3;
    float off = (qd > 0 ? s0 : 0.f) + (qd > 1 ? s1 : 0.f) + (qd > 2 ? s2 : 0.f);
#pragma unroll
    for (int i = 0; i < 16; ++i) { off += b0[i]; b0[i] = off; }
  }
  {
    const float s0 = seg1[d], s1 = seg1[64 + d], s2 = seg1[128 + d], s3 = seg1[192 + d];
    tot1 = s0 + s1 + s2 + s3;
    float off = (qd < 3 ? s3 : 0.f) + (qd < 2 ? s2 : 0.f) + (qd < 1 ? s1 : 0.f);
#pragma unroll
    for (int i = 15; i >= 0; --i) { off += b1[i]; b1[i] = off; }
  }
  bf16_t* kdT0 = (bf16_t*)(lds + GL_QT);
  bf16_t* kdT1 = (bf16_t*)(lds + GL_KT);
  const bf16_t* vT = (const bf16_t*)(lds + GL_VT);
#pragma unroll
  for (int i = 0; i < 16; ++i) {
    const float kv = bf2f(k16[i]);
    kdT0[d * 72 + qd * 16 + i] = f2bf(kv * __expf(tot0 - b0[i]));
    kdT1[d * 72 + qd * 16 + i] = f2bf(kv * __expf(tot1 - b1[i]));
  }
  const int chain0 = (b * 4 + h) * 2, sp0 = gla_scan_pos(c, 0), sp1 = gla_scan_pos(c, 1);
  if (qd == 0) DEC[(size_t)(chain0 * NCHUNK + sp0) * 64 + d] = __expf(tot0);
  if (qd == 1) DEC[(size_t)((chain0 + 1) * NCHUNK + sp1) * 64 + d] = __expf(tot1);
  __syncthreads();
  f32x16 acc[2][2];
#pragma unroll
  for (int dir = 0; dir < 2; ++dir)
#pragma unroll
    for (int x = 0; x < 2; ++x)
#pragma unroll
      for (int i = 0; i < 16; ++i) acc[dir][x][i] = 0.f;
#pragma unroll
  for (int s4 = 0; s4 < 4; ++s4) {
    const bf16x8 bq = *(const bf16x8*)(vT + (32 * w + r) * 72 + 16 * s4 + 8 * hh);
#pragma unroll
    for (int x = 0; x < 2; ++x) {
      const bf16x8 a0 = *(const bf16x8*)(kdT0 + (32 * x + r) * 72 + 16 * s4 + 8 * hh);
      const bf16x8 a1 = *(const bf16x8*)(kdT1 + (32 * x + r) * 72 + 16 * s4 + 8 * hh);
      acc[0][x] = MFMA32(a0, bq, acc[0][x]);
      acc[1][x] = MFMA32(a1, bq, acc[1][x]);
    }
  }
#pragma unroll
  for (int dir = 0; dir < 2; ++dir) {
    bf16_t* dst = KVST + (size_t)((chain0 + dir) * NCHUNK + (dir == 0 ? sp0 : sp1)) * 8192 + (32 * w + r) * 64;
#pragma unroll
    for (int x = 0; x < 2; ++x)
#pragma unroll
      for (int g = 0; g < 4; ++g) {
        u32x2 o; o.x = pk2(acc[dir][x][4 * g], acc[dir][x][4 * g + 1]); o.y = pk2(acc[dir][x][4 * g + 2], acc[dir][x][4 * g + 3]);
        *(u32x2*)(dst + 32 * x + 8 * g + 4 * hh) = o;
      }
  }
}

DI void gla_scan_item(const Params& p, int item) {
  bf16_t* KVST = (bf16_t*)(p.ws + WS_KVST);
  const float* DEC = (const float*)(p.ws + WS_DEC);
  const int idx = item * 256 + tid_opaque();
  const int chain = idx >> 11, off = (idx & 2047) * 4, d = off & 63;
  float S[4] = {0.f, 0.f, 0.f, 0.f};
#pragma unroll 1
  for (int sp0 = 0; sp0 < NCHUNK; sp0 += 6) {
    u32x2 kv[6]; f32x4 dc[6];
#pragma unroll
    for (int q = 0; q < 6; ++q) {
      kv[q] = *(const u32x2*)(KVST + (size_t)(chain * NCHUNK + sp0 + q) * 8192 + off);
      dc[q] = *(const f32x4*)(DEC + (size_t)(chain * NCHUNK + sp0 + q) * 64 + d);
    }
#pragma unroll
    for (int q = 0; q < 6; ++q) {
      u32x2 o; o.x = pk2(S[0], S[1]); o.y = pk2(S[2], S[3]);
      *(u32x2*)(KVST + (size_t)(chain * NCHUNK + sp0 + q) * 8192 + off) = o;
      S[0] = S[0] * dc[q].x + bflo(kv[q].x); S[1] = S[1] * dc[q].y + bfhi(kv[q].x); S[2] = S[2] * dc[q].z + bflo(kv[q].y); S[3] = S[3] * dc[q].w + bfhi(kv[q].y);
    }
  }
}

template <int DIR>
DI void gla_g3_dir(const float (&gw)[16], float gb, const float (&qreg)[16], const float (&kreg)[16], f32x16 (&o)[2], unsigned char* lds) {
  const int t = tid_opaque(), d = t & 63, qd = t >> 6, lane = t & 63, w = t >> 6, r = lane & 31, hh = lane >> 5;
  bf16_t* qt = (bf16_t*)(lds + GL_QT);
  bf16_t* kt = (bf16_t*)(lds + GL_KT);
  bf16_t* att = (bf16_t*)(lds + GL_ATT);
  const bf16_t* vT = (const bf16_t*)(lds + GL_VT);
  const bf16_t* ST = (const bf16_t*)(lds + GL_ST);
  const int lb = w >> 1, eb0 = 2 * (w & 1);
  float bb[16];
  (void)gla_decay<DIR>(gw, gb, lds, bb);
#pragma unroll
  for (int i = 0; i < 16; ++i) {
    const int l = qd * 16 + i;
    qt[l * 72 + d] = f2bf(qreg[i] * __expf(bb[i]));
    kt[l * 72 + d] = f2bf(kreg[i] * __expf(-bb[i]));
  }
  __syncthreads();
  {
    const int mb = w & 1;
    f32x16 a;
#pragma unroll
    for (int i = 0; i < 16; ++i) a[i] = 0.f;
#pragma unroll
    for (int s = 0; s < 4; ++s) {
      const bf16x8 fa = *(const bf16x8*)(qt + (32 * lb + r) * 72 + 16 * s + 8 * hh);
      const bf16x8 fb = *(const bf16x8*)(kt + (32 * mb + r) * 72 + 16 * s + 8 * hh);
      a = MFMA32(fa, fb, a);
    }
    const int mcol = 32 * mb + r;
#pragma unroll
    for (int i = 0; i < 16; ++i) {
      const int l = 32 * lb + crow(i, hh);
      const bool keep = (DIR == 0) ? (mcol <= l) : (mcol >= l);
      att[l * 72 + mcol] = f2bf(keep ? a[i] : 0.f);
    }
  }
  __syncthreads();
#pragma unroll
  for (int s = 0; s < 4; ++s) {
    const bf16x8 a1 = *(const bf16x8*)(att + (32 * lb + r) * 72 + 16 * s + 8 * hh);
    const bf16x8 a2 = *(const bf16x8*)(qt + (32 * lb + r) * 72 + 16 * s + 8 * hh);
#pragma unroll
    for (int x = 0; x < 2; ++x) {
      const bf16x8 b1 = *(const bf16x8*)(vT + (32 * (eb0 + x) + r) * 72 + 16 * s + 8 * hh);
      const bf16x8 b2 = *(const bf16x8*)(ST + (32 * (eb0 + x) + r) * 72 + 16 * s + 8 * hh);
      o[x] = MFMA32(a1, b1, o[x]);
      o[x] = MFMA32(a2, b2, o[x]);
    }
  }
  __syncthreads();
}

DI void gla_g3_item(const Params& p, int j, int item, unsigned char* lds) {
  const int b = item / (4 * NCHUNK), h = (item / NCHUNK) & 3, c = item % NCHUNK;
  const bf16_t* U2 = (const bf16_t*)(p.ws + WS_U2);
  const bf16_t* KVST = (const bf16_t*)(p.ws + WS_KVST);
  bf16_t* MIX = (bf16_t*)(p.ws + WS_R2);
  const int t = tid_opaque(), d = t & 63, qd = t >> 6, lane = t & 63, w = t >> 6, r = lane & 31, hh = lane >> 5;
  const int base_m = gla_base_row(b, c);
  const int chain0 = (b * 4 + h) * 2;
  GlaRaw raw; gla_load_raw(raw, U2, base_m, h);
  bf16_t k16[16], q16[16];
#pragma unroll
  for (int i = 0; i < 16; ++i) {
    const bf16_t* row = U2 + (size_t)(base_m + qd * 16 + i) * U2W + h * 64 + d;
    k16[i] = row[U2_KB]; q16[i] = row[U2_QB];
  }
  float gw0[16], gw1[16], gb0, gb1;
  gla_load_gate(p, j, h, 0, d, gw0, gb0);
  gla_load_gate(p, j, h, 1, d, gw1, gb1);
  u32x4 st[4];
  {
    const bf16_t* src = KVST + (size_t)(chain0 * NCHUNK + gla_scan_pos(c, 0)) * 8192;
#pragma unroll
    for (int q = 0; q < 4; ++q) st[q] = *(const u32x4*)(src + (size_t)(t + 256 * q) * 8);
  }
  __syncthreads();
  gla_stage_raw(raw, lds);
  bf16_t* STl = (bf16_t*)(lds + GL_ST);
#pragma unroll
  for (int q = 0; q < 4; ++q) { const int ci = t + 256 * q; *(u32x4*)(STl + (ci >> 3) * 72 + (ci & 7) * 8) = st[q]; }
  {
    const bf16_t* src = KVST + (size_t)((chain0 + 1) * NCHUNK + gla_scan_pos(c, 1)) * 8192;
#pragma unroll
    for (int q = 0; q < 4; ++q) st[q] = *(const u32x4*)(src + (size_t)(t + 256 * q) * 8);
  }
  float kreg[16], qreg[16];
#pragma unroll
  for (int i = 0; i < 16; ++i) { kreg[i] = bf2f(k16[i]); qreg[i] = bf2f(q16[i]) * 0.125f; }
  __syncthreads();
  const int lb = w >> 1, eb0 = 2 * (w & 1);
  f32x16 o[2];
#pragma unroll
  for (int x = 0; x < 2; ++x)
#pragma unroll
    for (int i = 0; i < 16; ++i) o[x][i] = 0.f;
  gla_g3_dir<0>(gw0, gb0, qreg, kreg, o, lds);
#pragma unroll
  for (int q = 0; q < 4; ++q) { const int ci = t + 256 * q; *(u32x4*)(STl + (ci >> 3) * 72 + (ci & 7) * 8) = st[q]; }
  const int erow = t >> 2, epart = t & 3;
  const int em = base_m + erow;
  u32x4 zb[4];
  {
    const bf16_t* zp = U2 + (size_t)em * U2W + U2_ZB + h * 128 + epart * 32;
#pragma unroll
    for (int q = 0; q < 4; ++q) zb[q] = *(const u32x4*)(zp + q * 8);
  }
  gla_g3_dir<1>(gw1, gb1, qreg, kreg, o, lds);
  float* ob = (float*)lds;
#pragma unroll
  for (int x = 0; x < 2; ++x)
#pragma unroll
    for (int i = 0; i < 16; ++i) ob[(32 * lb + crow(i, hh)) * 132 + 32 * (eb0 + x) + r] = o[x][i];
  __syncthreads();
  {
    float v[32];
    float ss = 0.f;
#pragma unroll
    for (int q = 0; q < 8; ++q) { *(f32x4*)(v + 4 * q) = *(const f32x4*)(ob + erow * 132 + epart * 32 + q * 4); }
#pragma unroll
    for (int e = 0; e < 32; ++e) ss += v[e] * v[e];
    ss += __shfl_xor(ss, 1); ss += __shfl_xor(ss, 2);
    const float rstd = rsqrtf(ss * (1.f / 128.f) + EPS);
    const float* gn = p.ev_gla_norm + j * 512 + h * 128 + epart * 32;
    bf16_t* dst = MIX + (size_t)em * D + 512 + h * 128 + epart * 32;
#pragma unroll
    for (int q = 0; q < 4; ++q) {
      float z[8], ov[8];
      unpack8(zb[q], z);
#pragma unroll
      for (int e = 0; e < 8; ++e) ov[e] = v[q * 8 + e] * rstd * gn[q * 8 + e] * silu_f(z[e]);
      *(u32x4*)(dst + q * 8) = pack8(ov);
    }
  }
}

template <int DQK, int MODE>
DI void attn_tile(const bf16_t* Ks, const bf16_t* Vs, const bf16x8 (&qf)[DQK / 16], f32x16 (&o)[2], float& mx, float& lsum,
                  int r, int hh, const float* rpbs, int ridx, int qc) {
  constexpr int KP = DQK + 8, VP = 72;
  f32x16 s[2];
#pragma unroll
  for (int kb = 0; kb < 2; ++kb) {
#pragma unroll
    for (int i = 0; i < 16; ++i) s[kb][i] = 0.f;
#pragma unroll
    for (int jj = 0; jj < DQK / 16; ++jj) {
      const bf16x8 a = *(const bf16x8*)(Ks + (32 * kb + r) * KP + 16 * jj + 8 * hh);
      s[kb] = MFMA32(a, qf[jj], s[kb]);
    }
  }
  if (MODE == 1) {
    const int cs = min(max(qc - 8, 0), 48);
    const int u = 4 * hh - cs;
    const float* bp = rpbs + (ridx * 31 + 4 * hh - qc + 15);
#pragma unroll
    for (int kb = 0; kb < 2; ++kb)
#pragma unroll
      for (int i = 0; i < 16; ++i) {
        const int c = 32 * kb + (i & 3) + 8 * (i >> 2);
        const bool valid = (unsigned)(u + c) < 16u;
        s[kb][i] = valid ? (s[kb][i] + bp[c]) : -INFINITY;
      }
  }
  float tmax = s[0][0];
#pragma unroll
  for (int kb = 0; kb < 2; ++kb)
#pragma unroll
    for (int i = 0; i < 16; ++i) tmax = fmaxf(tmax, s[kb][i]);
  tmax = fmaxf(tmax, __shfl_xor(tmax, 32));
  if (__builtin_amdgcn_ballot_w64(tmax > mx) != 0ull) {
    const float mnew = fmaxf(mx, tmax);
    const float alpha = exp2_fast(mx - mnew);
    mx = mnew;
    lsum *= alpha;
#pragma unroll
    for (int x = 0; x < 2; ++x)
#pragma unroll
      for (int i = 0; i < 16; ++i) o[x][i] *= alpha;
  }
  float psum = 0.f;
#pragma unroll
  for (int kb = 0; kb < 2; ++kb)
#pragma unroll
    for (int i = 0; i < 16; ++i) { s[kb][i] = exp2_fast(s[kb][i] - mx); psum += s[kb][i]; }
  lsum += psum;
#pragma unroll
  for (int kb = 0; kb < 2; ++kb)
#pragma unroll
    for (int sx = 0; sx < 2; ++sx) {
      u32x4 pk;
      pk.x = pk2(s[kb][8 * sx + 0], s[kb][8 * sx + 1]); pk.y = pk2(s[kb][8 * sx + 2], s[kb][8 * sx + 3]);
      pk.z = pk2(s[kb][8 * sx + 4], s[kb][8 * sx + 5]); pk.w = pk2(s[kb][8 * sx + 6], s[kb][8 * sx + 7]);
      const bf16x8 pf = __builtin_bit_cast(bf16x8, pk);
#pragma unroll
      for (int eb = 0; eb < 2; ++eb) {
        const bf16_t* vp = Vs + (32 * eb + r) * VP + 32 * kb + 16 * sx + 4 * hh;
        const s16x4 lo = *(const s16x4*)vp, hi = *(const s16x4*)(vp + 8);
        const bf16x8 vf = __builtin_shufflevector(lo, hi, 0, 1, 2, 3, 4, 5, 6, 7);
        o[eb] = MFMA32(vf, pf, o[eb]);
      }
    }
}

template <int DQK>
DI void attn_load_tile(const bf16_t* kg, const bf16_t* vg, u32x4 (&rk)[DQK / 32], u32x4 (&rv)[2]) {
  const int t = tid_opaque();
#pragma unroll
  for (int i = 0; i < DQK / 32; ++i) rk[i] = *(const u32x4*)(kg + (size_t)(t + 256 * i) * 8);
#pragma unroll
  for (int i = 0; i < 2; ++i) { const int ci = t + 256 * i, e = ci >> 3, cc = ci & 7; rv[i] = *(const u32x4*)(vg + (size_t)e * KEYS + cc * 8); }
}
template <int DQK>
DI void attn_store_tile(bf16_t* Ks, bf16_t* Vs, const u32x4 (&rk)[DQK / 32], const u32x4 (&rv)[2]) {
  constexpr int KP = DQK + 8, CPR = DQK / 8;
  const int t = tid_opaque();
#pragma unroll
  for (int i = 0; i < DQK / 32; ++i) { const int ci = t + 256 * i, row = ci / CPR, cc = ci % CPR; *(u32x4*)(Ks + row * KP + cc * 8) = rk[i]; }
#pragma unroll
  for (int i = 0; i < 2; ++i) { const int ci = t + 256 * i, e = ci >> 3, cc = ci & 7; *(u32x4*)(Vs + e * 72 + cc * 8) = rv[i]; }
}

constexpr int AT_KS = 0, AT_VS = 13312, AT_BUF = 22528  , AT_RPB = 45056, AT_QS = 47104;

DI void attn_write_out(const f32x16 (&o)[2], float lsum, const bf16_t* zrow, bf16_t* orow, int hh) {
  const float ltot = lsum + __shfl_xor(lsum, 32);
  const float inv = 1.f / ltot;
#pragma unroll
  for (int eb = 0; eb < 2; ++eb)
#pragma unroll
    for (int g = 0; g < 4; ++g) {
      const int e = 32 * eb + 8 * g + 4 * hh;
      const u32x2 zz = *(const u32x2*)(zrow + e);
      const float v0 = o[eb][4 * g + 0] * inv * silu_f(bflo(zz.x)), v1 = o[eb][4 * g + 1] * inv * silu_f(bfhi(zz.x));
      const float v2 = o[eb][4 * g + 2] * inv * silu_f(bflo(zz.y)), v3 = o[eb][4 * g + 3] * inv * silu_f(bfhi(zz.y));
      u32x2 ov; ov.x = pk2(v0, v1); ov.y = pk2(v2, v3);
      *(u32x2*)(orow + e) = ov;
    }
}

template <int DQK, int NH>
DI void attn_dense_item(const bf16_t* Q, const bf16_t* K, const bf16_t* VT, const bf16_t* Z, int zstride, bf16_t* MIX,
                        int b, int head, int qp0, int k_lo, int ntiles, unsigned char* lds) {
  const int t = tid_opaque(), lane = t & 63, w = t >> 6, r = lane & 31, hh = lane >> 5;
  bf16_t* Ks = (bf16_t*)(lds + AT_KS);
  bf16_t* Vs = (bf16_t*)(lds + AT_VS);
  const size_t bh = (size_t)(b * NH + head);
  const int qpos = qp0 + 32 * w + r;
  bf16x8 qf[DQK / 16];
#pragma unroll
  for (int jj = 0; jj < DQK / 16; ++jj) qf[jj] = *(const bf16x8*)(Q + (bh * KEYS + qpos) * DQK + 16 * jj + 8 * hh);
  f32x16 o[2];
#pragma unroll
  for (int x = 0; x < 2; ++x)
#pragma unroll
    for (int i = 0; i < 16; ++i) o[x][i] = 0.f;
  float mx = -1e30f, lsum = 0.f;
  const bf16_t* kbase = K + (bh * KEYS + k_lo) * DQK;
  const bf16_t* vbase = VT + bh * 64 * KEYS + k_lo;
  u32x4 rk[DQK / 32], rv[2];
  attn_load_tile<DQK>(kbase, vbase, rk, rv);
  for (int tt = 0; tt < ntiles; ++tt) {
    __syncthreads();
    attn_store_tile<DQK>(Ks, Vs, rk, rv);
    __syncthreads();
    if (tt + 1 < ntiles) attn_load_tile<DQK>(kbase + (size_t)(tt + 1) * 64 * DQK, vbase + (tt + 1) * 64, rk, rv);
    attn_tile<DQK, 0>(Ks, Vs, qf, o, mx, lsum, r, hh, nullptr, 0, 0);
  }
  const int m = (qpos < SEQ) ? b * SEQ + qpos : NLAT + b * CTXL + (qpos - SEQ);
  attn_write_out(o, lsum, Z + (size_t)m * zstride + head * 64, MIX + (size_t)m * D + head * 64, hh);
}


template <int DQK, int MODE, bool PARK>
DI void attn_tile2(const bf16_t* Ks, const bf16_t* Vs, const bf16x8 (&qfA)[DQK / 16], const bf16x8 (&qfB)[DQK / 16], const bf16_t* QsB, f32x16 (&o)[2][2], float (&mx)[2], float (&lsum)[2], int r, int hh,
                const float* rpbs, int ridx, int qcA) {
  constexpr int KP = DQK + 8, VP = 72;
  f32x16 s[2][2];
#pragma unroll
  for (int kb = 0; kb < 2; ++kb) {
#pragma unroll
    for (int g = 0; g < 2; ++g)
#pragma unroll
      for (int i = 0; i < 16; ++i) s[g][kb][i] = 0.f;
#pragma unroll
    for (int jj = 0; jj < DQK / 16; ++jj) {
      const bf16x8 a = *(const bf16x8*)(Ks + (32 * kb + r) * KP + 16 * jj + 8 * hh);
      const bf16x8 qb = PARK ? *(const bf16x8*)(QsB + 16 * jj) : qfB[jj];
      s[0][kb] = MFMA32(a, qfA[jj], s[0][kb]);
      s[1][kb] = MFMA32(a, qb, s[1][kb]);
    }
  }
#pragma unroll
  for (int g = 0; g < 2; ++g) {
    if (MODE == 1) {
      const int qc = qcA + 32 * g;
      const int cs = min(max(qc - 8, 0), 48);
      const int u = 4 * hh - cs;
      const float* bp = rpbs + (ridx * 31 + 4 * hh - qc + 15);
#pragma unroll
      for (int kb = 0; kb < 2; ++kb)
#pragma unroll
        for (int i = 0; i < 16; ++i) {
          const int c = 32 * kb + (i & 3) + 8 * (i >> 2);
          const bool valid = (unsigned)(u + c) < 16u;
          s[g][kb][i] = valid ? (s[g][kb][i] + bp[c]) : -INFINITY;
          if ((i & 3) == 3) __builtin_amdgcn_sched_barrier(0);
        }
    }
    float tmax = s[g][0][0];
#pragma unroll
    for (int kb = 0; kb < 2; ++kb)
#pragma unroll
      for (int i = 0; i < 16; ++i) tmax = fmaxf(tmax, s[g][kb][i]);
    tmax = fmaxf(tmax, __shfl_xor(tmax, 32));
    if (__builtin_amdgcn_ballot_w64(tmax > mx[g]) != 0ull) {
      const float mnew = fmaxf(mx[g], tmax);
      const float alpha = exp2_fast(mx[g] - mnew);
      mx[g] = mnew;
      lsum[g] *= alpha;
#pragma unroll
      for (int x = 0; x < 2; ++x)
#pragma unroll
        for (int i = 0; i < 16; ++i) o[g][x][i] *= alpha;
    }
    float psum = 0.f;
#pragma unroll
    for (int kb = 0; kb < 2; ++kb)
#pragma unroll
      for (int i = 0; i < 16; ++i) { s[g][kb][i] = exp2_fast(s[g][kb][i] - mx[g]); psum += s[g][kb][i]; }
    lsum[g] += psum;
#pragma unroll
    for (int kb = 0; kb < 2; ++kb)
#pragma unroll
      for (int sx = 0; sx < 2; ++sx) {
        u32x4 pk;
        pk.x = pk2(s[g][kb][8 * sx + 0], s[g][kb][8 * sx + 1]); pk.y = pk2(s[g][kb][8 * sx + 2], s[g][kb][8 * sx + 3]);
        pk.z = pk2(s[g][kb][8 * sx + 4], s[g][kb][8 * sx + 5]); pk.w = pk2(s[g][kb][8 * sx + 6], s[g][kb][8 * sx + 7]);
        const bf16x8 pf = __builtin_bit_cast(bf16x8, pk);
#pragma unroll
        for (int eb = 0; eb < 2; ++eb) {
          const bf16_t* vp = Vs + (32 * eb + r) * VP + 32 * kb + 16 * sx + 4 * hh;
          const s16x4 lo = *(const s16x4*)vp, hi = *(const s16x4*)(vp + 8);
          const bf16x8 vf = __builtin_shufflevector(lo, hi, 0, 1, 2, 3, 4, 5, 6, 7);
          o[g][eb] = MFMA32(vf, pf, o[g][eb]);
        }
      }
  }
}

template <int DQK, int NH>
DI void attn_dense_item2(const bf16_t* Q, const bf16_t* K, const bf16_t* VT, const bf16_t* Z, int zstride, bf16_t* MIX,
                         int b, int head, int qp0, int k_lo, int ntiles, unsigned char* lds) {
  const int t = tid_opaque(), lane = t & 63, w = t >> 6, r = lane & 31, hh = lane >> 5;
  bf16_t* Ks = (bf16_t*)(lds + AT_KS);
  bf16_t* Vs = (bf16_t*)(lds + AT_VS);
  const size_t bh = (size_t)(b * NH + head);
  const int qpos0 = qp0 + 64 * w + r;
  bf16x8 qfA[DQK / 16];
  bf16_t* QsB = (bf16_t*)(lds + AT_QS) + (32 * w + r) * (DQK + 8) + 8 * hh;
  __syncthreads();
#pragma unroll
  for (int jj = 0; jj < DQK / 16; ++jj) {
    qfA[jj] = *(const bf16x8*)(Q + (bh * KEYS + qpos0) * DQK + 16 * jj + 8 * hh);
    *(bf16x8*)(QsB + 16 * jj) = *(const bf16x8*)(Q + (bh * KEYS + qpos0 + 32) * DQK + 16 * jj + 8 * hh);
  }
  f32x16 o[2][2];
#pragma unroll
  for (int g = 0; g < 2; ++g)
#pragma unroll
    for (int x = 0; x < 2; ++x)
#pragma unroll
      for (int i = 0; i < 16; ++i) o[g][x][i] = 0.f;
  float mx[2] = {-1e30f, -1e30f}, lsum[2] = {0.f, 0.f};
  const bf16_t* kbase = K + (bh * KEYS + k_lo) * DQK;
  const bf16_t* vbase = VT + bh * 64 * KEYS + k_lo;
  u32x4 rk[DQK / 32], rv[2];
  attn_load_tile<DQK>(kbase, vbase, rk, rv);
  attn_store_tile<DQK>(Ks, Vs, rk, rv);
  if (ntiles > 1) attn_load_tile<DQK>(kbase + (size_t)64 * DQK, vbase + 64, rk, rv);
  __syncthreads();
#pragma unroll 1
  for (int tt = 0; tt < ntiles; ++tt) {
    const int bo = (tt & 1) * (AT_BUF / 2);
    attn_tile2<DQK, 0, true>(Ks + bo, Vs + bo, qfA, qfA, QsB, o, mx, lsum, r, hh, nullptr, 0, 0);
    if (tt + 1 < ntiles) {
      const int bn = ((tt + 1) & 1) * (AT_BUF / 2);
      attn_store_tile<DQK>(Ks + bn, Vs + bn, rk, rv);
      if (tt + 2 < ntiles) attn_load_tile<DQK>(kbase + (size_t)(tt + 2) * 64 * DQK, vbase + (tt + 2) * 64, rk, rv);
    }
    __syncthreads();
  }
#pragma unroll
  for (int g = 0; g < 2; ++g) {
    const int qpos = qpos0 + 32 * g;
    const int m = (qpos < SEQ) ? b * SEQ + qpos : NLAT + b * CTXL + (qpos - SEQ);
    attn_write_out(o[g], lsum[g], Z + (size_t)m * zstride + head * 64, MIX + (size_t)m * D + head * 64, hh);
  }
}

DI void natten_item(const Params& p, int j, int item, unsigned char* lds) {
  const int b = item >> 8, head = (item >> 4) & 15, rp = item & 15;
  const bf16_t* Q = (const bf16_t*)(p.ws + WS_QC);
  const bf16_t* K = (const bf16_t*)(p.ws + WS_KC);
  const bf16_t* VT = (const bf16_t*)(p.ws + WS_VCT);
  const bf16_t* Z = (const bf16_t*)(p.ws + WS_ZC);
  bf16_t* MIX = (bf16_t*)(p.ws + WS_OH);
  const int t = tid_opaque(), lane = t & 63, w = t >> 6, r = lane & 31, hh = lane >> 5;
  bf16_t* Ks = (bf16_t*)(lds + AT_KS);
  bf16_t* Vs = (bf16_t*)(lds + AT_VS);
  float* rpbs = (float*)(lds + AT_RPB);
  const size_t bh = (size_t)(b * 16 + head);
  const int r0 = 2 * rp, qrow = r0 + (w >> 1), qc = 32 * (w & 1) + r, qpos = qrow * 64 + qc;
  const int ra = min(max(r0 - 4, 0), 24), rb = min(max(r0 + 1 - 4, 0), 24) + 7;
  const int nlat = rb - ra + 1, ntiles = nlat + 4;
  const int my_rs = min(max(qrow - 4, 0), 24);
  __syncthreads();
  for (int i = t; i < 15 * 31; i += 256) rpbs[i] = p.od_rpb[((size_t)(j * 16 + head)) * 465 + i] * LOG2E;
  bf16x8 qf[4];
#pragma unroll
  for (int jj = 0; jj < 4; ++jj) qf[jj] = *(const bf16x8*)(Q + (bh * KEYS + qpos) * 64 + 16 * jj + 8 * hh);
  f32x16 o[2];
#pragma unroll
  for (int x = 0; x < 2; ++x)
#pragma unroll
    for (int i = 0; i < 16; ++i) o[x][i] = 0.f;
  float mx = -1e30f, lsum = 0.f;
  const bf16_t* kb0 = K + bh * KEYS * 64;
  const bf16_t* vb0 = VT + bh * 64 * KEYS;
  u32x4 rk[2], rv[2];
  attn_load_tile<64>(kb0 + (size_t)(ra * 64) * 64, vb0 + ra * 64, rk, rv);
  for (int tt = 0; tt < ntiles; ++tt) {
    __syncthreads();
    attn_store_tile<64>(Ks, Vs, rk, rv);
    __syncthreads();
    if (tt + 1 < ntiles) {
      const int key0 = (tt + 1 < nlat) ? (ra + tt + 1) * 64 : SEQ + (tt + 1 - nlat) * 64;
      attn_load_tile<64>(kb0 + (size_t)key0 * 64, vb0 + key0, rk, rv);
    }
    if (tt < nlat) {
      const int kr = ra + tt;
      if (kr >= my_rs && kr < my_rs + 8) attn_tile<64, 1>(Ks, Vs, qf, o, mx, lsum, r, hh, rpbs, kr - qrow + 7, qc);
    } else {
      attn_tile<64, 0>(Ks, Vs, qf, o, mx, lsum, r, hh, nullptr, 0, 0);
    }
  }
  const int m = b * SEQ + qpos;
  attn_write_out(o, lsum, Z + (size_t)m * D + head * 64, MIX + (size_t)m * D + head * 64, hh);
}


DI void natten_item2(const Params& p, int j, int item, unsigned char* lds) {
  const int b = item >> 7, head = (item >> 3) & 15, rq = item & 7;
  const bf16_t* Q = (const bf16_t*)(p.ws + WS_QC);
  const bf16_t* K = (const bf16_t*)(p.ws + WS_KC);
  const bf16_t* VT = (const bf16_t*)(p.ws + WS_VCT);
  const bf16_t* Z = (const bf16_t*)(p.ws + WS_ZC);
  bf16_t* MIX = (bf16_t*)(p.ws + WS_OH);
  const int t = tid_opaque(), lane = t & 63, w = t >> 6, r = lane & 31, hh = lane >> 5;
  bf16_t* Ks = (bf16_t*)(lds + AT_KS);
  bf16_t* Vs = (bf16_t*)(lds + AT_VS);
  float* rpbs = (float*)(lds + AT_RPB);
  const size_t bh = (size_t)(b * 16 + head);
  const int r0 = 4 * rq, qrow = r0 + w, qpos0 = qrow * 64 + r;
  const int ra = min(max(r0 - 4, 0), 24), rb = min(max(r0 + 3 - 4, 0), 24) + 7;
  const int nlat = rb - ra + 1, ntiles = nlat + 4;
  const int my_rs = min(max(qrow - 4, 0), 24);
  __syncthreads();
  for (int i = t; i < 15 * 31; i += 256) rpbs[i] = p.od_rpb[((size_t)(j * 16 + head)) * 465 + i] * LOG2E;
  bf16x8 qfA[4];
  bf16_t* QsB = (bf16_t*)(lds + AT_QS) + (32 * w + r) * 72 + 8 * hh;
#pragma unroll
  for (int jj = 0; jj < 4; ++jj) {
    qfA[jj] = *(const bf16x8*)(Q + (bh * KEYS + qpos0) * 64 + 16 * jj + 8 * hh);
    *(bf16x8*)(QsB + 16 * jj) = *(const bf16x8*)(Q + (bh * KEYS + qpos0 + 32) * 64 + 16 * jj + 8 * hh);
  }
  f32x16 o[2][2];
#pragma unroll
  for (int g = 0; g < 2; ++g)
#pragma unroll
    for (int x = 0; x < 2; ++x)
#pragma unroll
      for (int i = 0; i < 16; ++i) o[g][x][i] = 0.f;
  float mx[2] = {-1e30f, -1e30f}, lsum[2] = {0.f, 0.f};
  const bf16_t* kb0 = K + bh * KEYS * 64;
  const bf16_t* vb0 = VT + bh * 64 * KEYS;
  u32x4 rk[2], rv[2];
#define NAT_KEY0(tq) (((tq) < nlat) ? (ra + (tq)) * 64 : SEQ + ((tq) - nlat) * 64)
  attn_load_tile<64>(kb0 + (size_t)(ra * 64) * 64, vb0 + ra * 64, rk, rv);
  attn_store_tile<64>(Ks, Vs, rk, rv);
  { const int k1 = NAT_KEY0(1); attn_load_tile<64>(kb0 + (size_t)k1 * 64, vb0 + k1, rk, rv); }
  __syncthreads();
#pragma unroll 1
  for (int tt = 0; tt < ntiles; ++tt) {
    const int bo = (tt & 1) * (AT_BUF / 2);
    if (tt < nlat) {
      const int kr = ra + tt;
      if (kr >= my_rs && kr < my_rs + 8) attn_tile2<64, 1, true>(Ks + bo, Vs + bo, qfA, qfA, QsB, o, mx, lsum, r, hh, rpbs, kr - qrow + 7, r);
    } else {
      attn_tile2<64, 0, true>(Ks + bo, Vs + bo, qfA, qfA, QsB, o, mx, lsum, r, hh, nullptr, 0, 0);
    }
    if (tt + 1 < ntiles) {
      const int bn = ((tt + 1) & 1) * (AT_BUF / 2);
      attn_store_tile<64>(Ks + bn, Vs + bn, rk, rv);
      if (tt + 2 < ntiles) { const int k2 = NAT_KEY0(tt + 2); attn_load_tile<64>(kb0 + (size_t)k2 * 64, vb0 + k2, rk, rv); }
    }
    __syncthreads();
  }
#undef NAT_KEY0
#pragma unroll
  for (int g = 0; g < 2; ++g) {
    const int m = b * SEQ + qpos0 + 32 * g;
    attn_write_out(o[g], lsum[g], Z + (size_t)m * D + head * 64, MIX + (size_t)m * D + head * 64, hh);
  }
}

DI void od_win_tile(const Params& p, int j, int mt, int nt, unsigned char* lds) {
  const bf16_t* H = (const bf16_t*)(p.ws + WS_OH);
  const bf16_t* WT = (const bf16_t*)(p.ws + WS_WT + WT_OD_IN);
  const int t = tid_opaque(), m0 = mt * 128, n0 = nt * 128;
  const float* Cs = (const float*)lds;
  const int type = n0 >> 10, hh0 = (n0 & 1023) >> 6;
  int b, pos0; tok_bp(m0, b, pos0);
  if (type < 2) {
    bf16_t* dstb = (bf16_t*)(p.ws + (type == 0 ? WS_QC : WS_KC));
    const float* gain = (type == 0 ? p.od_q_gain : p.od_k_gain) + j * 64;
    const float sc = (type == 0) ? 0.125f * LOG2E : 1.f;
#pragma unroll 1
    for (int it = 0; it < 8; ++it) {
      const int idx = t + 256 * it, l8 = idx & 7, hsel = (idx >> 3) & 1, row = idx >> 4;
      float v[8];
      *(f32x4*)v = *(const f32x4*)(Cs + row * 132 + hsel * 64 + l8 * 8);
      *(f32x4*)(v + 4) = *(const f32x4*)(Cs + row * 132 + hsel * 64 + l8 * 8 + 4);
      float ss = 0.f;
#pragma unroll
      for (int e = 0; e < 8; ++e) ss += v[e] * v[e];
      ss += __shfl_xor(ss, 1); ss += __shfl_xor(ss, 2); ss += __shfl_xor(ss, 4);
      const float rstd = rsqrtf(ss * (1.f / 64.f) + EPS) * sc;
#pragma unroll
      for (int e = 0; e < 8; ++e) v[e] *= rstd * gain[l8 * 8 + e];
      *(u32x4*)(dstb + ((size_t)(b * 16 + hh0 + hsel) * KEYS + pos0 + row) * 64 + l8 * 8) = pack8(v);
    }
  } else if (type == 2) {
    bf16_t* VCT = (bf16_t*)(p.ws + WS_VCT);
#pragma unroll 1
    for (int it = 0; it < 8; ++it) {
      const int idx = t + 256 * it, rg = idx & 15, cc = idx >> 4, head = hh0 + (cc >> 6), e = cc & 63;
      float v[8];
#pragma unroll
      for (int q = 0; q < 8; ++q) v[q] = Cs[(rg * 8 + q) * 132 + cc];
      *(u32x4*)(VCT + ((size_t)(b * 16 + head) * 64 + e) * KEYS + pos0 + rg * 8) = pack8(v);
    }
  } else {
    bf16_t* ZC = (bf16_t*)(p.ws + WS_ZC);
#pragma unroll 1
    for (int it = 0; it < 8; ++it) {
      const int idx = t + 256 * it, row = idx >> 4, ch = idx & 15;
      float v[8];
      *(f32x4*)v = *(const f32x4*)(Cs + row * 132 + ch * 8);
      *(f32x4*)(v + 4) = *(const f32x4*)(Cs + row * 132 + ch * 8 + 4);
      *(u32x4*)(ZC + (size_t)(m0 + row) * D + (n0 - 3072) + ch * 8) = pack8(v);
    }
  }
}


struct OdWinOps {
  const Params* pp; int j; int layer;
  DI void map(int id, int& mt, int& nt) const {
    xcd_tile(id, 18, 32, 6, mt, nt);
  }
  DI TileDesc tile(int id) const {
    int mt, nt; map(id, mt, nt);
    TileDesc d; d.A = (const bf16_t*)(pp->ws + WS_OH) + (size_t)mt * 128 * D; d.B = (const bf16_t*)(pp->ws + WS_WT + WT_OD_IN) + (size_t)nt * 128 * D; d.nvalid = 128;
    return d;
  }
  DI void epi(int id, unsigned char* lds) const { int mt, nt; map(id, mt, nt); od_win_tile(*pp, j, mt, nt, lds); }
};


struct OdWinOps2 {
  const Params* pp; int j; int layer;
  DI void epi_lds(int, unsigned char*) const {}
  DI TileDesc tile(int id) const {
    int mt, nt; xcd_tile(id, 18, 32, 6, mt, nt);
    TileDesc d; d.A = (const bf16_t*)(pp->ws + WS_OH) + (size_t)mt * 128 * D; d.B = (const bf16_t*)(pp->ws + WS_WT + WT_OD_IN) + (size_t)nt * 128 * D; d.nvalid = 128;
    return d;
  }
  DI void epi_read(int id, unsigned char* lds, float (&c)[64]) const {
    int mt, nt; xcd_tile(id, 18, 32, 6, mt, nt);
    const int type = nt >> 3;
    const int t = tid_opaque();
    const float* Cs = (const float*)lds;
    if (type == 2) {
      const int rg = t & 15;
#pragma unroll
      for (int it = 0; it < 8; ++it) {
        const int cc = (t >> 4) + 16 * it;
#pragma unroll
        for (int q = 0; q < 8; ++q) c[it * 8 + q] = Cs[(rg * 8 + q) * 132 + cc];
      }
    } else {
      const int off = (type < 2) ? ((t >> 3) & 1) * 64 + (t & 7) * 8 : (t & 15) * 8;
#pragma unroll
      for (int it = 0; it < 8; ++it) {
        const int row = (t >> 4) + 16 * it;
        *(f32x4*)(c + it * 8) = *(const f32x4*)(Cs + row * 132 + off);
        *(f32x4*)(c + it * 8 + 4) = *(const f32x4*)(Cs + row * 132 + off + 4);
      }
    }
  }
  DI void epi_write(int id, const float (&c)[64]) const {
    const Params& p = *pp;
    int mt, nt; xcd_tile(id, 18, 32, 6, mt, nt);
    const int m0 = mt * 128, n0 = nt * 128;
    const int t = tid_opaque();
    const int type = n0 >> 10, hh0 = (n0 & 1023) >> 6;
    int b, pos0; tok_bp(m0, b, pos0);
    if (type < 2) {
      bf16_t* dstb = (bf16_t*)(p.ws + (type == 0 ? WS_QC : WS_KC));
      const int l8 = t & 7, hsel = (t >> 3) & 1;
      const float* gain = (type == 0 ? p.od_q_gain : p.od_k_gain) + j * 64 + l8 * 8;
      const f32x4 g0 = *(const f32x4*)gain, g1 = *(const f32x4*)(gain + 4);
      const float gg[8] = {g0.x, g0.y, g0.z, g0.w, g1.x, g1.y, g1.z, g1.w};
      const float sc = (type == 0) ? 0.125f * LOG2E : 1.f;
#pragma unroll
      for (int it = 0; it < 8; ++it) {
        const int row = (t >> 4) + 16 * it;
        float v[8];
        float ss = 0.f;
#pragma unroll
        for (int e = 0; e < 8; ++e) { v[e] = c[it * 8 + e]; ss += v[e] * v[e]; }
        ss += __shfl_xor(ss, 1); ss += __shfl_xor(ss, 2); ss += __shfl_xor(ss, 4);
        const float rstd = rsqrtf(ss * (1.f / 64.f) + EPS) * sc;
#pragma unroll
        for (int e = 0; e < 8; ++e) v[e] *= rstd * gg[e];
        *(u32x4*)(dstb + ((size_t)(b * 16 + hh0 + hsel) * KEYS + pos0 + row) * 64 + l8 * 8) = pack8(v);
      }
    } else if (type == 2) {
      bf16_t* VCT = (bf16_t*)(p.ws + WS_VCT);
      const int rg = t & 15;
#pragma unroll
      for (int it = 0; it < 8; ++it) {
        const int cc = (t >> 4) + 16 * it, head = hh0 + (cc >> 6), e = cc & 63;
        *(u32x4*)(VCT + ((size_t)(b * 16 + head) * 64 + e) * KEYS + pos0 + rg * 8) = pack8(c + it * 8);
      }
    } else {
      bf16_t* ZC = (bf16_t*)(p.ws + WS_ZC);
      const int ch = t & 15;
#pragma unroll
      for (int it = 0; it < 8; ++it) {
        const int row = (t >> 4) + 16 * it;
        *(u32x4*)(ZC + (size_t)(m0 + row) * D + (n0 - 3072) + ch * 8) = pack8(c + it * 8);
      }
    }
  }
};

__global__ void __launch_bounds__(256, 2) fwd_megakernel(Params p) {
  extern __shared__ __attribute__((aligned(16))) unsigned char smem[];
  cg::grid_group grid = cg::this_grid();
  unsigned char* lds = smem;
  volatile LAS unsigned* stw = (volatile LAS unsigned*)(smem + LDS_MAIN);
  if (__builtin_amdgcn_workitem_id_x() < 4) stw[__builtin_amdgcn_workitem_id_x()] = 0u;
  __syncthreads();
  const XcdBarrier xbar = xcd_barrier_post((unsigned*)(p.ws + WS_BAR), stw);
  if (p.ws == nullptr) grid.sync();

  for (int rep = 0; rep < NREP(5); ++rep) phase_setup(p, lds);
  GSYNC();

  for (int layer = 0; layer < 4; ++layer) {
    const int j = layer >> 1;
    for (int rep = 0; rep < NREP(4); ++rep) phase_norm(p, layer, lds);
    GSYNC();
    if ((layer & 1) == 0) {
      for (int rep = 0; rep < NREP(0); ++rep) phase_ev_win(p, lds);
      GSYNC();
      for (int rep = 0; rep < NREP(2); ++rep) {
        { EvQOps ops; ops.pp = &p; ops.j = j; gemm_glds2<3, EvQOps, true, true>(1152, U1W, 768, ops, lds); }
        { EvKvOps ops; ops.pp = &p; ops.j = j; gemm_glds2<4, EvKvOps, true, true>(1152, U1W, 256, ops, lds, 128); }
        for (int id = (blockIdx.x + 256) % gridDim.x; id < 1152; id += gridDim.x) gla_g1_item(p, j, id, lds);
      }
      GSYNC();
      {
        const bf16_t* QA = (const bf16_t*)(p.ws + WS_R1 + R1_QA);
        const bf16_t* KA = (const bf16_t*)(p.ws + WS_R1 + R1_KA);
        const bf16_t* VAT = (const bf16_t*)(p.ws + WS_R1 + R1_VAT);
        const bf16_t* U2 = (const bf16_t*)(p.ws + WS_U2);
        bf16_t* MIX = (bf16_t*)(p.ws + WS_R2);
        for (int rep = 0; rep < NREP(1); ++rep)
        for (int id = blockIdx.x; id < (rep == 0 ? 512 + 512 : 512); id += gridDim.x) {
          if (id < 512) {
            const int qb = id & 7, head = (id >> 3) & 7, b = id >> 6;
            attn_dense_item2<96, 8>(QA, KA, VAT, U2 + U2_ZA, U2W, MIX, b, head, qb * 256, 0, KEYS / 64, lds);
          } else {
            gla_scan_item(p, id - 512);
          }
        }
      }
      GSYNC();
      {
        const bf16_t* QA = (const bf16_t*)(p.ws + WS_R1 + R1_QA);
        const bf16_t* KA = (const bf16_t*)(p.ws + WS_R1 + R1_KA);
        const bf16_t* VAT = (const bf16_t*)(p.ws + WS_R1 + R1_VAT);
        const bf16_t* U2 = (const bf16_t*)(p.ws + WS_U2);
        bf16_t* MIX = (bf16_t*)(p.ws + WS_R2);
        for (int rep = 0; rep < NREP(3); ++rep)
        for (int id = blockIdx.x; id < 1152 + 64; id += gridDim.x) {
          if (id < 1152) gla_g3_item(p, j, id, lds);
          else {
            const int i2 = id - 1152, head = i2 & 7, b = i2 >> 3;
            attn_dense_item2<96, 8>(QA, KA, VAT, U2 + U2_ZA, U2W, MIX, b, head, SEQ, SEQ, CTXL / 64, lds);
          }
        }
      }
      GSYNC();
    } else {
      for (int rep = 0; rep < NREP(0); ++rep) {
        OdWinOps2 ops; ops.pp = &p; ops.j = j; ops.layer = layer;
        gemm_glds2<4>(144 * 32, D, D, ops, lds);
      }
      GSYNC();
      {
        const int nctx = (layer == 3) ? 0 : 128;
        const bf16_t* QC = (const bf16_t*)(p.ws + WS_QC);
        const bf16_t* KC = (const bf16_t*)(p.ws + WS_KC);
        const bf16_t* VCT = (const bf16_t*)(p.ws + WS_VCT);
        const bf16_t* ZC = (const bf16_t*)(p.ws + WS_ZC);
        bf16_t* MIX = (bf16_t*)(p.ws + WS_OH);
        for (int rep = 0; rep < NREP(1); ++rep)
        for (int id = blockIdx.x; id < 1024 + nctx; id += gridDim.x) {
          if (id < 1024) natten_item2(p, j, id, lds);
          else {
            const int i2 = id - 1024, head = i2 & 15, b = i2 >> 4;
            attn_dense_item2<64, 16>(QC, KC, VCT, ZC, D, MIX, b, head, SEQ, SEQ, CTXL / 64, lds);
          }
        }
      }
      GSYNC();
    }
    phase_wout(p, layer, lds);
    if (layer < 3) GSYNC();
  }
}

extern "C" void kernel_launch(void* const* d_in, const int* in_sizes, int n_in, void* d_out, int out_size, void* d_ws, size_t ws_size,
                              hipStream_t stream) {
  static int grid_blocks = 0;
  if (!grid_blocks) {
    int dev = 0, cus = 0, per_cu = 0;
    hipGetDevice(&dev);
    hipDeviceGetAttribute(&cus, hipDeviceAttributeMultiprocessorCount, dev);
    hipFuncSetAttribute((const void*)fwd_megakernel, hipFuncAttributeMaxDynamicSharedMemorySize, LDS_BYTES);
    hipOccupancyMaxActiveBlocksPerMultiprocessor(&per_cu, (const void*)fwd_megakernel, 256, LDS_BYTES);
    if (per_cu < 1) per_cu = 1;
    if (per_cu > 2) per_cu = 2;
    grid_blocks = cus * per_cu;
    if (ws_size < WS_NEED) fprintf(stderr, "kernel_launch: workspace too small: %zu < %zu\n", ws_size, (size_t)WS_NEED);
  }
  Params p{};
  const float** pp = (const float**)&p;
  for (int i = 0; i < 23; ++i) pp[i] = (const float*)d_in[i];
  p.out = (float*)d_out;
  p.ws = (unsigned char*)d_ws;
  hipMemsetAsync((unsigned char*)d_ws + WS_BAR, 0, BAR_BYTES, stream);
  void* args[] = {&p};
  hipError_t e = hipLaunchCooperativeKernel((const void*)fwd_megakernel, dim3(grid_blocks), dim3(256), args, LDS_BYTES, stream);
  if (e != hipSuccess) fprintf(stderr, "cooperative launch failed: %s (grid %d)\n", hipGetErrorString(e), grid_blocks);
}
```

```cpp
#include <hip/hip_runtime.h>
#include <hip/hip_cooperative_groups.h>
#include <stdint.h>
#include <stdio.h>
namespace cg = cooperative_groups;
#ifndef PHM
#define PHM 0xffff
#endif
#ifndef DBLM
#define DBLM 0
#endif
#define GSYNC() do { xcd_barrier(xbar); if (NREP(6) == 2) xcd_barrier(xbar); } while (0)
#define NREP(k) (((DBLM >> (k)) & 1) ? 2 : 1)

#define DI __device__ __forceinline__
typedef unsigned short bf16_t;
typedef short bf16x8 __attribute__((ext_vector_type(8)));
typedef short s16x4 __attribute__((ext_vector_type(4)));
typedef float f32x4 __attribute__((ext_vector_type(4)));
typedef float f32x16 __attribute__((ext_vector_type(16)));
typedef unsigned u32x4 __attribute__((ext_vector_type(4)));
typedef unsigned u32x2 __attribute__((ext_vector_type(2)));

constexpr int D = 1024, NB = 8, SEQ = 2048, CTXL = 256, NLAT = NB * SEQ, NCTX = NB * CTXL, NTOK = NLAT + NCTX, KEYS = SEQ + CTXL;
constexpr int EVEN_IN = 3136, ODD_IN = 4096;
constexpr int U1W = 1056, U2W = 2080;
constexpr int U2_ZA = 0, U2_QB = 512, U2_KB = 768, U2_VB = 1024, U2_GLR = 1536, U2_ZB = 1568;
constexpr float EPS = 1e-6f;
constexpr float LOG2E = 1.4426950408889634f;
constexpr int NCHUNK = 36;

constexpr size_t WS_WT = 0;
constexpr size_t WT_EV_IN = 0, WT_EV_UQ = (size_t)EVEN_IN * D * 2, WT_EV_UKV = WT_EV_UQ + (size_t)768 * 768 * 2,
                 WT_EV_OUT = WT_EV_UKV + (size_t)1024 * 256 * 2;
constexpr size_t WT_OD_IN = 0, WT_OD_OUT = (size_t)ODD_IN * D * 2;
constexpr size_t WT_BYTES = (size_t)ODD_IN * D * 2 + (size_t)D * D * 2;
constexpr size_t WS_MOD = WS_WT + WT_BYTES;
constexpr size_t WS_ROPEC = WS_MOD + 4 * 9 * 3072 * 4;
constexpr size_t WS_ROPES = WS_ROPEC + 2048 * 16 * 4;
constexpr size_t WS_DEC = WS_ROPES + 2048 * 16 * 4;
constexpr size_t WS_CX = WS_DEC + 64 * 36 * 64 * 4;
constexpr size_t WS_R1 = WS_CX + (size_t)NCTX * D * 4;
constexpr size_t R1_QA = 0, R1_KA = (size_t)NB * 8 * KEYS * 96 * 2, R1_VAT = 2 * R1_KA;
constexpr size_t R1_BYTES = 2 * R1_KA + (size_t)NB * 8 * 64 * KEYS * 2;
constexpr size_t WS_R2 = WS_R1 + R1_BYTES;
constexpr size_t R2_BYTES = (size_t)NTOK * U1W * 2;
constexpr size_t WS_U2 = WS_R2 + R2_BYTES;
constexpr size_t U2_BYTES = (size_t)NTOK * U2W * 2;
constexpr size_t WS_KVST = WS_U2 + U2_BYTES;
constexpr size_t KVST_BYTES = (size_t)64 * 36 * 8192 * 2;
constexpr size_t WS_END_EVEN = WS_KVST + KVST_BYTES;
constexpr size_t WS_OH = WS_R1;
constexpr size_t OH_BYTES = (size_t)NTOK * D * 2;
constexpr size_t WS_QC = WS_OH + OH_BYTES;
constexpr size_t QC_BYTES = (size_t)NB * 16 * KEYS * 64 * 2;
constexpr size_t WS_KC = WS_QC + QC_BYTES, WS_VCT = WS_KC + QC_BYTES, WS_ZC = WS_VCT + QC_BYTES;
constexpr size_t WS_END_ODD = WS_ZC + OH_BYTES;
constexpr size_t WS_BAR = ((WS_END_EVEN > WS_END_ODD ? WS_END_EVEN : WS_END_ODD) + 255) / 256 * 256;
constexpr size_t BAR_BYTES = 16384;
constexpr size_t WS_NEED = WS_BAR + BAR_BYTES;

constexpr int LDS_MAIN = 73728;
constexpr int LDS_BYTES = LDS_MAIN + 16;

struct Params {
  const float *x, *c, *ctx, *c_ctx, *norm_g, *ada_w, *ada_b, *ev_w_in, *ev_q_norm, *ev_w_uq, *ev_kv_norm, *ev_w_ukv,
      *ev_q_gain, *ev_k_gain, *ev_gate_w, *ev_gate_b, *ev_gla_norm, *ev_w_out, *od_w_in, *od_q_gain, *od_k_gain, *od_rpb, *od_w_out;
  float* out;
  unsigned char* ws;
};

typedef __bf16 bf16v2_t __attribute__((ext_vector_type(2)));
typedef float f32x2_t __attribute__((ext_vector_type(2)));
DI unsigned pk2(float lo, float hi) { f32x2_t f = {lo, hi}; bf16v2_t b = __builtin_convertvector(f, bf16v2_t); return __builtin_bit_cast(unsigned, b); }
DI bf16_t f2bf(float x) { return (bf16_t)(pk2(x, 0.f) & 0xffffu); }
DI float bf2f(bf16_t b) { return __uint_as_float((unsigned)b << 16); }
DI float bflo(unsigned u) { return __uint_as_float(u << 16); }
DI float bfhi(unsigned u) { return __uint_as_float(u & 0xffff0000u); }
DI u32x4 pack8(const float* v) { u32x4 o; o.x = pk2(v[0], v[1]); o.y = pk2(v[2], v[3]); o.z = pk2(v[4], v[5]); o.w = pk2(v[6], v[7]); return o; }
DI void unpack8(u32x4 u, float* v) { v[0] = bflo(u.x); v[1] = bfhi(u.x); v[2] = bflo(u.y); v[3] = bfhi(u.y); v[4] = bflo(u.z); v[5] = bfhi(u.z); v[6] = bflo(u.w); v[7] = bfhi(u.w); }
DI float wave_sum(float v) {
#pragma unroll
  for (int o = 32; o; o >>= 1) v += __shfl_xor(v, o);
  return v;
}
DI int tid_opaque() { int t = __builtin_amdgcn_workitem_id_x(); asm volatile("" : "+v"(t)); return t; }
DI float silu_f(float z) { return z / (1.f + __expf(-z)); }
DI float exp2_fast(float x) { return __builtin_amdgcn_exp2f(x); }
DI int crow(int i, int h) { return (i & 3) + 8 * (i >> 2) + 4 * h; }
#define MFMA32(a, b, c) __builtin_amdgcn_mfma_f32_32x32x16_bf16((a), (b), (c), 0, 0, 0)
#define MFMA16(a, b, c) __builtin_amdgcn_mfma_f32_16x16x32_bf16((a), (b), (c), 0, 0, 0)


#define XB_TMO      128
#define XB_XCNT(j)  (256  + 64 * (j))
#define XB_XSUB(j)  (1280 + 64 * (j))
#define XB_XGEN(j)  (2304 + 64 * (j))
#define XB_TOP      3328
#define XB_TOPGEN   3392
#define XCD_BAR_WORDS 3456
#define XB_SPIN_CAP (1u << 18)
#define LAS __attribute__((address_space(3)))
DI unsigned xb_ld(unsigned* p) { return __hip_atomic_load(p, __ATOMIC_RELAXED, __HIP_MEMORY_SCOPE_AGENT); }
DI unsigned xb_add(unsigned* p, unsigned v) { return __hip_atomic_fetch_add(p, v, __ATOMIC_RELAXED, __HIP_MEMORY_SCOPE_AGENT); }
DI unsigned xb_xcc_id() { return (unsigned)__builtin_amdgcn_s_getreg((3 << 11) | 20) & 0xFu; }
#define XB_SPIN(cond, bar) do { unsigned _sp = 0; while (cond) { __builtin_amdgcn_s_sleep(1); \
    if ((++_sp & 255u) == 0u) { if (xb_ld(&(bar)[XB_TMO])) break; if (_sp > XB_SPIN_CAP) { atomicAdd(&(bar)[XB_TMO], 1u); break; } } } } while (0)
struct XcdBarrier { unsigned* bar; unsigned x; volatile LAS unsigned* st; };
DI XcdBarrier xcd_barrier_post(unsigned* bar, volatile LAS unsigned* st) {
  XcdBarrier b; b.bar = bar; b.x = xb_xcc_id(); b.st = st;
  if (__builtin_amdgcn_workitem_id_x() == 0) (void)xb_add(&bar[XB_XCNT(b.x)], 1u);
  return b;
}
DI void xcd_barrier_complete(unsigned* bar, unsigned x, unsigned& nloc, unsigned& nx) {
  const unsigned G = gridDim.x * gridDim.y * gridDim.z;
  unsigned sum, cnt, mine, sp = 0u;
  for (;;) {
    sum = 0u; cnt = 0u; mine = 0u;
#pragma unroll
    for (unsigned j = 0; j < 16; ++j) { const unsigned c = xb_ld(&bar[XB_XCNT(j)]); sum += c; cnt += (c > 0u) ? 1u : 0u; mine = (j == x) ? c : mine; }
    if (sum == G) break;
    __builtin_amdgcn_s_sleep(1);
    if ((++sp & 255u) == 0u) { if (xb_ld(&bar[XB_TMO])) break; if (sp > XB_SPIN_CAP) { atomicAdd(&bar[XB_TMO], 1u); break; } }
  }
  nloc = mine > 0u ? mine : 1u; nx = cnt > 0u ? cnt : 1u;
}
DI void xcd_barrier(const XcdBarrier& b) {
  asm volatile("s_waitcnt vmcnt(0)" ::: "memory");
  __syncthreads();
  if (__builtin_amdgcn_workitem_id_x() == 0) {
    unsigned* bar = b.bar;
    const unsigned bx = xb_xcc_id();
    __builtin_amdgcn_s_waitcnt(0);
    unsigned nloc = b.st[0], nx = b.st[1];
    if (nloc == 0u) { xcd_barrier_complete(bar, bx, nloc, nx); b.st[0] = nloc; b.st[1] = nx; }
    const unsigned old = xb_add(&bar[XB_XSUB(bx)], 1u);
    const unsigned gen = old / nloc;
    if (old + 1u == (gen + 1u) * nloc) {
      __builtin_amdgcn_fence(__ATOMIC_RELEASE, "agent");
      asm volatile("s_waitcnt vmcnt(0)" ::: "memory");
      const unsigned og = xb_add(&bar[XB_TOP], 1u);
      const unsigned tg = og / nx;
      if (og + 1u == (tg + 1u) * nx) xb_add(&bar[XB_TOPGEN], 1u);
      else XB_SPIN(xb_ld(&bar[XB_TOPGEN]) == tg, bar);
      __builtin_amdgcn_fence(__ATOMIC_ACQUIRE, "agent");
      xb_add(&bar[XB_XGEN(bx)], 1u);
      asm volatile("s_waitcnt vmcnt(0)" ::: "memory");
    } else {
      XB_SPIN(xb_ld(&bar[XB_XGEN(bx)]) == gen, bar);
      __builtin_amdgcn_fence(__ATOMIC_ACQUIRE, "agent");
      asm volatile("s_waitcnt vmcnt(0)" ::: "memory");
    }
  }
  __syncthreads();
}

DI void tok_bp(int m, int& b, int& pos) {
  if (m < NLAT) { b = m >> 11; pos = m & 2047; } else { int mm = m - NLAT; b = mm >> 8; pos = SEQ + (mm & 255); }
}

DI void phase_setup(const Params& p, unsigned char* lds) {
  const int t = tid_opaque();
  float* MOD = (float*)(p.ws + WS_MOD);
  for (int item = blockIdx.x; item < 384; item += gridDim.x) {
    const int layer = item / 96, n0 = (item % 96) * 32;
    float* sc = (float*)lds;
    float* red = sc + 9 * 1024;
    __syncthreads();
    for (int i = t; i < 9 * 1024; i += 256) {
      const int r = i >> 10, k = i & 1023;
      const float v = (r < 8) ? p.c[r * 1024 + k] : p.c_ctx[k];
      sc[i] = silu_f(v);
    }
    __syncthreads();
    const int col = t & 31, kq = t >> 5;
    float acc[9];
#pragma unroll
    for (int r = 0; r < 9; ++r) acc[r] = 0.f;
    const float* W = p.ada_w + (size_t)layer * 1024 * 3072 + n0 + col;
#pragma unroll 4
    for (int k = kq * 128; k < kq * 128 + 128; k += 4) {
      const float w0 = W[(size_t)k * 3072], w1 = W[(size_t)(k + 1) * 3072], w2 = W[(size_t)(k + 2) * 3072], w3 = W[(size_t)(k + 3) * 3072];
#pragma unroll
      for (int r = 0; r < 9; ++r) {
        const f32x4 s4 = *(const f32x4*)(sc + r * 1024 + k);
        acc[r] += s4.x * w0 + s4.y * w1 + s4.z * w2 + s4.w * w3;
      }
    }
#pragma unroll
    for (int r = 0; r < 9; ++r) red[(kq * 9 + r) * 32 + col] = acc[r];
    __syncthreads();
    for (int i = t; i < 9 * 32; i += 256) {
      const int r = i >> 5, cc = i & 31;
      float v = 0.f;
#pragma unroll
      for (int q = 0; q < 8; ++q) v += red[(q * 9 + r) * 32 + cc];
      MOD[(size_t)(layer * 9 + r) * 3072 + n0 + cc] = v + p.ada_b[layer * 3072 + n0 + cc];
    }
  }
  float* RC = (float*)(p.ws + WS_ROPEC);
  float* RS = (float*)(p.ws + WS_ROPES);
  for (int i = blockIdx.x * 256 + t; i < 2048 * 16; i += gridDim.x * 256) {
    const int pos = i >> 4, a = (i >> 3) & 1, f = i & 7;
    const float coord = (float)(a == 0 ? (pos >> 6) : (pos & 63));
    const float inv = exp2f(-(float)f * 0.125f * 13.287712379549449f);
    const float ang = coord * inv;
    const float k = rintf(ang * 0.15915494309189535f);
    float rr = fmaf(-k, 6.28125f, ang);
    rr = fmaf(-k, 0.0019353071795864769f, rr);
    RC[i] = __cosf(rr);
    RS[i] = __sinf(rr);
  }
}

DI void transpose_item(const float* __restrict__ W, int K, int N, bf16_t* __restrict__ WT, const float* __restrict__ kscale, int item, float* tile) {
  const int t = tid_opaque();
  const int nblk = N >> 6, kb = item / nblk, nb = item % nblk, k0 = kb * 64, n0 = nb * 64;
  __syncthreads();
  {
    const int nn = t & 63, kk0 = t >> 6;
#pragma unroll
    for (int i = 0; i < 16; ++i) {
      const int kk = kk0 + 4 * i;
      float v = W[(size_t)(k0 + kk) * N + n0 + nn];
      if (kscale) v *= kscale[k0 + kk];
      tile[kk * 65 + nn] = v;
    }
  }
  __syncthreads();
  {
    const int n = t >> 2, kc = t & 3;
    float v[16];
#pragma unroll
    for (int j = 0; j < 16; ++j) v[j] = tile[(kc * 16 + j) * 65 + n];
    bf16_t* dst = WT + (size_t)(n0 + n) * K + k0 + kc * 16;
    *(u32x4*)dst = pack8(v);
    *(u32x4*)(dst + 8) = pack8(v + 8);
  }
}

DI void phase_norm(const Params& p, int layer, unsigned char* lds) {
  const int j = layer >> 1;
  bf16_t* WT = (bf16_t*)(p.ws + WS_WT);
  float* tile = (float*)lds;
  if ((layer & 1) == 0) {
    const int n1 = 16 * 49, n2 = n1 + 12 * 12, n3 = n2 + 4 * 16, n4 = n3 + 16 * 16;
    for (int it = blockIdx.x; it < n4; it += gridDim.x) {
      if (it < n1) transpose_item(p.ev_w_in + (size_t)j * D * EVEN_IN, D, EVEN_IN, (bf16_t*)((unsigned char*)WT + WT_EV_IN), nullptr, it, tile);
      else if (it < n2) transpose_item(p.ev_w_uq + (size_t)j * 768 * 768, 768, 768, (bf16_t*)((unsigned char*)WT + WT_EV_UQ), p.ev_q_norm + j * 768, it - n1, tile);
      else if (it < n3) transpose_item(p.ev_w_ukv + (size_t)j * 256 * 1024, 256, 1024, (bf16_t*)((unsigned char*)WT + WT_EV_UKV), p.ev_kv_norm + j * 256, it - n2, tile);
      else transpose_item(p.ev_w_out + (size_t)j * D * D, D, D, (bf16_t*)((unsigned char*)WT + WT_EV_OUT), nullptr, it - n3, tile);
    }
  } else {
    const int n1 = 16 * 64, n2 = n1 + 16 * 16;
    for (int it = blockIdx.x; it < n2; it += gridDim.x) {
      if (it < n1) transpose_item(p.od_w_in + (size_t)j * D * ODD_IN, D, ODD_IN, (bf16_t*)((unsigned char*)WT + WT_OD_IN), nullptr, it, tile);
      else transpose_item(p.od_w_out + (size_t)j * D * D, D, D, (bf16_t*)((unsigned char*)WT + WT_OD_OUT), nullptr, it - n1, tile);
    }
  }
  const int lane = tid_opaque() & 63, wv = tid_opaque() >> 6;
  const float* MOD = (const float*)(p.ws + WS_MOD);
  const float* xl = (layer == 0) ? p.x : p.out;
  const float* xc = (layer == 0) ? p.ctx : (const float*)(p.ws + WS_CX);
  bf16_t* H = (bf16_t*)(p.ws + (((layer & 1) == 0) ? WS_R1 : WS_OH));
  const float* g = p.norm_g + layer * D;
  const int wstride = gridDim.x * 4;
  for (int m0 = blockIdx.x * 4 + wv; m0 < NTOK; m0 += 3 * wstride) {
    f32x4 v[3][4];
    float ss[3];
#pragma unroll
    for (int u = 0; u < 3; ++u) {
      const int m = m0 + u * wstride;
      const int mc = m < NTOK ? m : m0;
      const float* xr = (mc < NLAT) ? xl + (size_t)mc * D : xc + (size_t)(mc - NLAT) * D;
#pragma unroll
      for (int q = 0; q < 4; ++q) v[u][q] = *(const f32x4*)(xr + 4 * lane + 256 * q);
    }
#pragma unroll
    for (int u = 0; u < 3; ++u) {
      float a = 0.f;
#pragma unroll
      for (int q = 0; q < 4; ++q) a += v[u][q].x * v[u][q].x + v[u][q].y * v[u][q].y + v[u][q].z * v[u][q].z + v[u][q].w * v[u][q].w;
      ss[u] = wave_sum(a);
    }
#pragma unroll
    for (int u = 0; u < 3; ++u) {
      const int m = m0 + u * wstride;
      if (m < NTOK) {
        const int r = (m < NLAT) ? (m >> 11) : 8;
        const float* shift = MOD + (size_t)(layer * 9 + r) * 3072;
        const float* scale = shift + 1024;
        const float rstd = rsqrtf(ss[u] * (1.f / D) + EPS);
#pragma unroll
        for (int q = 0; q < 4; ++q) {
          const int k = 4 * lane + 256 * q;
          const f32x4 gg = *(const f32x4*)(g + k), sc = *(const f32x4*)(scale + k), sh = *(const f32x4*)(shift + k);
          const float o0 = v[u][q].x * rstd * gg.x * (1.f + sc.x) + sh.x, o1 = v[u][q].y * rstd * gg.y * (1.f + sc.y) + sh.y;
          const float o2 = v[u][q].z * rstd * gg.z * (1.f + sc.z) + sh.z, o3 = v[u][q].w * rstd * gg.w * (1.f + sc.w) + sh.w;
          u32x2 o; o.x = pk2(o0, o1); o.y = pk2(o2, o3);
          *(u32x2*)(H + (size_t)m * D + k) = o;
        }
      }
    }
  }
}

constexpr int ROWSTAT_OFF = 67584, ROWSTAT2_OFF = ROWSTAT_OFF + 512;

template <int NFRAG, bool SUMSQ>
DI void gemm_mainloop(const bf16_t* __restrict__ A, int lda, const bf16_t* __restrict__ Bt, int K, int nvalid,
                      f32x4 (&acc)[4][NFRAG], unsigned char* lds) {
  constexpr int NBI = NFRAG;
  bf16_t* As = (bf16_t*)lds;
  bf16_t* Bs = As + 128 * 72;
  const int t = tid_opaque(), lane = t & 63, w = t >> 6, wr = w >> 1, wc = w & 1, fr = lane & 15, fq = lane >> 4;
  const int lc = t & 7, lr = t >> 3;
  const bf16_t* Ap = A + (size_t)lr * lda + lc * 8;
  const bf16_t* Bp = Bt + (size_t)lr * K + lc * 8;
  u32x4 ra[4], rb[NBI];
  float ssq[4] = {0.f, 0.f, 0.f, 0.f};
#pragma unroll
  for (int mi = 0; mi < 4; ++mi)
#pragma unroll
    for (int ni = 0; ni < NFRAG; ++ni) acc[mi][ni] = (f32x4){0.f, 0.f, 0.f, 0.f};
  const int nk = K >> 6;
#pragma unroll
  for (int i = 0; i < 4; ++i) ra[i] = *(const u32x4*)(Ap + (size_t)(32 * i) * lda);
#pragma unroll
  for (int i = 0; i < NBI; ++i) rb[i] = (lr + 32 * i < nvalid) ? *(const u32x4*)(Bp + (size_t)(32 * i) * K) : (u32x4){0u, 0u, 0u, 0u};
  for (int kt = 0; kt < nk; ++kt) {
    __syncthreads();
#pragma unroll
    for (int i = 0; i < 4; ++i) {
      *(u32x4*)(As + (lr + 32 * i) * 72 + lc * 8) = ra[i];
      if (SUMSQ) { float v[8]; unpack8(ra[i], v);
#pragma unroll
        for (int e = 0; e < 8; ++e) ssq[i] += v[e] * v[e]; }
    }
#pragma unroll
    for (int i = 0; i < NBI; ++i) *(u32x4*)(Bs + (lr + 32 * i) * 72 + lc * 8) = rb[i];
    __syncthreads();
    if (kt + 1 < nk) {
      const int ko = (kt + 1) * 64;
#pragma unroll
      for (int i = 0; i < 4; ++i) ra[i] = *(const u32x4*)(Ap + (size_t)(32 * i) * lda + ko);
#pragma unroll
      for (int i = 0; i < NBI; ++i) rb[i] = (lr + 32 * i < nvalid) ? *(const u32x4*)(Bp + (size_t)(32 * i) * K + ko) : (u32x4){0u, 0u, 0u, 0u};
    }
#pragma unroll
    for (int kk = 0; kk < 2; ++kk) {
      bf16x8 af[4], bfr[NFRAG];
#pragma unroll
      for (int mi = 0; mi < 4; ++mi) af[mi] = *(const bf16x8*)(As + (wr * 64 + mi * 16 + fr) * 72 + kk * 32 + fq * 8);
#pragma unroll
      for (int ni = 0; ni < NFRAG; ++ni) bfr[ni] = *(const bf16x8*)(Bs + (wc * NFRAG * 16 + ni * 16 + fr) * 72 + kk * 32 + fq * 8);
#pragma unroll
      for (int mi = 0; mi < 4; ++mi)
#pragma unroll
        for (int ni = 0; ni < NFRAG; ++ni) acc[mi][ni] = MFMA16(af[mi], bfr[ni], acc[mi][ni]);
    }
  }
  constexpr int CP = 32 * NFRAG + 4;
  float* Cs = (float*)lds;
  __syncthreads();
#pragma unroll
  for (int mi = 0; mi < 4; ++mi)
#pragma unroll
    for (int ni = 0; ni < NFRAG; ++ni)
#pragma unroll
      for (int jj = 0; jj < 4; ++jj) Cs[(wr * 64 + mi * 16 + fq * 4 + jj) * CP + wc * NFRAG * 16 + ni * 16 + fr] = acc[mi][ni][jj];
  if (SUMSQ) {
    float* rowstat = (float*)(lds + ROWSTAT_OFF);
#pragma unroll
    for (int i = 0; i < 4; ++i) {
      float s = ssq[i];
      s += __shfl_xor(s, 1); s += __shfl_xor(s, 2); s += __shfl_xor(s, 4);
      if (lc == 0) rowstat[lr + 32 * i] = rsqrtf(s / (float)K + EPS);
    }
  }
  __syncthreads();
}

DI void rope8(float* v, const float* pv, const float* RC, const float* RS, int pos, int a, int half) {
  const f32x4 c0 = *(const f32x4*)(RC + pos * 16 + a * 8), c1 = *(const f32x4*)(RC + pos * 16 + a * 8 + 4);
  const f32x4 s0 = *(const f32x4*)(RS + pos * 16 + a * 8), s1 = *(const f32x4*)(RS + pos * 16 + a * 8 + 4);
  const float cs[8] = {c0.x, c0.y, c0.z, c0.w, c1.x, c1.y, c1.z, c1.w};
  const float sn[8] = {s0.x, s0.y, s0.z, s0.w, s1.x, s1.y, s1.z, s1.w};
#pragma unroll
  for (int e = 0; e < 8; ++e) v[e] = (half == 0) ? (v[e] * cs[e] - pv[e] * sn[e]) : (v[e] * cs[e] + pv[e] * sn[e]);
}


DI void xcd_tile(int v, int MPX, int NT, int MC, int& mt, int& nt) {
  const int x = v & 7, L = v >> 3;
  const int c = L / (MC * NT), base = c * MC;
  const int rows = min(MC, MPX - base), rem = L - c * MC * NT;
  nt = rem / rows;
  mt = x * MPX + base + rem % rows;
}

struct TileDesc { const bf16_t* A; const bf16_t* B; int nvalid; };

template <int NFRAG>
DI void g_issue(u32x4 (&ra)[4], u32x4 (&rb)[NFRAG], const bf16_t* cA, const bf16_t* cB, int cnv, int lda, int K, int ko, int lr) {
#pragma unroll
  for (int i = 0; i < 4; ++i) ra[i] = *(const u32x4*)(cA + (size_t)(32 * i) * lda + ko);
#pragma unroll
  for (int i = 0; i < NFRAG; ++i) { const int ro = (lr + 32 * i < cnv) ? 32 * i : 0;
    rb[i] = *(const u32x4*)(cB + (size_t)ro * K + ko); }
}

constexpr int GP = 80;

template <int NFRAG, bool SUMSQ>
DI void g_write(const u32x4 (&ra)[4], const u32x4 (&rb)[NFRAG], float (&ssq)[4], bf16_t* As, bf16_t* Bs, int lr, int lc) {
#pragma unroll
  for (int i = 0; i < 4; ++i) {
    *(u32x4*)(As + (lr + 32 * i) * GP + lc * 8) = ra[i];
    if (SUMSQ) {
      ssq[i] = __builtin_amdgcn_fdot2_f32_bf16(__builtin_bit_cast(bf16v2_t, ra[i].x), __builtin_bit_cast(bf16v2_t, ra[i].x), ssq[i], false);
      ssq[i] = __builtin_amdgcn_fdot2_f32_bf16(__builtin_bit_cast(bf16v2_t, ra[i].y), __builtin_bit_cast(bf16v2_t, ra[i].y), ssq[i], false);
      ssq[i] = __builtin_amdgcn_fdot2_f32_bf16(__builtin_bit_cast(bf16v2_t, ra[i].z), __builtin_bit_cast(bf16v2_t, ra[i].z), ssq[i], false);
      ssq[i] = __builtin_amdgcn_fdot2_f32_bf16(__builtin_bit_cast(bf16v2_t, ra[i].w), __builtin_bit_cast(bf16v2_t, ra[i].w), ssq[i], false);
    }
  }
#pragma unroll
  for (int i = 0; i < NFRAG; ++i) *(u32x4*)(Bs + (lr + 32 * i) * GP + lc * 8) = rb[i];
}

template <int NFRAG>
DI void g_read(bf16x8 (&af)[2][4], bf16x8 (&bfr)[2][NFRAG], const bf16_t* As, const bf16_t* Bs, int wr, int wc, int fr, int fq) {
#pragma unroll
  for (int kk = 0; kk < 2; ++kk) {
#pragma unroll
    for (int mi = 0; mi < 4; ++mi) af[kk][mi] = *(const bf16x8*)(As + (wr * 64 + mi * 16 + fr) * GP + kk * 32 + fq * 8);
#pragma unroll
    for (int ni = 0; ni < NFRAG; ++ni) bfr[kk][ni] = *(const bf16x8*)(Bs + (wc * NFRAG * 16 + ni * 16 + fr) * GP + kk * 32 + fq * 8);
  }
}

template <int NFRAG>
DI void g_mma(f32x4 (&acc)[4][NFRAG], const bf16x8 (&af)[2][4], const bf16x8 (&bfr)[2][NFRAG]) {
#pragma unroll
  for (int kk = 0; kk < 2; ++kk)
#pragma unroll
    for (int mi = 0; mi < 4; ++mi)
#pragma unroll
      for (int ni = 0; ni < NFRAG; ++ni) acc[mi][ni] = MFMA16(af[kk][mi], bfr[kk][ni], acc[mi][ni]);
}

template <int NFRAG, bool SUMSQ, class OPS>
DI void gemm_stream(int ntiles, int lda, int K, const OPS& ops, unsigned char* lds, int rot = 0) {
  bf16_t* As = (bf16_t*)lds;
  bf16_t* Bs = As + 128 * GP;
  const int t = tid_opaque(), lane = t & 63, w = t >> 6, wr = w >> 1, wc = w & 1, fr = lane & 15, fq = lane >> 4;
  const int lc = t & 7, lr = t >> 3;
  const int nk = K >> 6;
  const int G = gridDim.x;
  const int vb = (int)((blockIdx.x + (unsigned)rot) % gridDim.x);
  int lt = vb, lk = 0;
  const bf16_t *cA = nullptr, *cB = nullptr; int cnv = 0;
  if (lt >= ntiles) return;
  { const TileDesc d = ops.tile(lt); cA = d.A + (size_t)lr * lda + lc * 8; cB = d.B + (size_t)lr * K + lc * 8; cnv = d.nvalid; }
  u32x4 ra[4], rb[NFRAG];
#define G_ADVANCE() do { ++lk; if (lk == nk) { lk = 0; lt += G; if (lt < ntiles) { const TileDesc d = ops.tile(lt); cA = d.A + (size_t)lr * lda + lc * 8; cB = d.B + (size_t)lr * K + lc * 8; cnv = d.nvalid; } } } while (0)
  g_issue<NFRAG>(ra, rb, cA, cB, cnv, lda, K, lk * 64, lr);
  G_ADVANCE();
#pragma unroll 1
  for (int tile = vb; tile < ntiles; tile += G) {
    f32x4 acc[4][NFRAG];
    float ssq[4] = {0.f, 0.f, 0.f, 0.f};
#pragma unroll
    for (int mi = 0; mi < 4; ++mi)
#pragma unroll
      for (int ni = 0; ni < NFRAG; ++ni) acc[mi][ni] = (f32x4){0.f, 0.f, 0.f, 0.f};
    __syncthreads();
    g_write<NFRAG, SUMSQ>(ra, rb, ssq, As, Bs, lr, lc);
    g_issue<NFRAG>(ra, rb, cA, cB, cnv, lda, K, lk * 64, lr);
    G_ADVANCE();
    __syncthreads();
#pragma unroll 1
    for (int kt = 0; kt < nk - 1; ++kt) {
      bf16x8 af[2][4], bfr[2][NFRAG];
      g_read<NFRAG>(af, bfr, As, Bs, wr, wc, fr, fq);
      __syncthreads();
      g_write<NFRAG, SUMSQ>(ra, rb, ssq, As, Bs, lr, lc);
      g_issue<NFRAG>(ra, rb, cA, cB, cnv, lda, K, lk * 64, lr);
      G_ADVANCE();
      g_mma<NFRAG>(acc, af, bfr);
      __syncthreads();
    }
    {
      bf16x8 af[2][4], bfr[2][NFRAG];
      g_read<NFRAG>(af, bfr, As, Bs, wr, wc, fr, fq);
      g_mma<NFRAG>(acc, af, bfr);
    }
#undef G_ADVANCE
    constexpr int CP = 32 * NFRAG + 4;
    float* Cs = (float*)lds;
    __syncthreads();
#pragma unroll
    for (int mi = 0; mi < 4; ++mi)
#pragma unroll
      for (int ni = 0; ni < NFRAG; ++ni)
#pragma unroll
        for (int jj = 0; jj < 4; ++jj) Cs[(wr * 64 + mi * 16 + fq * 4 + jj) * CP + wc * NFRAG * 16 + ni * 16 + fr] = acc[mi][ni][jj];
    if (SUMSQ) {
      float* rowstat = (float*)(lds + ROWSTAT_OFF);
#pragma unroll
      for (int i = 0; i < 4; ++i) {
        float sv = ssq[i];
        sv += __shfl_xor(sv, 1); sv += __shfl_xor(sv, 2); sv += __shfl_xor(sv, 4);
        if (lc == 0) rowstat[lr + 32 * i] = rsqrtf(sv / (float)K + EPS);
      }
    }
    __syncthreads();
    ops.epi(tile, lds);
  }
}


template <int NFRAG, class OPS>
DI void gemm_glds(int ntiles, int lda, int K, const OPS& ops, unsigned char* lds, int rot = 0) {
  const int t = tid_opaque(), lane = t & 63, w = t >> 6, wr = w >> 1, wc = w & 1, fr = lane & 15, fq = lane >> 4;
  const int nk = K >> 6;
  const int G = gridDim.x;
  const int vb = (int)((blockIdx.x + (unsigned)rot) % gridDim.x);
  const int srow = t >> 3, skc = (t & 7) ^ ((t >> 3) & 7);
  constexpr int STAGE = 32768, BOFF = 16384;
#pragma unroll 1
  for (int tile = vb; tile < ntiles; tile += G) {
    const TileDesc d = ops.tile(tile);
    const bf16_t* gA = d.A + (size_t)srow * lda + skc * 8;
    const bf16_t* gB = d.B + (size_t)srow * K + skc * 8;
    const int cnv = d.nvalid;
    f32x4 acc[4][NFRAG];
#pragma unroll
    for (int mi = 0; mi < 4; ++mi)
#pragma unroll
      for (int ni = 0; ni < NFRAG; ++ni) acc[mi][ni] = (f32x4){0.f, 0.f, 0.f, 0.f};
    __syncthreads();
#define GLDS_ISSUE(stg, ko) do { \
      _Pragma("unroll") for (int i = 0; i < 4; ++i) \
        __builtin_amdgcn_global_load_lds((const unsigned*)(gA + (size_t)(32 * i) * lda + (ko)), (__attribute__((address_space(3))) unsigned*)(lds + (stg) * STAGE + (i * 256 + t) * 16), 16, 0, 0); \
      _Pragma("unroll") for (int i = 0; i < NFRAG; ++i) { const int ro = (srow + 32 * i < cnv) ? 32 * i : 0; \
        __builtin_amdgcn_global_load_lds((const unsigned*)(gB + (size_t)ro * K + (ko)), (__attribute__((address_space(3))) unsigned*)(lds + (stg) * STAGE + BOFF + (i * 256 + t) * 16), 16, 0, 0); } \
    } while (0)
    GLDS_ISSUE(0, 0);
    asm volatile("s_waitcnt vmcnt(0)" ::: "memory");
    __syncthreads();
#pragma unroll 1
    for (int kt = 0; kt < nk; ++kt) {
      const int sg = kt & 1;
      if (kt + 1 < nk) GLDS_ISSUE(sg ^ 1, (kt + 1) * 64);
      const unsigned char* As = lds + sg * STAGE;
      const unsigned char* Bs = As + BOFF;
#pragma unroll
      for (int kk = 0; kk < 2; ++kk) {
        bf16x8 af[4], bfr[NFRAG];
        const int sw = ((kk * 4 + fq) ^ (fr & 7)) * 16;
#pragma unroll
        for (int mi = 0; mi < 4; ++mi) af[mi] = *(const bf16x8*)(As + (wr * 64 + mi * 16 + fr) * 128 + sw);
#pragma unroll
        for (int ni = 0; ni < NFRAG; ++ni) bfr[ni] = *(const bf16x8*)(Bs + (wc * NFRAG * 16 + ni * 16 + fr) * 128 + sw);
#pragma unroll
        for (int mi = 0; mi < 4; ++mi)
#pragma unroll
          for (int ni = 0; ni < NFRAG; ++ni) acc[mi][ni] = MFMA16(af[mi], bfr[ni], acc[mi][ni]);
      }
      asm volatile("s_waitcnt vmcnt(0)" ::: "memory");
      __syncthreads();
    }
#undef GLDS_ISSUE
    constexpr int CP = 32 * NFRAG + 4;
    float* Cs = (float*)lds;
#pragma unroll
    for (int mi = 0; mi < 4; ++mi)
#pragma unroll
      for (int ni = 0; ni < NFRAG; ++ni)
#pragma unroll
        for (int jj = 0; jj < 4; ++jj) Cs[(wr * 64 + mi * 16 + fq * 4 + jj) * CP + wc * NFRAG * 16 + ni * 16 + fr] = acc[mi][ni][jj];
    __syncthreads();
    ops.epi(tile, lds);
  }
}


template <int NFRAG, class OPS, bool SUMSQ = false, bool LDSEPI = false>
DI void gemm_glds2(int ntiles, int lda, int K, const OPS& ops, unsigned char* lds, int rot = 0) {
  const int t = tid_opaque(), lane = t & 63, w = t >> 6, wr = w >> 1, wc = w & 1, fr = lane & 15, fq = lane >> 4;
  const int nk = K >> 6;
  const int G = gridDim.x;
  const int vb = (int)((blockIdx.x + (unsigned)rot) % gridDim.x);
  const int srow = t >> 3, skc = (t & 7) ^ ((t >> 3) & 7);
  constexpr int STAGE = 32768, BOFF = 16384;
  int tile = vb;
  if (tile >= ntiles) return;
  const bf16_t *gA, *gB; int cnv;
  { const TileDesc d = ops.tile(tile); gA = d.A + (size_t)srow * lda + skc * 8; gB = d.B + (size_t)srow * K + skc * 8; cnv = d.nvalid; }
#define GLDS_ISSUE(stg, ko) do { \
    _Pragma("unroll") for (int i = 0; i < 4; ++i) \
      __builtin_amdgcn_global_load_lds((const unsigned*)(gA + (size_t)(32 * i) * lda + (ko)), (__attribute__((address_space(3))) unsigned*)(lds + (stg) * STAGE + (i * 256 + t) * 16), 16, 0, 0); \
    _Pragma("unroll") for (int i = 0; i < NFRAG; ++i) { const int ro = (srow + 32 * i < cnv) ? 32 * i : 0; \
      __builtin_amdgcn_global_load_lds((const unsigned*)(gB + (size_t)ro * K + (ko)), (__attribute__((address_space(3))) unsigned*)(lds + (stg) * STAGE + BOFF + (i * 256 + t) * 16), 16, 0, 0); } \
  } while (0)
  __syncthreads();
  GLDS_ISSUE(0, 0);
#pragma unroll 1
  for (;;) {
    f32x4 acc[4][NFRAG];
#pragma unroll
    for (int mi = 0; mi < 4; ++mi)
#pragma unroll
      for (int ni = 0; ni < NFRAG; ++ni) acc[mi][ni] = (f32x4){0.f, 0.f, 0.f, 0.f};
    float ssq[4] = {0.f, 0.f, 0.f, 0.f};
    asm volatile("s_waitcnt vmcnt(0)" ::: "memory");
    __syncthreads();
#pragma unroll 1
    for (int kt = 0; kt < nk; ++kt) {
      const int sg = kt & 1;
      const unsigned char* As = lds + sg * STAGE;
      const unsigned char* Bs = As + BOFF;
#pragma unroll
      for (int kk = 0; kk < 2; ++kk) {
        bf16x8 af[4], bfr[NFRAG];
        const int sw = ((kk * 4 + fq) ^ (fr & 7)) * 16;
#pragma unroll
        for (int mi = 0; mi < 4; ++mi) af[mi] = *(const bf16x8*)(As + (wr * 64 + mi * 16 + fr) * 128 + sw);
#pragma unroll
        for (int ni = 0; ni < NFRAG; ++ni) bfr[ni] = *(const bf16x8*)(Bs + (wc * NFRAG * 16 + ni * 16 + fr) * 128 + sw);
        if (SUMSQ) {
#pragma unroll
          for (int mi = 0; mi < 4; ++mi) {
            const u32x4 aw = __builtin_bit_cast(u32x4, af[mi]);
            ssq[mi] = __builtin_amdgcn_fdot2_f32_bf16(__builtin_bit_cast(bf16v2_t, aw.x), __builtin_bit_cast(bf16v2_t, aw.x), ssq[mi], false);
            ssq[mi] = __builtin_amdgcn_fdot2_f32_bf16(__builtin_bit_cast(bf16v2_t, aw.y), __builtin_bit_cast(bf16v2_t, aw.y), ssq[mi], false);
            ssq[mi] = __builtin_amdgcn_fdot2_f32_bf16(__builtin_bit_cast(bf16v2_t, aw.z), __builtin_bit_cast(bf16v2_t, aw.z), ssq[mi], false);
            ssq[mi] = __builtin_amdgcn_fdot2_f32_bf16(__builtin_bit_cast(bf16v2_t, aw.w), __builtin_bit_cast(bf16v2_t, aw.w), ssq[mi], false);
          }
        }
        if (kk == 0 && kt + 1 < nk) GLDS_ISSUE(sg ^ 1, (kt + 1) * 64);
#pragma unroll
        for (int mi = 0; mi < 4; ++mi)
#pragma unroll
          for (int ni = 0; ni < NFRAG; ++ni) acc[mi][ni] = MFMA16(af[mi], bfr[ni], acc[mi][ni]);
      }
      asm volatile("s_waitcnt vmcnt(0)" ::: "memory");
      __syncthreads();
    }
    constexpr int CP = 32 * NFRAG + 4;
    float* Cs = (float*)lds;
#pragma unroll
    for (int mi = 0; mi < 4; ++mi)
#pragma unroll
      for (int ni = 0; ni < NFRAG; ++ni)
#pragma unroll
        for (int jj = 0; jj < 4; ++jj) Cs[(wr * 64 + mi * 16 + fq * 4 + jj) * CP + wc * NFRAG * 16 + ni * 16 + fr] = acc[mi][ni][jj];
    if (SUMSQ) {
      float* rowstat = (float*)(lds + ROWSTAT_OFF);
#pragma unroll
      for (int mi = 0; mi < 4; ++mi) {
        float sv = ssq[mi];
        sv += __shfl_xor(sv, 16); sv += __shfl_xor(sv, 32);
        if (wc == 0 && fq == 0) rowstat[wr * 64 + mi * 16 + fr] = rsqrtf(sv / (float)K + EPS);
      }
    }
    __syncthreads();
    const int cur = tile;
    if (LDSEPI) {
      ops.epi_lds(cur, lds);
      __syncthreads();
      tile += G;
      const bool more = tile < ntiles;
      if (more) {
        const TileDesc d = ops.tile(tile); gA = d.A + (size_t)srow * lda + skc * 8; gB = d.B + (size_t)srow * K + skc * 8; cnv = d.nvalid;
        GLDS_ISSUE(0, 0);
      }
      if (!more) break;
    } else {
      float c[64];
      ops.epi_read(cur, lds, c);
      __syncthreads();
      tile += G;
      const bool more = tile < ntiles;
      if (more) {
        const TileDesc d = ops.tile(tile); gA = d.A + (size_t)srow * lda + skc * 8; gB = d.B + (size_t)srow * K + skc * 8; cnv = d.nvalid;
        GLDS_ISSUE(0, 0);
      }
      ops.epi_write(cur, c);
      if (!more) break;
    }
  }
#undef GLDS_ISSUE
}

struct EvWinOps2 {
  const Params* pp;
  DI void epi_lds(int, unsigned char*) const {}
  DI TileDesc tile(int id) const {
    int mt, nt; xcd_tile(id, 18, 25, 6, mt, nt);
    TileDesc d; d.A = (const bf16_t*)(pp->ws + WS_R1) + (size_t)mt * 128 * D; d.B = (const bf16_t*)(pp->ws + WS_WT + WT_EV_IN) + (size_t)nt * 128 * D; d.nvalid = EVEN_IN - nt * 128;
    return d;
  }
  DI void epi_read(int id, unsigned char* lds, float (&c)[64]) const {
    const int t = tid_opaque();
    const float* Cs = (const float*)lds;
#pragma unroll
    for (int it = 0; it < 8; ++it) {
      const int row = (t >> 4) + 16 * it, ch = t & 15;
      *(f32x4*)(c + it * 8) = *(const f32x4*)(Cs + row * 132 + ch * 8);
      *(f32x4*)(c + it * 8 + 4) = *(const f32x4*)(Cs + row * 132 + ch * 8 + 4);
    }
  }
  DI void epi_write(int id, const float (&c)[64]) const {
    int mt, nt; xcd_tile(id, 18, 25, 6, mt, nt);
    const int m0 = mt * 128, n0 = nt * 128;
    bf16_t* U1 = (bf16_t*)(pp->ws + WS_R2);
    bf16_t* U2 = (bf16_t*)(pp->ws + WS_U2);
    const int t = tid_opaque();
    const int ch = t & 15, col = n0 + ch * 8;
    if (col < EVEN_IN) {
#pragma unroll
      for (int it = 0; it < 8; ++it) {
        const int m = m0 + (t >> 4) + 16 * it;
        bf16_t* dst = (col < U1W) ? U1 + (size_t)m * U1W + col : U2 + (size_t)m * U2W + (col - U1W);
        *(u32x4*)dst = pack8(c + it * 8);
      }
    }
  }
};

struct WoutOps2 {
  const Params* pp; int layer;
  DI void epi_lds(int, unsigned char*) const {}
  DI TileDesc tile(int id) const {
    const bool even = (layer & 1) == 0;
    int mt, nt; xcd_tile(id, (layer == 3) ? 16 : 18, 8, (layer == 3) ? 8 : 6, mt, nt);
    TileDesc d; d.A = (const bf16_t*)(pp->ws + (even ? WS_R2 : WS_OH)) + (size_t)mt * 128 * D;
    d.B = (const bf16_t*)(pp->ws + WS_WT + (even ? WT_EV_OUT : WT_OD_OUT)) + (size_t)nt * 128 * D; d.nvalid = 128;
    return d;
  }
  DI void epi_read(int id, unsigned char* lds, float (&c)[64]) const {
    const int t = tid_opaque();
    const float* Cs = (const float*)lds;
#pragma unroll
    for (int it = 0; it < 16; ++it) {
      const int row = (t >> 5) + 8 * it, c4 = t & 31;
      *(f32x4*)(c + it * 4) = *(const f32x4*)(Cs + row * 132 + c4 * 4);
    }
  }
  DI void epi_write(int id, const float (&c)[64]) const {
    const Params& p = *pp;
    int mt, nt; xcd_tile(id, (layer == 3) ? 16 : 18, 8, (layer == 3) ? 8 : 6, mt, nt);
    const int m0 = mt * 128, n0 = nt * 128;
    const float* MOD = (const float*)(p.ws + WS_MOD);
    float* CX = (float*)(p.ws + WS_CX);
    const int t = tid_opaque();
    const bool lat = m0 < NLAT;
    const int r = lat ? (m0 >> 11) : 8;
    const int n = n0 + (t & 31) * 4;
    const float* xin = (lat ? ((layer == 0 ? p.x : p.out) + (size_t)m0 * D) : ((layer == 0 ? p.ctx : CX) + (size_t)(m0 - NLAT) * D)) + n;
    float* xout = (lat ? (p.out + (size_t)m0 * D) : (CX + (size_t)(m0 - NLAT) * D)) + n;
    const f32x4 g = *(const f32x4*)(MOD + (size_t)(layer * 9 + r) * 3072 + 2048 + n);
#pragma unroll
    for (int half = 0; half < 2; ++half) {
      f32x4 xi[8];
#pragma unroll
      for (int q = 0; q < 8; ++q) xi[q] = *(const f32x4*)(xin + (size_t)((t >> 5) + 8 * (half * 8 + q)) * D);
#pragma unroll
      for (int q = 0; q < 8; ++q) {
        const int it = half * 8 + q;
        f32x4 o; o.x = xi[q].x + g.x * c[it * 4]; o.y = xi[q].y + g.y * c[it * 4 + 1]; o.z = xi[q].z + g.z * c[it * 4 + 2]; o.w = xi[q].w + g.w * c[it * 4 + 3];
        *(f32x4*)(xout + (size_t)((t >> 5) + 8 * it) * D) = o;
      }
    }
  }
};

struct EvWinOps {
  const Params* pp;
  DI TileDesc tile(int id) const {
    int mt, nt; xcd_tile(id, 18, 25, 6, mt, nt);
    TileDesc d; d.A = (const bf16_t*)(pp->ws + WS_R1) + (size_t)mt * 128 * D; d.B = (const bf16_t*)(pp->ws + WS_WT + WT_EV_IN) + (size_t)nt * 128 * D; d.nvalid = EVEN_IN - nt * 128;
    return d;
  }
  DI void epi(int id, unsigned char* lds) const {
    int mt, nt; xcd_tile(id, 18, 25, 6, mt, nt);
    const int m0 = mt * 128, n0 = nt * 128;
    bf16_t* U1 = (bf16_t*)(pp->ws + WS_R2);
    bf16_t* U2 = (bf16_t*)(pp->ws + WS_U2);
    const int t = tid_opaque();
    const float* Cs = (const float*)lds;
    for (int idx = t; idx < 128 * 16; idx += 256) {
      const int row = idx >> 4, ch = idx & 15, col = n0 + ch * 8;
      if (col < EVEN_IN) {
        float v[8];
        *(f32x4*)v = *(const f32x4*)(Cs + row * 132 + ch * 8);
        *(f32x4*)(v + 4) = *(const f32x4*)(Cs + row * 132 + ch * 8 + 4);
        const int m = m0 + row;
        bf16_t* dst = (col < U1W) ? U1 + (size_t)m * U1W + col : U2 + (size_t)m * U2W + (col - U1W);
        *(u32x4*)dst = pack8(v);
      }
    }
  }
};
DI void phase_ev_win(const Params& p, unsigned char* lds) {
  EvWinOps2 ops; ops.pp = &p;
  gemm_glds2<4>(144 * 25, D, D, ops, lds);
}

struct WoutOps {
  const Params* pp; int layer;
  DI TileDesc tile(int id) const {
    const bool even = (layer & 1) == 0;
    int mt, nt; xcd_tile(id, (layer == 3) ? 16 : 18, 8, (layer == 3) ? 8 : 6, mt, nt);
    TileDesc d; d.A = (const bf16_t*)(pp->ws + (even ? WS_R2 : WS_OH)) + (size_t)mt * 128 * D;
    d.B = (const bf16_t*)(pp->ws + WS_WT + (even ? WT_EV_OUT : WT_OD_OUT)) + (size_t)nt * 128 * D; d.nvalid = 128;
    return d;
  }
  DI void epi(int id, unsigned char* lds) const {
    const Params& p = *pp;
    int mt, nt; xcd_tile(id, (layer == 3) ? 16 : 18, 8, (layer == 3) ? 8 : 6, mt, nt);
    const int m0 = mt * 128, n0 = nt * 128;
    const float* MOD = (const float*)(p.ws + WS_MOD);
    float* CX = (float*)(p.ws + WS_CX);
    const int t = tid_opaque();
    const float* Cs = (const float*)lds;
    const bool lat = m0 < NLAT;
    const int r = lat ? (m0 >> 11) : 8;
    const float* gate = MOD + (size_t)(layer * 9 + r) * 3072 + 2048;
    const float* xin = lat ? ((layer == 0 ? p.x : p.out) + (size_t)m0 * D) : ((layer == 0 ? p.ctx : CX) + (size_t)(m0 - NLAT) * D);
    float* xout = lat ? (p.out + (size_t)m0 * D) : (CX + (size_t)(m0 - NLAT) * D);
    for (int idx = t; idx < 128 * 32; idx += 256) {
      const int row = idx >> 5, c4 = idx & 31, n = n0 + c4 * 4;
      const f32x4 a = *(const f32x4*)(Cs + row * 132 + c4 * 4);
      const f32x4 g = *(const f32x4*)(gate + n);
      const f32x4 xi = *(const f32x4*)(xin + (size_t)row * D + n);
      f32x4 o; o.x = xi.x + g.x * a.x; o.y = xi.y + g.y * a.y; o.z = xi.z + g.z * a.z; o.w = xi.w + g.w * a.w;
      *(f32x4*)(xout + (size_t)row * D + n) = o;
    }
  }
};
DI void phase_wout(const Params& p, int layer, unsigned char* lds) {
  WoutOps2 ops; ops.pp = &p; ops.layer = layer;
  gemm_glds2<4>(((layer == 3) ? 128 : 144) * 8, D, D, ops, lds);
}

DI void ev_q_tile(const Params& p, int j, int mt, int head, unsigned char* lds) {
  const bf16_t* U1 = (const bf16_t*)(p.ws + WS_R2);
  const bf16_t* WT = (const bf16_t*)(p.ws + WS_WT + WT_EV_UQ);
  bf16_t* QA = (bf16_t*)(p.ws + WS_R1 + R1_QA);
  const float* RC = (const float*)(p.ws + WS_ROPEC);
  const float* RS = (const float*)(p.ws + WS_ROPES);
  const int t = tid_opaque(), m0 = mt * 128;
  float* Cs = (float*)lds;
  float* rowstat = (float*)(lds + ROWSTAT_OFF);
  float* rowstat2 = (float*)(lds + ROWSTAT2_OFF);
#pragma unroll 1
  for (int it = 0; it < 4; ++it) {
    const int idx = t + 256 * it, row = idx >> 3, l8 = idx & 7;
    float ss = 0.f;
#pragma unroll
    for (int q = 0; q < 3; ++q) { const f32x4 v = *(const f32x4*)(Cs + row * 100 + l8 * 12 + q * 4); ss += v.x * v.x + v.y * v.y + v.z * v.z + v.w * v.w; }
    ss += __shfl_xor(ss, 1); ss += __shfl_xor(ss, 2); ss += __shfl_xor(ss, 4);
    const float rin = rowstat[row];
    const float rstd2 = rsqrtf(ss * rin * rin * (1.f / 96.f) + EPS);
    if (l8 == 0) rowstat2[row] = rin * rstd2;
  }
  __syncthreads();
  const float* qg = p.ev_q_gain + j * 96;
  int b, pos0; tok_bp(m0, b, pos0);
  const bool lat = m0 < NLAT;
  const float QS = 0.10206207261596575f * LOG2E;
  bf16_t* qdst = QA + ((size_t)(b * 8 + head) * KEYS + pos0) * 96;
  {
    const int ch = t & 7;
    const f32x4 g0 = *(const f32x4*)(qg + ch * 8), g1 = *(const f32x4*)(qg + ch * 8 + 4);
    const float gg[8] = {g0.x, g0.y, g0.z, g0.w, g1.x, g1.y, g1.z, g1.w};
#pragma unroll
    for (int it = 0; it < 4; ++it) {
      const int row = (t >> 3) + 32 * it;
      const float f = rowstat2[row] * QS;
      float v[8];
      *(f32x4*)v = *(const f32x4*)(Cs + row * 100 + ch * 8);
      *(f32x4*)(v + 4) = *(const f32x4*)(Cs + row * 100 + ch * 8 + 4);
#pragma unroll
      for (int e = 0; e < 8; ++e) v[e] *= f * gg[e];
      *(u32x4*)(qdst + (size_t)row * 96 + ch * 8) = pack8(v);
    }
  }
  {
    const int rc = t & 3, ch = 8 + rc, pch = ch ^ 1;
    const f32x4 g0 = *(const f32x4*)(qg + ch * 8), g1 = *(const f32x4*)(qg + ch * 8 + 4);
    const f32x4 h0 = *(const f32x4*)(qg + pch * 8), h1 = *(const f32x4*)(qg + pch * 8 + 4);
    const float gg[8] = {g0.x, g0.y, g0.z, g0.w, g1.x, g1.y, g1.z, g1.w};
    const float pg[8] = {h0.x, h0.y, h0.z, h0.w, h1.x, h1.y, h1.z, h1.w};
    f32x4 cs4[2][2], sn4[2][2];
    if (lat) {
#pragma unroll
      for (int it = 0; it < 2; ++it) {
        const int pos = pos0 + (t >> 2) + 64 * it;
        cs4[it][0] = *(const f32x4*)(RC + pos * 16 + (rc >> 1) * 8); cs4[it][1] = *(const f32x4*)(RC + pos * 16 + (rc >> 1) * 8 + 4);
        sn4[it][0] = *(const f32x4*)(RS + pos * 16 + (rc >> 1) * 8); sn4[it][1] = *(const f32x4*)(RS + pos * 16 + (rc >> 1) * 8 + 4);
      }
    }
#pragma unroll
    for (int it = 0; it < 2; ++it) {
      const int row = (t >> 2) + 64 * it;
      const float f = rowstat2[row];
      float v[8], pv[8];
      *(f32x4*)v = *(const f32x4*)(Cs + row * 100 + ch * 8);
      *(f32x4*)(v + 4) = *(const f32x4*)(Cs + row * 100 + ch * 8 + 4);
      *(f32x4*)pv = *(const f32x4*)(Cs + row * 100 + pch * 8);
      *(f32x4*)(pv + 4) = *(const f32x4*)(Cs + row * 100 + pch * 8 + 4);
#pragma unroll
      for (int e = 0; e < 8; ++e) { v[e] *= f * gg[e]; pv[e] *= f * pg[e]; }
      if (lat) {
        const float cs[8] = {cs4[it][0].x, cs4[it][0].y, cs4[it][0].z, cs4[it][0].w, cs4[it][1].x, cs4[it][1].y, cs4[it][1].z, cs4[it][1].w};
        const float sn[8] = {sn4[it][0].x, sn4[it][0].y, sn4[it][0].z, sn4[it][0].w, sn4[it][1].x, sn4[it][1].y, sn4[it][1].z, sn4[it][1].w};
#pragma unroll
        for (int e = 0; e < 8; ++e) v[e] = ((rc & 1) == 0) ? (v[e] * cs[e] - pv[e] * sn[e]) : (v[e] * cs[e] + pv[e] * sn[e]);
      }
#pragma unroll
      for (int e = 0; e < 8; ++e) v[e] *= QS;
      *(u32x4*)(qdst + (size_t)row * 96 + ch * 8) = pack8(v);
    }
  }
}

DI void ev_kv_tile(const Params& p, int j, int mt, int head, unsigned char* lds) {
  const bf16_t* U1 = (const bf16_t*)(p.ws + WS_R2);
  const bf16_t* WT = (const bf16_t*)(p.ws + WS_WT + WT_EV_UKV);
  bf16_t* KA = (bf16_t*)(p.ws + WS_R1 + R1_KA);
  bf16_t* VAT = (bf16_t*)(p.ws + WS_R1 + R1_VAT);
  const float* RC = (const float*)(p.ws + WS_ROPEC);
  const float* RS = (const float*)(p.ws + WS_ROPES);
  const int t = tid_opaque(), m0 = mt * 128;
  float* Cs = (float*)lds;
  float* rowstat = (float*)(lds + ROWSTAT_OFF);
  float* rowstat2 = (float*)(lds + ROWSTAT2_OFF);
  {
    const int l8 = t & 7;
    u32x2 kr[4];
#pragma unroll
    for (int it = 0; it < 4; ++it) kr[it] = *(const u32x2*)(U1 + (size_t)(m0 + (t >> 3) + 32 * it) * U1W + 1024 + l8 * 4);
#pragma unroll
    for (int it = 0; it < 4; ++it) {
      const int row = (t >> 3) + 32 * it;
      const float rin = rowstat[row];
      float ss = 0.f;
#pragma unroll
      for (int q = 0; q < 2; ++q) { const f32x4 v = *(const f32x4*)(Cs + row * 132 + l8 * 8 + q * 4); ss += v.x * v.x + v.y * v.y + v.z * v.z + v.w * v.w; }
      ss *= rin * rin;
      const float k0 = bflo(kr[it].x), k1 = bfhi(kr[it].x), k2 = bflo(kr[it].y), k3 = bfhi(kr[it].y);
      ss += k0 * k0 + k1 * k1 + k2 * k2 + k3 * k3;
      ss += __shfl_xor(ss, 1); ss += __shfl_xor(ss, 2); ss += __shfl_xor(ss, 4);
      if (l8 == 0) rowstat2[row] = rsqrtf(ss * (1.f / 96.f) + EPS);
    }
  }
  __syncthreads();
  const float* kg = p.ev_k_gain + j * 96;
  int b, pos0; tok_bp(m0, b, pos0);
  const bool lat = m0 < NLAT;
  bf16_t* kdst = KA + ((size_t)(b * 8 + head) * KEYS + pos0) * 96;
  {
    const int ch = t & 7;
    const f32x4 g0 = *(const f32x4*)(kg + ch * 8), g1 = *(const f32x4*)(kg + ch * 8 + 4);
    const float gg[8] = {g0.x, g0.y, g0.z, g0.w, g1.x, g1.y, g1.z, g1.w};
#pragma unroll
    for (int it = 0; it < 4; ++it) {
      const int row = (t >> 3) + 32 * it;
      const float f = rowstat[row] * rowstat2[row];
      float v[8];
      *(f32x4*)v = *(const f32x4*)(Cs + row * 132 + ch * 8);
      *(f32x4*)(v + 4) = *(const f32x4*)(Cs + row * 132 + ch * 8 + 4);
#pragma unroll
      for (int e = 0; e < 8; ++e) v[e] *= f * gg[e];
      *(u32x4*)(kdst + (size_t)row * 96 + ch * 8) = pack8(v);
    }
  }
  {
    const int rc = t & 3, prc = rc ^ 1;
    const f32x4 g0 = *(const f32x4*)(kg + 64 + rc * 8), g1 = *(const f32x4*)(kg + 64 + rc * 8 + 4);
    const f32x4 h0 = *(const f32x4*)(kg + 64 + prc * 8), h1 = *(const f32x4*)(kg + 64 + prc * 8 + 4);
    const float gg[8] = {g0.x, g0.y, g0.z, g0.w, g1.x, g1.y, g1.z, g1.w};
    const float pg[8] = {h0.x, h0.y, h0.z, h0.w, h1.x, h1.y, h1.z, h1.w};
    u32x4 own[2], par[2];
    f32x4 cs4[2][2], sn4[2][2];
#pragma unroll
    for (int it = 0; it < 2; ++it) {
      const int row = (t >> 2) + 64 * it;
      const bf16_t* krp = U1 + (size_t)(m0 + row) * U1W + 1024;
      own[it] = *(const u32x4*)(krp + rc * 8);
      par[it] = *(const u32x4*)(krp + prc * 8);
      if (lat) {
        const int pos = pos0 + row;
        cs4[it][0] = *(const f32x4*)(RC + pos * 16 + (rc >> 1) * 8); cs4[it][1] = *(const f32x4*)(RC + pos * 16 + (rc >> 1) * 8 + 4);
        sn4[it][0] = *(const f32x4*)(RS + pos * 16 + (rc >> 1) * 8); sn4[it][1] = *(const f32x4*)(RS + pos * 16 + (rc >> 1) * 8 + 4);
      }
    }
#pragma unroll
    for (int it = 0; it < 2; ++it) {
      const int row = (t >> 2) + 64 * it;
      const float rk = rowstat2[row];
      float v[8], pv[8];
      unpack8(own[it], v);
      unpack8(par[it], pv);
#pragma unroll
      for (int e = 0; e < 8; ++e) { v[e] *= rk * gg[e]; pv[e] *= rk * pg[e]; }
      if (lat) {
        const float cs[8] = {cs4[it][0].x, cs4[it][0].y, cs4[it][0].z, cs4[it][0].w, cs4[it][1].x, cs4[it][1].y, cs4[it][1].z, cs4[it][1].w};
        const float sn[8] = {sn4[it][0].x, sn4[it][0].y, sn4[it][0].z, sn4[it][0].w, sn4[it][1].x, sn4[it][1].y, sn4[it][1].z, sn4[it][1].w};
#pragma unroll
        for (int e = 0; e < 8; ++e) v[e] = ((rc & 1) == 0) ? (v[e] * cs[e] - pv[e] * sn[e]) : (v[e] * cs[e] + pv[e] * sn[e]);
      }
      *(u32x4*)(kdst + (size_t)row * 96 + 64 + rc * 8) = pack8(v);
    }
  }
#pragma unroll
  for (int it = 0; it < 4; ++it) {
    const int idx = t + 256 * it, rg = idx & 15, e = idx >> 4;
    float v[8];
#pragma unroll
    for (int q = 0; q < 8; ++q) v[q] = Cs[(rg * 8 + q) * 132 + 64 + e] * rowstat[rg * 8 + q];
    *(u32x4*)(VAT + ((size_t)(b * 8 + head) * 64 + e) * KEYS + pos0 + rg * 8) = pack8(v);
  }
}

struct EvQOps {
  const Params* pp; int j;
  DI TileDesc tile(int id) const {
    int mt, head; xcd_tile(id, 18, 8, 6, mt, head);
    TileDesc d; d.A = (const bf16_t*)(pp->ws + WS_R2) + (size_t)mt * 128 * U1W; d.B = (const bf16_t*)(pp->ws + WS_WT + WT_EV_UQ) + (size_t)(head * 96) * 768; d.nvalid = 96;
    return d;
  }
  DI void epi(int id, unsigned char* lds) const { int mt, head; xcd_tile(id, 18, 8, 6, mt, head); ev_q_tile(*pp, j, mt, head, lds); }
  DI void epi_lds(int id, unsigned char* lds) const { epi(id, lds); }
  DI void epi_read(int, unsigned char*, float (&)[64]) const {}
  DI void epi_write(int, const float (&)[64]) const {}
};
struct EvKvOps {
  const Params* pp; int j;
  DI TileDesc tile(int id) const {
    int mt, head; xcd_tile(id, 18, 8, 6, mt, head);
    TileDesc d; d.A = (const bf16_t*)(pp->ws + WS_R2) + (size_t)mt * 128 * U1W + 768; d.B = (const bf16_t*)(pp->ws + WS_WT + WT_EV_UKV) + (size_t)(head * 128) * 256; d.nvalid = 128;
    return d;
  }
  DI void epi(int id, unsigned char* lds) const { int mt, head; xcd_tile(id, 18, 8, 6, mt, head); ev_kv_tile(*pp, j, mt, head, lds); }
  DI void epi_lds(int id, unsigned char* lds) const { epi(id, lds); }
  DI void epi_read(int, unsigned char*, float (&)[64]) const {}
  DI void epi_write(int, const float (&)[64]) const {}
};

constexpr int GL_QT = 0, GL_KT = 9216, GL_ATT = 18432, GL_VT = 27648, GL_ST = 46080, GL_RS = 64512, GL_SEG = 72704;

DI float log_sigmoid_f(float x) { return fminf(x, 0.f) - __logf(1.f + __expf(-fabsf(x))); }

template <int DIR>
DI float gla_decay(const float (&gw)[16], float gb, unsigned char* lds, float (&bb)[16]) {
  const int t = tid_opaque(), d = t & 63, qd = t >> 6;
  const float* rs = (const float*)(lds + GL_RS);
  float* seg = (float*)(lds + GL_SEG);
  float ssum = 0.f;
#pragma unroll
  for (int i = 0; i < 16; ++i) {
    const int l = qd * 16 + i;
    float lg = gb;
#pragma unroll
    for (int q = 0; q < 4; ++q) {
      const f32x4 rv = *(const f32x4*)(rs + l * 32 + DIR * 16 + q * 4);
      lg += rv.x * gw[q * 4] + rv.y * gw[q * 4 + 1] + rv.z * gw[q * 4 + 2] + rv.w * gw[q * 4 + 3];
    }
    bb[i] = log_sigmoid_f(lg) * (1.f / 16.f);
    ssum += bb[i];
  }
  __syncthreads();
  seg[qd * 64 + d] = ssum;
  __syncthreads();
  const float s0 = seg[d], s1 = seg[64 + d], s2 = seg[128 + d], s3 = seg[192 + d];
  const float tot = s0 + s1 + s2 + s3;
  if (DIR == 0) {
    float off = (qd > 0 ? s0 : 0.f) + (qd > 1 ? s1 : 0.f) + (qd > 2 ? s2 : 0.f);
#pragma unroll
    for (int i = 0; i < 16; ++i) { off += bb[i]; bb[i] = off; }
  } else {
    float off = (qd < 3 ? s3 : 0.f) + (qd < 2 ? s2 : 0.f) + (qd < 1 ? s1 : 0.f);
#pragma unroll
    for (int i = 15; i >= 0; --i) { off += bb[i]; bb[i] = off; }
  }
  return tot;
}

DI int gla_base_row(int b, int c) { return (c < 32) ? b * SEQ + c * 64 : NLAT + b * CTXL + (c - 32) * 64; }
DI int gla_scan_pos(int c, int dir) { return dir == 0 ? ((c >= 32) ? c - 32 : 4 + c) : ((c >= 32) ? 3 - (c - 32) : 4 + (31 - c)); }

struct GlaRaw { u32x4 v[4]; u32x4 r; };
DI void gla_load_raw(GlaRaw& g, const bf16_t* U2, int base_m, int h) {
  const int t = tid_opaque();
  const bf16_t* vrow = U2 + (size_t)(base_m + (t & 63)) * U2W + U2_VB + h * 128 + (t >> 6) * 32;
#pragma unroll
  for (int i = 0; i < 4; ++i) g.v[i] = *(const u32x4*)(vrow + 8 * i);
  g.r = *(const u32x4*)(U2 + (size_t)(base_m + (t >> 2)) * U2W + U2_GLR + (t & 3) * 8);
}
DI void gla_stage_raw(const GlaRaw& g, unsigned char* lds) {
  const int t = tid_opaque();
  float* rs = (float*)(lds + GL_RS);
  bf16_t* vT = (bf16_t*)(lds + GL_VT);
  {
    const int l = t >> 2, q = t & 3;
    float v[8];
    unpack8(g.r, v);
    *(f32x4*)(rs + l * 32 + q * 8) = (f32x4){v[0], v[1], v[2], v[3]};
    *(f32x4*)(rs + l * 32 + q * 8 + 4) = (f32x4){v[4], v[5], v[6], v[7]};
  }
  {
    const int l = t & 63, e0 = (t >> 6) * 32;
#pragma unroll
    for (int i = 0; i < 4; ++i) {
      const unsigned w4[4] = {g.v[i].x, g.v[i].y, g.v[i].z, g.v[i].w};
#pragma unroll
      for (int q = 0; q < 4; ++q) {
        vT[(e0 + 8 * i + 2 * q) * 72 + l] = (bf16_t)(w4[q] & 0xffffu);
        vT[(e0 + 8 * i + 2 * q + 1) * 72 + l] = (bf16_t)(w4[q] >> 16);
      }
    }
  }
}
DI void gla_load_gate(const Params& p, int j, int h, int dir, int d, float (&gw)[16], float& gb) {
  const float* GW = p.ev_gate_w + ((size_t)(j * 2 + dir) * 16) * 256 + h * 64 + d;
#pragma unroll
  for (int r = 0; r < 16; ++r) gw[r] = GW[r * 256];
  gb = p.ev_gate_b[(j * 2 + dir) * 256 + h * 64 + d];
}

DI void gla_g1_item(const Params& p, int j, int item, unsigned char* lds) {
  const int b = item / (4 * NCHUNK), h = (item / NCHUNK) & 3, c = item % NCHUNK;
  const bf16_t* U2 = (const bf16_t*)(p.ws + WS_U2);
  bf16_t* KVST = (bf16_t*)(p.ws + WS_KVST);
  float* DEC = (float*)(p.ws + WS_DEC);
  const int t = tid_opaque(), d = t & 63, qd = t >> 6, lane = t & 63, w = t >> 6, r = lane & 31, hh = lane >> 5;
  const int base_m = gla_base_row(b, c);
  GlaRaw raw; gla_load_raw(raw, U2, base_m, h);
  bf16_t k16[16];
#pragma unroll
  for (int i = 0; i < 16; ++i) k16[i] = U2[(size_t)(base_m + qd * 16 + i) * U2W + U2_KB + h * 64 + d];
  float gw0[16], gw1[16], gb0, gb1;
  gla_load_gate(p, j, h, 0, d, gw0, gb0);
  gla_load_gate(p, j, h, 1, d, gw1, gb1);
  __syncthreads();
  gla_stage_raw(raw, lds);
  __syncthreads();
  const float* rs = (const float*)(lds + GL_RS);
  float* seg0 = (float*)(lds + GL_SEG);
  float* seg1 = (float*)(lds + GL_ATT);
  float b0[16], b1[16];
  float sum0 = 0.f, sum1 = 0.f;
#pragma unroll
  for (int i = 0; i < 16; ++i) {
    const int l = qd * 16 + i;
    float l0 = gb0, l1 = gb1;
#pragma unroll
    for (int q = 0; q < 4; ++q) {
      const f32x4 r0 = *(const f32x4*)(rs + l * 32 + q * 4), r1 = *(const f32x4*)(rs + l * 32 + 16 + q * 4);
      l0 += r0.x * gw0[q * 4] + r0.y * gw0[q * 4 + 1] + r0.z * gw0[q * 4 + 2] + r0.w * gw0[q * 4 + 3];
      l1 += r1.x * gw1[q * 4] + r1.y * gw1[q * 4 + 1] + r1.z * gw1[q * 4 + 2] + r1.w * gw1[q * 4 + 3];
    }
    b0[i] = log_sigmoid_f(l0) * (1.f / 16.f); sum0 += b0[i];
    b1[i] = log_sigmoid_f(l1) * (1.f / 16.f); sum1 += b1[i];
  }
  seg0[qd * 64 + d] = sum0;
  seg1[qd * 64 + d] = sum1;
  __syncthreads();
  float tot0, tot1;
  {
    const float s0 = seg0[d], s1 = seg0[64 + d], s2 = seg0[128 + d], s3 = seg0[192 + d];
    tot0 = s0 + s1 + s2 + s3;
    float off = (qd > 0 ? s0 : 0.f) + (qd > 1 ? s1 : 0.f) + (qd > 2 ? s2 : 0.f);
#pragma unroll
    for (int i = 0; i < 16; ++i) { off += b0[i]; b0[i] = off; }
  }
  {
    const float s0 = seg1[d], s1 = seg1[64 + d], s2 = seg1[128 + d], s3 = seg1[192 + d];
    tot1 = s0 + s1 + s2 + s3;
    float off = (qd < 3 ? s3 : 0.f) + (qd < 2 ? s2 : 0.f) + (qd < 1 ? s1 : 0.f);
#pragma unroll
    for (int i = 15; i >= 0; --i) { off += b1[i]; b1[i] = off; }
  }
  bf16_t* kdT0 = (bf16_t*)(lds + GL_QT);
  bf16_t* kdT1 = (bf16_t*)(lds + GL_KT);
  const bf16_t* vT = (const bf16_t*)(lds + GL_VT);
#pragma unroll
  for (int i = 0; i < 16; ++i) {
    const float kv = bf2f(k16[i]);
    kdT0[d * 72 + qd * 16 + i] = f2bf(kv * __expf(tot0 - b0[i]));
    kdT1[d * 72 + qd * 16 + i] = f2bf(kv * __expf(tot1 - b1[i]));
  }
  const int chain0 = (b * 4 + h) * 2, sp0 = gla_scan_pos(c, 0), sp1 = gla_scan_pos(c, 1);
  if (qd == 0) DEC[(size_t)(chain0 * NCHUNK + sp0) * 64 + d] = __expf(tot0);
  if (qd == 1) DEC[(size_t)((chain0 + 1) * NCHUNK + sp1) * 64 + d] = __expf(tot1);
  __syncthreads();
  f32x16 acc[2][2];
#pragma unroll
  for (int dir = 0; dir < 2; ++dir)
#pragma unroll
    for (int x = 0; x < 2; ++x)
#pragma unroll
      for (int i = 0; i < 16; ++i) acc[dir][x][i] = 0.f;
#pragma unroll
  for (int s4 = 0; s4 < 4; ++s4) {
    const bf16x8 bq = *(const bf16x8*)(vT + (32 * w + r) * 72 + 16 * s4 + 8 * hh);
#pragma unroll
    for (int x = 0; x < 2; ++x) {
      const bf16x8 a0 = *(const bf16x8*)(kdT0 + (32 * x + r) * 72 + 16 * s4 + 8 * hh);
      const bf16x8 a1 = *(const bf16x8*)(kdT1 + (32 * x + r) * 72 + 16 * s4 + 8 * hh);
      acc[0][x] = MFMA32(a0, bq, acc[0][x]);
      acc[1][x] = MFMA32(a1, bq, acc[1][x]);
    }
  }
#pragma unroll
  for (int dir = 0; dir < 2; ++dir) {
    bf16_t* dst = KVST + (size_t)((chain0 + dir) * NCHUNK + (dir == 0 ? sp0 : sp1)) * 8192 + (32 * w + r) * 64;
#pragma unroll
    for (int x = 0; x < 2; ++x)
#pragma unroll
      for (int g = 0; g < 4; ++g) {
        u32x2 o; o.x = pk2(acc[dir][x][4 * g], acc[dir][x][4 * g + 1]); o.y = pk2(acc[dir][x][4 * g + 2], acc[dir][x][4 * g + 3]);
        *(u32x2*)(dst + 32 * x + 8 * g + 4 * hh) = o;
      }
  }
}

DI void gla_scan_item(const Params& p, int item) {
  bf16_t* KVST = (bf16_t*)(p.ws + WS_KVST);
  const float* DEC = (const float*)(p.ws + WS_DEC);
  const int idx = item * 256 + tid_opaque();
  const int chain = idx >> 11, off = (idx & 2047) * 4, d = off & 63;
  float S[4] = {0.f, 0.f, 0.f, 0.f};
#pragma unroll 1
  for (int sp0 = 0; sp0 < NCHUNK; sp0 += 6) {
    u32x2 kv[6]; f32x4 dc[6];
#pragma unroll
    for (int q = 0; q < 6; ++q) {
      kv[q] = *(const u32x2*)(KVST + (size_t)(chain * NCHUNK + sp0 + q) * 8192 + off);
      dc[q] = *(const f32x4*)(DEC + (size_t)(chain * NCHUNK + sp0 + q) * 64 + d);
    }
#pragma unroll
    for (int q = 0; q < 6; ++q) {
      u32x2 o; o.x = pk2(S[0], S[1]); o.y = pk2(S[2], S[3]);
      *(u32x2*)(KVST + (size_t)(chain * NCHUNK + sp0 + q) * 8192 + off) = o;
      S[0] = S[0] * dc[q].x + bflo(kv[q].x); S[1] = S[1] * dc[q].y + bfhi(kv[q].x); S[2] = S[2] * dc[q].z + bflo(kv[q].y); S[3] = S[3] * dc[q].w + bfhi(kv[q].y);
    }
  }
}

template <int DIR>
DI void gla_g3_dir(const float (&gw)[16], float gb, const float (&qreg)[16], const float (&kreg)[16], f32x16 (&o)[2], unsigned char* lds) {
  const int t = tid_opaque(), d = t & 63, qd = t >> 6, lane = t & 63, w = t >> 6, r = lane & 31, hh = lane >> 5;
  bf16_t* qt = (bf16_t*)(lds + GL_QT);
  bf16_t* kt = (bf16_t*)(lds + GL_KT);
  bf16_t* att = (bf16_t*)(lds + GL_ATT);
  const bf16_t* vT = (const bf16_t*)(lds + GL_VT);
  const bf16_t* ST = (const bf16_t*)(lds + GL_ST);
  const int lb = w >> 1, eb0 = 2 * (w & 1);
  float bb[16];
  (void)gla_decay<DIR>(gw, gb, lds, bb);
#pragma unroll
  for (int i = 0; i < 16; ++i) {
    const int l = qd * 16 + i;
    qt[l * 72 + d] = f2bf(qreg[i] * __expf(bb[i]));
    kt[l * 72 + d] = f2bf(kreg[i] * __expf(-bb[i]));
  }
  __syncthreads();
  {
    const int mb = w & 1;
    f32x16 a;
#pragma unroll
    for (int i = 0; i < 16; ++i) a[i] = 0.f;
#pragma unroll
    for (int s = 0; s < 4; ++s) {
      const bf16x8 fa = *(const bf16x8*)(qt + (32 * lb + r) * 72 + 16 * s + 8 * hh);
      const bf16x8 fb = *(const bf16x8*)(kt + (32 * mb + r) * 72 + 16 * s + 8 * hh);
      a = MFMA32(fa, fb, a);
    }
    const int mcol = 32 * mb + r;
#pragma unroll
    for (int i = 0; i < 16; ++i) {
      const int l = 32 * lb + crow(i, hh);
      const bool keep = (DIR == 0) ? (mcol <= l) : (mcol >= l);
      att[l * 72 + mcol] = f2bf(keep ? a[i] : 0.f);
    }
  }
  __syncthreads();
#pragma unroll
  for (int s = 0; s < 4; ++s) {
    const bf16x8 a1 = *(const bf16x8*)(att + (32 * lb + r) * 72 + 16 * s + 8 * hh);
    const bf16x8 a2 = *(const bf16x8*)(qt + (32 * lb + r) * 72 + 16 * s + 8 * hh);
#pragma unroll
    for (int x = 0; x < 2; ++x) {
      const bf16x8 b1 = *(const bf16x8*)(vT + (32 * (eb0 + x) + r) * 72 + 16 * s + 8 * hh);
      const bf16x8 b2 = *(const bf16x8*)(ST + (32 * (eb0 + x) + r) * 72 + 16 * s + 8 * hh);
      o[x] = MFMA32(a1, b1, o[x]);
      o[x] = MFMA32(a2, b2, o[x]);
    }
  }
  __syncthreads();
}

DI void gla_g3_item(const Params& p, int j, int item, unsigned char* lds) {
  const int b = item / (4 * NCHUNK), h = (item / NCHUNK) & 3, c = item % NCHUNK;
  const bf16_t* U2 = (const bf16_t*)(p.ws + WS_U2);
  const bf16_t* KVST = (const bf16_t*)(p.ws + WS_KVST);
  bf16_t* MIX = (bf16_t*)(p.ws + WS_R2);
  const int t = tid_opaque(), d = t & 63, qd = t >> 6, lane = t & 63, w = t >> 6, r = lane & 31, hh = lane >> 5;
  const int base_m = gla_base_row(b, c);
  const int chain0 = (b * 4 + h) * 2;
  GlaRaw raw; gla_load_raw(raw, U2, base_m, h);
  bf16_t k16[16], q16[16];
#pragma unroll
  for (int i = 0; i < 16; ++i) {
    const bf16_t* row = U2 + (size_t)(base_m + qd * 16 + i) * U2W + h * 64 + d;
    k16[i] = row[U2_KB]; q16[i] = row[U2_QB];
  }
  float gw0[16], gw1[16], gb0, gb1;
  gla_load_gate(p, j, h, 0, d, gw0, gb0);
  gla_load_gate(p, j, h, 1, d, gw1, gb1);
  u32x4 st[4];
  {
    const bf16_t* src = KVST + (size_t)(chain0 * NCHUNK + gla_scan_pos(c, 0)) * 8192;
#pragma unroll
    for (int q = 0; q < 4; ++q) st[q] = *(const u32x4*)(src + (size_t)(t + 256 * q) * 8);
  }
  __syncthreads();
  gla_stage_raw(raw, lds);
  bf16_t* STl = (bf16_t*)(lds + GL_ST);
#pragma unroll
  for (int q = 0; q < 4; ++q) { const int ci = t + 256 * q; *(u32x4*)(STl + (ci >> 3) * 72 + (ci & 7) * 8) = st[q]; }
  {
    const bf16_t* src = KVST + (size_t)((chain0 + 1) * NCHUNK + gla_scan_pos(c, 1)) * 8192;
#pragma unroll
    for (int q = 0; q < 4; ++q) st[q] = *(const u32x4*)(src + (size_t)(t + 256 * q) * 8);
  }
  float kreg[16], qreg[16];
#pragma unroll
  for (int i = 0; i < 16; ++i) { kreg[i] = bf2f(k16[i]); qreg[i] = bf2f(q16[i]) * 0.125f; }
  __syncthreads();
  const int lb = w >> 1, eb0 = 2 * (w & 1);
  f32x16 o[2];
#pragma unroll
  for (int x = 0; x < 2; ++x)
#pragma unroll
    for (int i = 0; i < 16; ++i) o[x][i] = 0.f;
  gla_g3_dir<0>(gw0, gb0, qreg, kreg, o, lds);
#pragma unroll
  for (int q = 0; q < 4; ++q) { const int ci = t + 256 * q; *(u32x4*)(STl + (ci >> 3) * 72 + (ci & 7) * 8) = st[q]; }
  const int erow = t >> 2, epart = t & 3;
  const int em = base_m + erow;
  u32x4 zb[4];
  {
    const bf16_t* zp = U2 + (size_t)em * U2W + U2_ZB + h * 128 + epart * 32;
#pragma unroll
    for (int q = 0; q < 4; ++q) zb[q] = *(const u32x4*)(zp + q * 8);
  }
  gla_g3_dir<1>(gw1, gb1, qreg, kreg, o, lds);
  float* ob = (float*)lds;
#pragma unroll
  for (int x = 0; x < 2; ++x)
#pragma unroll
    for (int i = 0; i < 16; ++i) ob[(32 * lb + crow(i, hh)) * 132 + 32 * (eb0 + x) + r] = o[x][i];
  __syncthreads();
  {
    float v[32];
    float ss = 0.f;
#pragma unroll
    for (int q = 0; q < 8; ++q) { *(f32x4*)(v + 4 * q) = *(const f32x4*)(ob + erow * 132 + epart * 32 + q * 4); }
#pragma unroll
    for (int e = 0; e < 32; ++e) ss += v[e] * v[e];
    ss += __shfl_xor(ss, 1); ss += __shfl_xor(ss, 2);
    const float rstd = rsqrtf(ss * (1.f / 128.f) + EPS);
    const float* gn = p.ev_gla_norm + j * 512 + h * 128 + epart * 32;
    bf16_t* dst = MIX + (size_t)em * D + 512 + h * 128 + epart * 32;
#pragma unroll
    for (int q = 0; q < 4; ++q) {
      float z[8], ov[8];
      unpack8(zb[q], z);
#pragma unroll
      for (int e = 0; e < 8; ++e) ov[e] = v[q * 8 + e] * rstd * gn[q * 8 + e] * silu_f(z[e]);
      *(u32x4*)(dst + q * 8) = pack8(ov);
    }
  }
}

template <int DQK, int MODE>
DI void attn_tile(const bf16_t* Ks, const bf16_t* Vs, const bf16x8 (&qf)[DQK / 16], f32x16 (&o)[2], float& mx, float& lsum,
                  int r, int hh, const float* rpbs, int ridx, int qc) {
  constexpr int KP = DQK + 8, VP = 72;
  f32x16 s[2];
#pragma unroll
  for (int kb = 0; kb < 2; ++kb) {
#pragma unroll
    for (int i = 0; i < 16; ++i) s[kb][i] = 0.f;
#pragma unroll
    for (int jj = 0; jj < DQK / 16; ++jj) {
      const bf16x8 a = *(const bf16x8*)(Ks + (32 * kb + r) * KP + 16 * jj + 8 * hh);
      s[kb] = MFMA32(a, qf[jj], s[kb]);
    }
  }
  if (MODE == 1) {
    const int cs = min(max(qc - 8, 0), 48);
    const int u = 4 * hh - cs;
    const float* bp = rpbs + (ridx * 31 + 4 * hh - qc + 15);
#pragma unroll
    for (int kb = 0; kb < 2; ++kb)
#pragma unroll
      for (int i = 0; i < 16; ++i) {
        const int c = 32 * kb + (i & 3) + 8 * (i >> 2);
        const bool valid = (unsigned)(u + c) < 16u;
        s[kb][i] = valid ? (s[kb][i] + bp[c]) : -INFINITY;
      }
  }
  float tmax = s[0][0];
#pragma unroll
  for (int kb = 0; kb < 2; ++kb)
#pragma unroll
    for (int i = 0; i < 16; ++i) tmax = fmaxf(tmax, s[kb][i]);
  tmax = fmaxf(tmax, __shfl_xor(tmax, 32));
  if (__builtin_amdgcn_ballot_w64(tmax > mx) != 0ull) {
    const float mnew = fmaxf(mx, tmax);
    const float alpha = exp2_fast(mx - mnew);
    mx = mnew;
    lsum *= alpha;
#pragma unroll
    for (int x = 0; x < 2; ++x)
#pragma unroll
      for (int i = 0; i < 16; ++i) o[x][i] *= alpha;
  }
  float psum = 0.f;
#pragma unroll
  for (int kb = 0; kb < 2; ++kb)
#pragma unroll
    for (int i = 0; i < 16; ++i) { s[kb][i] = exp2_fast(s[kb][i] - mx); psum += s[kb][i]; }
  lsum += psum;
#pragma unroll
  for (int kb = 0; kb < 2; ++kb)
#pragma unroll
    for (int sx = 0; sx < 2; ++sx) {
      u32x4 pk;
      pk.x = pk2(s[kb][8 * sx + 0], s[kb][8 * sx + 1]); pk.y = pk2(s[kb][8 * sx + 2], s[kb][8 * sx + 3]);
      pk.z = pk2(s[kb][8 * sx + 4], s[kb][8 * sx + 5]); pk.w = pk2(s[kb][8 * sx + 6], s[kb][8 * sx + 7]);
      const bf16x8 pf = __builtin_bit_cast(bf16x8, pk);
#pragma unroll
      for (int eb = 0; eb < 2; ++eb) {
        const bf16_t* vp = Vs + (32 * eb + r) * VP + 32 * kb + 16 * sx + 4 * hh;
        const s16x4 lo = *(const s16x4*)vp, hi = *(const s16x4*)(vp + 8);
        const bf16x8 vf = __builtin_shufflevector(lo, hi, 0, 1, 2, 3, 4, 5, 6, 7);
        o[eb] = MFMA32(vf, pf, o[eb]);
      }
    }
}

template <int DQK>
DI void attn_load_tile(const bf16_t* kg, const bf16_t* vg, u32x4 (&rk)[DQK / 32], u32x4 (&rv)[2]) {
  const int t = tid_opaque();
#pragma unroll
  for (int i = 0; i < DQK / 32; ++i) rk[i] = *(const u32x4*)(kg + (size_t)(t + 256 * i) * 8);
#pragma unroll
  for (int i = 0; i < 2; ++i) { const int ci = t + 256 * i, e = ci >> 3, cc = ci & 7; rv[i] = *(const u32x4*)(vg + (size_t)e * KEYS + cc * 8); }
}
template <int DQK>
DI void attn_store_tile(bf16_t* Ks, bf16_t* Vs, const u32x4 (&rk)[DQK / 32], const u32x4 (&rv)[2]) {
  constexpr int KP = DQK + 8, CPR = DQK / 8;
  const int t = tid_opaque();
#pragma unroll
  for (int i = 0; i < DQK / 32; ++i) { const int ci = t + 256 * i, row = ci / CPR, cc = ci % CPR; *(u32x4*)(Ks + row * KP + cc * 8) = rk[i]; }
#pragma unroll
  for (int i = 0; i < 2; ++i) { const int ci = t + 256 * i, e = ci >> 3, cc = ci & 7; *(u32x4*)(Vs + e * 72 + cc * 8) = rv[i]; }
}

constexpr int AT_KS = 0, AT_VS = 13312, AT_BUF = 22528  , AT_RPB = 45056, AT_QS = 47104;

DI void attn_write_out(const f32x16 (&o)[2], float lsum, const bf16_t* zrow, bf16_t* orow, int hh) {
  const float ltot = lsum + __shfl_xor(lsum, 32);
  const float inv = 1.f / ltot;
#pragma unroll
  for (int eb = 0; eb < 2; ++eb)
#pragma unroll
    for (int g = 0; g < 4; ++g) {
      const int e = 32 * eb + 8 * g + 4 * hh;
      const u32x2 zz = *(const u32x2*)(zrow + e);
      const float v0 = o[eb][4 * g + 0] * inv * silu_f(bflo(zz.x)), v1 = o[eb][4 * g + 1] * inv * silu_f(bfhi(zz.x));
      const float v2 = o[eb][4 * g + 2] * inv * silu_f(bflo(zz.y)), v3 = o[eb][4 * g + 3] * inv * silu_f(bfhi(zz.y));
      u32x2 ov; ov.x = pk2(v0, v1); ov.y = pk2(v2, v3);
      *(u32x2*)(orow + e) = ov;
    }
}

template <int DQK, int NH>
DI void attn_dense_item(const bf16_t* Q, const bf16_t* K, const bf16_t* VT, const bf16_t* Z, int zstride, bf16_t* MIX,
                        int b, int head, int qp0, int k_lo, int ntiles, unsigned char* lds) {
  const int t = tid_opaque(), lane = t & 63, w = t >> 6, r = lane & 31, hh = lane >> 5;
  bf16_t* Ks = (bf16_t*)(lds + AT_KS);
  bf16_t* Vs = (bf16_t*)(lds + AT_VS);
  const size_t bh = (size_t)(b * NH + head);
  const int qpos = qp0 + 32 * w + r;
  bf16x8 qf[DQK / 16];
#pragma unroll
  for (int jj = 0; jj < DQK / 16; ++jj) qf[jj] = *(const bf16x8*)(Q + (bh * KEYS + qpos) * DQK + 16 * jj + 8 * hh);
  f32x16 o[2];
#pragma unroll
  for (int x = 0; x < 2; ++x)
#pragma unroll
    for (int i = 0; i < 16; ++i) o[x][i] = 0.f;
  float mx = -1e30f, lsum = 0.f;
  const bf16_t* kbase = K + (bh * KEYS + k_lo) * DQK;
  const bf16_t* vbase = VT + bh * 64 * KEYS + k_lo;
  u32x4 rk[DQK / 32], rv[2];
  attn_load_tile<DQK>(kbase, vbase, rk, rv);
  for (int tt = 0; tt < ntiles; ++tt) {
    __syncthreads();
    attn_store_tile<DQK>(Ks, Vs, rk, rv);
    __syncthreads();
    if (tt + 1 < ntiles) attn_load_tile<DQK>(kbase + (size_t)(tt + 1) * 64 * DQK, vbase + (tt + 1) * 64, rk, rv);
    attn_tile<DQK, 0>(Ks, Vs, qf, o, mx, lsum, r, hh, nullptr, 0, 0);
  }
  const int m = (qpos < SEQ) ? b * SEQ + qpos : NLAT + b * CTXL + (qpos - SEQ);
  attn_write_out(o, lsum, Z + (size_t)m * zstride + head * 64, MIX + (size_t)m * D + head * 64, hh);
}


template <int DQK, int MODE, bool PARK>
DI void attn_tile2(const bf16_t* Ks, const bf16_t* Vs, const bf16x8 (&qfA)[DQK / 16], const bf16x8 (&qfB)[DQK / 16], const bf16_t* QsB, f32x16 (&o)[2][2], float (&mx)[2], float (&lsum)[2], int r, int hh,
                const float* rpbs, int ridx, int qcA) {
  constexpr int KP = DQK + 8, VP = 72;
  f32x16 s[2][2];
#pragma unroll
  for (int kb = 0; kb < 2; ++kb) {
#pragma unroll
    for (int g = 0; g < 2; ++g)
#pragma unroll
      for (int i = 0; i < 16; ++i) s[g][kb][i] = 0.f;
#pragma unroll
    for (int jj = 0; jj < DQK / 16; ++jj) {
      const bf16x8 a = *(const bf16x8*)(Ks + (32 * kb + r) * KP + 16 * jj + 8 * hh);
      const bf16x8 qb = PARK ? *(const bf16x8*)(QsB + 16 * jj) : qfB[jj];
      s[0][kb] = MFMA32(a, qfA[jj], s[0][kb]);
      s[1][kb] = MFMA32(a, qb, s[1][kb]);
    }
  }
#pragma unroll
  for (int g = 0; g < 2; ++g) {
    if (MODE == 1) {
      const int qc = qcA + 32 * g;
      const int cs = min(max(qc - 8, 0), 48);
      const int u = 4 * hh - cs;
      const float* bp = rpbs + (ridx * 31 + 4 * hh - qc + 15);
#pragma unroll
      for (int kb = 0; kb < 2; ++kb)
#pragma unroll
        for (int i = 0; i < 16; ++i) {
          const int c = 32 * kb + (i & 3) + 8 * (i >> 2);
          const bool valid = (unsigned)(u + c) < 16u;
          s[g][kb][i] = valid ? (s[g][kb][i] + bp[c]) : -INFINITY;
          if ((i & 3) == 3) __builtin_amdgcn_sched_barrier(0);
        }
    }
    float tmax = s[g][0][0];
#pragma unroll
    for (int kb = 0; kb < 2; ++kb)
#pragma unroll
      for (int i = 0; i < 16; ++i) tmax = fmaxf(tmax, s[g][kb][i]);
    tmax = fmaxf(tmax, __shfl_xor(tmax, 32));
    if (__builtin_amdgcn_ballot_w64(tmax > mx[g]) != 0ull) {
      const float mnew = fmaxf(mx[g], tmax);
      const float alpha = exp2_fast(mx[g] - mnew);
      mx[g] = mnew;
      lsum[g] *= alpha;
#pragma unroll
      for (int x = 0; x < 2; ++x)
#pragma unroll
        for (int i = 0; i < 16; ++i) o[g][x][i] *= alpha;
    }
    float psum = 0.f;
#pragma unroll
    for (int kb = 0; kb < 2; ++kb)
#pragma unroll
      for (int i = 0; i < 16; ++i) { s[g][kb][i] = exp2_fast(s[g][kb][i] - mx[g]); psum += s[g][kb][i]; }
    lsum[g] += psum;
#pragma unroll
    for (int kb = 0; kb < 2; ++kb)
#pragma unroll
      for (int sx = 0; sx < 2; ++sx) {
        u32x4 pk;
        pk.x = pk2(s[g][kb][8 * sx + 0], s[g][kb][8 * sx + 1]); pk.y = pk2(s[g][kb][8 * sx + 2], s[g][kb][8 * sx + 3]);
        pk.z = pk2(s[g][kb][8 * sx + 4], s[g][kb][8 * sx + 5]); pk.w = pk2(s[g][kb][8 * sx + 6], s[g][kb][8 * sx + 7]);
        const bf16x8 pf = __builtin_bit_cast(bf16x8, pk);
#pragma unroll
        for (int eb = 0; eb < 2; ++eb) {
          const bf16_t* vp = Vs + (32 * eb + r) * VP + 32 * kb + 16 * sx + 4 * hh;
          const s16x4 lo = *(const s16x4*)vp, hi = *(const s16x4*)(vp + 8);
          const bf16x8 vf = __builtin_shufflevector(lo, hi, 0, 1, 2, 3, 4, 5, 6, 7);
          o[g][eb] = MFMA32(vf, pf, o[g][eb]);
        }
      }
  }
}

template <int DQK, int NH>
DI void attn_dense_item2(const bf16_t* Q, const bf16_t* K, const bf16_t* VT, const bf16_t* Z, int zstride, bf16_t* MIX,
                         int b, int head, int qp0, int k_lo, int ntiles, unsigned char* lds) {
  const int t = tid_opaque(), lane = t & 63, w = t >> 6, r = lane & 31, hh = lane >> 5;
  bf16_t* Ks = (bf16_t*)(lds + AT_KS);
  bf16_t* Vs = (bf16_t*)(lds + AT_VS);
  const size_t bh = (size_t)(b * NH + head);
  const int qpos0 = qp0 + 64 * w + r;
  bf16x8 qfA[DQK / 16];
  bf16_t* QsB = (bf16_t*)(lds + AT_QS) + (32 * w + r) * (DQK + 8) + 8 * hh;
  __syncthreads();
#pragma unroll
  for (int jj = 0; jj < DQK / 16; ++jj) {
    qfA[jj] = *(const bf16x8*)(Q + (bh * KEYS + qpos0) * DQK + 16 * jj + 8 * hh);
    *(bf16x8*)(QsB + 16 * jj) = *(const bf16x8*)(Q + (bh * KEYS + qpos0 + 32) * DQK + 16 * jj + 8 * hh);
  }
  f32x16 o[2][2];
#pragma unroll
  for (int g = 0; g < 2; ++g)
#pragma unroll
    for (int x = 0; x < 2; ++x)
#pragma unroll
      for (int i = 0; i < 16; ++i) o[g][x][i] = 0.f;
  float mx[2] = {-1e30f, -1e30f}, lsum[2] = {0.f, 0.f};
  const bf16_t* kbase = K + (bh * KEYS + k_lo) * DQK;
  const bf16_t* vbase = VT + bh * 64 * KEYS + k_lo;
  u32x4 rk[DQK / 32], rv[2];
  attn_load_tile<DQK>(kbase, vbase, rk, rv);
  attn_store_tile<DQK>(Ks, Vs, rk, rv);
  if (ntiles > 1) attn_load_tile<DQK>(kbase + (size_t)64 * DQK, vbase + 64, rk, rv);
  __syncthreads();
#pragma unroll 1
  for (int tt = 0; tt < ntiles; ++tt) {
    const int bo = (tt & 1) * (AT_BUF / 2);
    attn_tile2<DQK, 0, true>(Ks + bo, Vs + bo, qfA, qfA, QsB, o, mx, lsum, r, hh, nullptr, 0, 0);
    if (tt + 1 < ntiles) {
      const int bn = ((tt + 1) & 1) * (AT_BUF / 2);
      attn_store_tile<DQK>(Ks + bn, Vs + bn, rk, rv);
      if (tt + 2 < ntiles) attn_load_tile<DQK>(kbase + (size_t)(tt + 2) * 64 * DQK, vbase + (tt + 2) * 64, rk, rv);
    }
    __syncthreads();
  }
#pragma unroll
  for (int g = 0; g < 2; ++g) {
    const int qpos = qpos0 + 32 * g;
    const int m = (qpos < SEQ) ? b * SEQ + qpos : NLAT + b * CTXL + (qpos - SEQ);
    attn_write_out(o[g], lsum[g], Z + (size_t)m * zstride + head * 64, MIX + (size_t)m * D + head * 64, hh);
  }
}

DI void natten_item(const Params& p, int j, int item, unsigned char* lds) {
  const int b = item >> 8, head = (item >> 4) & 15, rp = item & 15;
  const bf16_t* Q = (const bf16_t*)(p.ws + WS_QC);
  const bf16_t* K = (const bf16_t*)(p.ws + WS_KC);
  const bf16_t* VT = (const bf16_t*)(p.ws + WS_VCT);
  const bf16_t* Z = (const bf16_t*)(p.ws + WS_ZC);
  bf16_t* MIX = (bf16_t*)(p.ws + WS_OH);
  const int t = tid_opaque(), lane = t & 63, w = t >> 6, r = lane & 31, hh = lane >> 5;
  bf16_t* Ks = (bf16_t*)(lds + AT_KS);
  bf16_t* Vs = (bf16_t*)(lds + AT_VS);
  float* rpbs = (float*)(lds + AT_RPB);
  const size_t bh = (size_t)(b * 16 + head);
  const int r0 = 2 * rp, qrow = r0 + (w >> 1), qc = 32 * (w & 1) + r, qpos = qrow * 64 + qc;
  const int ra = min(max(r0 - 4, 0), 24), rb = min(max(r0 + 1 - 4, 0), 24) + 7;
  const int nlat = rb - ra + 1, ntiles = nlat + 4;
  const int my_rs = min(max(qrow - 4, 0), 24);
  __syncthreads();
  for (int i = t; i < 15 * 31; i += 256) rpbs[i] = p.od_rpb[((size_t)(j * 16 + head)) * 465 + i] * LOG2E;
  bf16x8 qf[4];
#pragma unroll
  for (int jj = 0; jj < 4; ++jj) qf[jj] = *(const bf16x8*)(Q + (bh * KEYS + qpos) * 64 + 16 * jj + 8 * hh);
  f32x16 o[2];
#pragma unroll
  for (int x = 0; x < 2; ++x)
#pragma unroll
    for (int i = 0; i < 16; ++i) o[x][i] = 0.f;
  float mx = -1e30f, lsum = 0.f;
  const bf16_t* kb0 = K + bh * KEYS * 64;
  const bf16_t* vb0 = VT + bh * 64 * KEYS;
  u32x4 rk[2], rv[2];
  attn_load_tile<64>(kb0 + (size_t)(ra * 64) * 64, vb0 + ra * 64, rk, rv);
  for (int tt = 0; tt < ntiles; ++tt) {
    __syncthreads();
    attn_store_tile<64>(Ks, Vs, rk, rv);
    __syncthreads();
    if (tt + 1 < ntiles) {
      const int key0 = (tt + 1 < nlat) ? (ra + tt + 1) * 64 : SEQ + (tt + 1 - nlat) * 64;
      attn_load_tile<64>(kb0 + (size_t)key0 * 64, vb0 + key0, rk, rv);
    }
    if (tt < nlat) {
      const int kr = ra + tt;
      if (kr >= my_rs && kr < my_rs + 8) attn_tile<64, 1>(Ks, Vs, qf, o, mx, lsum, r, hh, rpbs, kr - qrow + 7, qc);
    } else {
      attn_tile<64, 0>(Ks, Vs, qf, o, mx, lsum, r, hh, nullptr, 0, 0);
    }
  }
  const int m = b * SEQ + qpos;
  attn_write_out(o, lsum, Z + (size_t)m * D + head * 64, MIX + (size_t)m * D + head * 64, hh);
}


DI void natten_item2(const Params& p, int j, int item, unsigned char* lds) {
  const int b = item >> 7, head = (item >> 3) & 15, rq = item & 7;
  const bf16_t* Q = (const bf16_t*)(p.ws + WS_QC);
  const bf16_t* K = (const bf16_t*)(p.ws + WS_KC);
  const bf16_t* VT = (const bf16_t*)(p.ws + WS_VCT);
  const bf16_t* Z = (const bf16_t*)(p.ws + WS_ZC);
  bf16_t* MIX = (bf16_t*)(p.ws + WS_OH);
  const int t = tid_opaque(), lane = t & 63, w = t >> 6, r = lane & 31, hh = lane >> 5;
  bf16_t* Ks = (bf16_t*)(lds + AT_KS);
  bf16_t* Vs = (bf16_t*)(lds + AT_VS);
  float* rpbs = (float*)(lds + AT_RPB);
  const size_t bh = (size_t)(b * 16 + head);
  const int r0 = 4 * rq, qrow = r0 + w, qpos0 = qrow * 64 + r;
  const int ra = min(max(r0 - 4, 0), 24), rb = min(max(r0 + 3 - 4, 0), 24) + 7;
  const int nlat = rb - ra + 1, ntiles = nlat + 4;
  const int my_rs = min(max(qrow - 4, 0), 24);
  __syncthreads();
  for (int i = t; i < 15 * 31; i += 256) rpbs[i] = p.od_rpb[((size_t)(j * 16 + head)) * 465 + i] * LOG2E;
  bf16x8 qfA[4];
  bf16_t* QsB = (bf16_t*)(lds + AT_QS) + (32 * w + r) * 72 + 8 * hh;
#pragma unroll
  for (int jj = 0; jj < 4; ++jj) {
    qfA[jj] = *(const bf16x8*)(Q + (bh * KEYS + qpos0) * 64 + 16 * jj + 8 * hh);
    *(bf16x8*)(QsB + 16 * jj) = *(const bf16x8*)(Q + (bh * KEYS + qpos0 + 32) * 64 + 16 * jj + 8 * hh);
  }
  f32x16 o[2][2];
#pragma unroll
  for (int g = 0; g < 2; ++g)
#pragma unroll
    for (int x = 0; x < 2; ++x)
#pragma unroll
      for (int i = 0; i < 16; ++i) o[g][x][i] = 0.f;
  float mx[2] = {-1e30f, -1e30f}, lsum[2] = {0.f, 0.f};
  const bf16_t* kb0 = K + bh * KEYS * 64;
  const bf16_t* vb0 = VT + bh * 64 * KEYS;
  u32x4 rk[2], rv[2];
#define NAT_KEY0(tq) (((tq) < nlat) ? (ra + (tq)) * 64 : SEQ + ((tq) - nlat) * 64)
  attn_load_tile<64>(kb0 + (size_t)(ra * 64) * 64, vb0 + ra * 64, rk, rv);
  attn_store_tile<64>(Ks, Vs, rk, rv);
  { const int k1 = NAT_KEY0(1); attn_load_tile<64>(kb0 + (size_t)k1 * 64, vb0 + k1, rk, rv); }
  __syncthreads();
#pragma unroll 1
  for (int tt = 0; tt < ntiles; ++tt) {
    const int bo = (tt & 1) * (AT_BUF / 2);
    if (tt < nlat) {
      const int kr = ra + tt;
      if (kr >= my_rs && kr < my_rs + 8) attn_tile2<64, 1, true>(Ks + bo, Vs + bo, qfA, qfA, QsB, o, mx, lsum, r, hh, rpbs, kr - qrow + 7, r);
    } else {
      attn_tile2<64, 0, true>(Ks + bo, Vs + bo, qfA, qfA, QsB, o, mx, lsum, r, hh, nullptr, 0, 0);
    }
    if (tt + 1 < ntiles) {
      const int bn = ((tt + 1) & 1) * (AT_BUF / 2);
      attn_store_tile<64>(Ks + bn, Vs + bn, rk, rv);
      if (tt + 2 < ntiles) { const int k2 = NAT_KEY0(tt + 2); attn_load_tile<64>(kb0 + (size_t)k2 * 64, vb0 + k2, rk, rv); }
    }
    __syncthreads();
  }
#undef NAT_KEY0
#pragma unroll
  for (int g = 0; g < 2; ++g) {
    const int m = b * SEQ + qpos0 + 32 * g;
    attn_write_out(o[g], lsum[g], Z + (size_t)m * D + head * 64, MIX + (size_t)m * D + head * 64, hh);
  }
}

DI void od_win_tile(const Params& p, int j, int mt, int nt, unsigned char* lds) {
  const bf16_t* H = (const bf16_t*)(p.ws + WS_OH);
  const bf16_t* WT = (const bf16_t*)(p.ws + WS_WT + WT_OD_IN);
  const int t = tid_opaque(), m0 = mt * 128, n0 = nt * 128;
  const float* Cs = (const float*)lds;
  const int type = n0 >> 10, hh0 = (n0 & 1023) >> 6;
  int b, pos0; tok_bp(m0, b, pos0);
  if (type < 2) {
    bf16_t* dstb = (bf16_t*)(p.ws + (type == 0 ? WS_QC : WS_KC));
    const float* gain = (type == 0 ? p.od_q_gain : p.od_k_gain) + j * 64;
    const float sc = (type == 0) ? 0.125f * LOG2E : 1.f;
#pragma unroll 1
    for (int it = 0; it < 8; ++it) {
      const int idx = t + 256 * it, l8 = idx & 7, hsel = (idx >> 3) & 1, row = idx >> 4;
      float v[8];
      *(f32x4*)v = *(const f32x4*)(Cs + row * 132 + hsel * 64 + l8 * 8);
      *(f32x4*)(v + 4) = *(const f32x4*)(Cs + row * 132 + hsel * 64 + l8 * 8 + 4);
      float ss = 0.f;
#pragma unroll
      for (int e = 0; e < 8; ++e) ss += v[e] * v[e];
      ss += __shfl_xor(ss, 1); ss += __shfl_xor(ss, 2); ss += __shfl_xor(ss, 4);
      const float rstd = rsqrtf(ss * (1.f / 64.f) + EPS) * sc;
#pragma unroll
      for (int e = 0; e < 8; ++e) v[e] *= rstd * gain[l8 * 8 + e];
      *(u32x4*)(dstb + ((size_t)(b * 16 + hh0 + hsel) * KEYS + pos0 + row) * 64 + l8 * 8) = pack8(v);
    }
  } else if (type == 2) {
    bf16_t* VCT = (bf16_t*)(p.ws + WS_VCT);
#pragma unroll 1
    for (int it = 0; it < 8; ++it) {
      const int idx = t + 256 * it, rg = idx & 15, cc = idx >> 4, head = hh0 + (cc >> 6), e = cc & 63;
      float v[8];
#pragma unroll
      for (int q = 0; q < 8; ++q) v[q] = Cs[(rg * 8 + q) * 132 + cc];
      *(u32x4*)(VCT + ((size_t)(b * 16 + head) * 64 + e) * KEYS + pos0 + rg * 8) = pack8(v);
    }
  } else {
    bf16_t* ZC = (bf16_t*)(p.ws + WS_ZC);
#pragma unroll 1
    for (int it = 0; it < 8; ++it) {
      const int idx = t + 256 * it, row = idx >> 4, ch = idx & 15;
      float v[8];
      *(f32x4*)v = *(const f32x4*)(Cs + row * 132 + ch * 8);
      *(f32x4*)(v + 4) = *(const f32x4*)(Cs + row * 132 + ch * 8 + 4);
      *(u32x4*)(ZC + (size_t)(m0 + row) * D + (n0 - 3072) + ch * 8) = pack8(v);
    }
  }
}


struct OdWinOps {
  const Params* pp; int j; int layer;
  DI void map(int id, int& mt, int& nt) const {
    xcd_tile(id, 18, 32, 6, mt, nt);
  }
  DI TileDesc tile(int id) const {
    int mt, nt; map(id, mt, nt);
    TileDesc d; d.A = (const bf16_t*)(pp->ws + WS_OH) + (size_t)mt * 128 * D; d.B = (const bf16_t*)(pp->ws + WS_WT + WT_OD_IN) + (size_t)nt * 128 * D; d.nvalid = 128;
    return d;
  }
  DI void epi(int id, unsigned char* lds) const { int mt, nt; map(id, mt, nt); od_win_tile(*pp, j, mt, nt, lds); }
};


struct OdWinOps2 {
  const Params* pp; int j; int layer;
  DI void epi_lds(int, unsigned char*) const {}
  DI TileDesc tile(int id) const {
    int mt, nt; xcd_tile(id, 18, 32, 6, mt, nt);
    TileDesc d; d.A = (const bf16_t*)(pp->ws + WS_OH) + (size_t)mt * 128 * D; d.B = (const bf16_t*)(pp->ws + WS_WT + WT_OD_IN) + (size_t)nt * 128 * D; d.nvalid = 128;
    return d;
  }
  DI void epi_read(int id, unsigned char* lds, float (&c)[64]) const {
    int mt, nt; xcd_tile(id, 18, 32, 6, mt, nt);
    const int type = nt >> 3;
    const int t = tid_opaque();
    const float* Cs = (const float*)lds;
    if (type == 2) {
      const int rg = t & 15;
#pragma unroll
      for (int it = 0; it < 8; ++it) {
        const int cc = (t >> 4) + 16 * it;
#pragma unroll
        for (int q = 0; q < 8; ++q) c[it * 8 + q] = Cs[(rg * 8 + q) * 132 + cc];
      }
    } else {
      const int off = (type < 2) ? ((t >> 3) & 1) * 64 + (t & 7) * 8 : (t & 15) * 8;
#pragma unroll
      for (int it = 0; it < 8; ++it) {
        const int row = (t >> 4) + 16 * it;
        *(f32x4*)(c + it * 8) = *(const f32x4*)(Cs + row * 132 + off);
        *(f32x4*)(c + it * 8 + 4) = *(const f32x4*)(Cs + row * 132 + off + 4);
      }
    }
  }
  DI void epi_write(int id, const float (&c)[64]) const {
    const Params& p = *pp;
    int mt, nt; xcd_tile(id, 18, 32, 6, mt, nt);
    const int m0 = mt * 128, n0 = nt * 128;
    const int t = tid_opaque();
    const int type = n0 >> 10, hh0 = (n0 & 1023) >> 6;
    int b, pos0; tok_bp(m0, b, pos0);
    if (type < 2) {
      bf16_t* dstb = (bf16_t*)(p.ws + (type == 0 ? WS_QC : WS_KC));
      const int l8 = t & 7, hsel = (t >> 3) & 1;
      const float* gain = (type == 0 ? p.od_q_gain : p.od_k_gain) + j * 64 + l8 * 8;
      const f32x4 g0 = *(const f32x4*)gain, g1 = *(const f32x4*)(gain + 4);
      const float gg[8] = {g0.x, g0.y, g0.z, g0.w, g1.x, g1.y, g1.z, g1.w};
      const float sc = (type == 0) ? 0.125f * LOG2E : 1.f;
#pragma unroll
      for (int it = 0; it < 8; ++it) {
        const int row = (t >> 4) + 16 * it;
        float v[8];
        float ss = 0.f;
#pragma unroll
        for (int e = 0; e < 8; ++e) { v[e] = c[it * 8 + e]; ss += v[e] * v[e]; }
        ss += __shfl_xor(ss, 1); ss += __shfl_xor(ss, 2); ss += __shfl_xor(ss, 4);
        const float rstd = rsqrtf(ss * (1.f / 64.f) + EPS) * sc;
#pragma unroll
        for (int e = 0; e < 8; ++e) v[e] *= rstd * gg[e];
        *(u32x4*)(dstb + ((size_t)(b * 16 + hh0 + hsel) * KEYS + pos0 + row) * 64 + l8 * 8) = pack8(v);
      }
    } else if (type == 2) {
      bf16_t* VCT = (bf16_t*)(p.ws + WS_VCT);
      const int rg = t & 15;
#pragma unroll
      for (int it = 0; it < 8; ++it) {
        const int cc = (t >> 4) + 16 * it, head = hh0 + (cc >> 6), e = cc & 63;
        *(u32x4*)(VCT + ((size_t)(b * 16 + head) * 64 + e) * KEYS + pos0 + rg * 8) = pack8(c + it * 8);
      }
    } else {
      bf16_t* ZC = (bf16_t*)(p.ws + WS_ZC);
      const int ch = t & 15;
#pragma unroll
      for (int it = 0; it < 8; ++it) {
        const int row = (t >> 4) + 16 * it;
        *(u32x4*)(ZC + (size_t)(m0 + row) * D + (n0 - 3072) + ch * 8) = pack8(c + it * 8);
      }
    }
  }
};

__global__ void __launch_bounds__(256, 2) fwd_megakernel(Params p) {
  extern __shared__ __attribute__((aligned(16))) unsigned char smem[];
  cg::grid_group grid = cg::this_grid();
  unsigned char* lds = smem;
  volatile LAS unsigned* stw = (volatile LAS unsigned*)(smem + LDS_MAIN);
  if (__builtin_amdgcn_workitem_id_x() < 4) stw[__builtin_amdgcn_workitem_id_x()] = 0u;
  __syncthreads();
  const XcdBarrier xbar = xcd_barrier_post((unsigned*)(p.ws + WS_BAR), stw);
  if (p.ws == nullptr) grid.sync();

  for (int rep = 0; rep < NREP(5); ++rep) phase_setup(p, lds);
  GSYNC();

  for (int layer = 0; layer < 4; ++layer) {
    const int j = layer >> 1;
    for (int rep = 0; rep < NREP(4); ++rep) phase_norm(p, layer, lds);
    GSYNC();
    if ((layer & 1) == 0) {
      for (int rep = 0; rep < NREP(0); ++rep) phase_ev_win(p, lds);
      GSYNC();
      for (int rep = 0; rep < NREP(2); ++rep) {
        const bool rev = blockIdx.x >= (gridDim.x >> 1);
#pragma unroll 1
        for (int k3 = 0; k3 < 3; ++k3) {
          const int which = rev ? 2 - k3 : k3;
          if (which == 0) { EvQOps ops; ops.pp = &p; ops.j = j; gemm_glds2<3, EvQOps, true, true>(1152, U1W, 768, ops, lds); }
          else if (which == 1) { EvKvOps ops; ops.pp = &p; ops.j = j; gemm_glds2<4, EvKvOps, true, true>(1152, U1W, 256, ops, lds, 128); }
          else { for (int id = (blockIdx.x + 256) % gridDim.x; id < 1152; id += gridDim.x) gla_g1_item(p, j, id, lds); }
        }
      }
      GSYNC();
      {
        const bf16_t* QA = (const bf16_t*)(p.ws + WS_R1 + R1_QA);
        const bf16_t* KA = (const bf16_t*)(p.ws + WS_R1 + R1_KA);
        const bf16_t* VAT = (const bf16_t*)(p.ws + WS_R1 + R1_VAT);
        const bf16_t* U2 = (const bf16_t*)(p.ws + WS_U2);
        bf16_t* MIX = (bf16_t*)(p.ws + WS_R2);
        for (int rep = 0; rep < NREP(1); ++rep)
        {
          const bool rev = blockIdx.x >= (gridDim.x >> 1);
          if (rev && rep == 0) for (int id = 512 + blockIdx.x; id < 1024; id += gridDim.x) gla_scan_item(p, id - 512);
          for (int id = blockIdx.x; id < 512; id += gridDim.x) {
            const int qb = id & 7, head = (id >> 3) & 7, b = id >> 6;
            attn_dense_item2<96, 8>(QA, KA, VAT, U2 + U2_ZA, U2W, MIX, b, head, qb * 256, 0, KEYS / 64, lds);
          }
          if (!rev && rep == 0) for (int id = 512 + blockIdx.x; id < 1024; id += gridDim.x) gla_scan_item(p, id - 512);
        }
      }
      GSYNC();
      {
        const bf16_t* QA = (const bf16_t*)(p.ws + WS_R1 + R1_QA);
        const bf16_t* KA = (const bf16_t*)(p.ws + WS_R1 + R1_KA);
        const bf16_t* VAT = (const bf16_t*)(p.ws + WS_R1 + R1_VAT);
        const bf16_t* U2 = (const bf16_t*)(p.ws + WS_U2);
        bf16_t* MIX = (bf16_t*)(p.ws + WS_R2);
        for (int rep = 0; rep < NREP(3); ++rep)
        for (int id = blockIdx.x; id < 1152 + 64; id += gridDim.x) {
          if (id < 1152) gla_g3_item(p, j, id, lds);
          else {
            const int i2 = id - 1152, head = i2 & 7, b = i2 >> 3;
            attn_dense_item2<96, 8>(QA, KA, VAT, U2 + U2_ZA, U2W, MIX, b, head, SEQ, SEQ, CTXL / 64, lds);
          }
        }
      }
      GSYNC();
    } else {
      for (int rep = 0; rep < NREP(0); ++rep) {
        OdWinOps2 ops; ops.pp = &p; ops.j = j; ops.layer = layer;
        gemm_glds2<4>(144 * 32, D, D, ops, lds);
      }
      GSYNC();
      {
        const int nctx = (layer == 3) ? 0 : 128;
        const bf16_t* QC = (const bf16_t*)(p.ws + WS_QC);
        const bf16_t* KC = (const bf16_t*)(p.ws + WS_KC);
        const bf16_t* VCT = (const bf16_t*)(p.ws + WS_VCT);
        const bf16_t* ZC = (const bf16_t*)(p.ws + WS_ZC);
        bf16_t* MIX = (bf16_t*)(p.ws + WS_OH);
        for (int rep = 0; rep < NREP(1); ++rep)
        for (int id = blockIdx.x; id < 1024 + nctx; id += gridDim.x) {
          if (id < 1024) natten_item2(p, j, id, lds);
          else {
            const int i2 = id - 1024, head = i2 & 15, b = i2 >> 4;
            attn_dense_item2<64, 16>(QC, KC, VCT, ZC, D, MIX, b, head, SEQ, SEQ, CTXL / 64, lds);
          }
        }
      }
      GSYNC();
    }
    phase_wout(p, layer, lds);
    if (layer < 3) GSYNC();
  }
}

extern "C" void kernel_launch(void* const* d_in, const int* in_sizes, int n_in, void* d_out, int out_size, void* d_ws, size_t ws_size,
                              hipStream_t stream) {
  static int grid_blocks = 0;
  if (!grid_blocks) {
    int dev = 0, cus = 0, per_cu = 0;
    hipGetDevice(&dev);
    hipDeviceGetAttribute(&cus, hipDeviceAttributeMultiprocessorCount, dev);
    hipFuncSetAttribute((const void*)fwd_megakernel, hipFuncAttributeMaxDynamicSharedMemorySize, LDS_BYTES);
    hipOccupancyMaxActiveBlocksPerMultiprocessor(&per_cu, (const void*)fwd_megakernel, 256, LDS_BYTES);
    if (per_cu < 1) per_cu = 1;
    if (per_cu > 2) per_cu = 2;
    grid_blocks = cus * per_cu;
    if (ws_size < WS_NEED) fprintf(stderr, "kernel_launch: workspace too small: %zu < %zu\n", ws_size, (size_t)WS_NEED);
  }
  Params p{};
  const float** pp = (const float**)&p;
  for (int i = 0; i < 23; ++i) pp[i] = (const float*)d_in[i];
  p.out = (float*)d_out;
  p.ws = (unsigned char*)d_ws;
  hipMemsetAsync((unsigned char*)d_ws + WS_BAR, 0, BAR_BYTES, stream);
  void* args[] = {&p};
  hipError_t e = hipLaunchCooperativeKernel((const void*)fwd_megakernel, dim3(grid_blocks), dim3(256), args, LDS_BYTES, stream);
  if (e != hipSuccess) fprintf(stderr, "cooperative launch failed: %s (grid %d)\n", hipGetErrorString(e), grid_blocks);
}
```

```cpp
#include <hip/hip_runtime.h>
#include <hip/hip_cooperative_groups.h>
#include <stdint.h>
#include <stdio.h>
namespace cg = cooperative_groups;
#ifndef PHM
#define PHM 0xffff
#endif
#ifndef DBLM
#define DBLM 0
#endif
#define GSYNC() do { xcd_barrier(xbar); if (NREP(6) == 2) xcd_barrier(xbar); } while (0)
#define NREP(k) (((DBLM >> (k)) & 1) ? 2 : 1)

#define DI __device__ __forceinline__
typedef unsigned short bf16_t;
typedef short bf16x8 __attribute__((ext_vector_type(8)));
typedef short s16x4 __attribute__((ext_vector_type(4)));
typedef float f32x4 __attribute__((ext_vector_type(4)));
typedef float f32x16 __attribute__((ext_vector_type(16)));
typedef unsigned u32x4 __attribute__((ext_vector_type(4)));
typedef unsigned u32x2 __attribute__((ext_vector_type(2)));

constexpr int D = 1024, NB = 8, SEQ = 2048, CTXL = 256, NLAT = NB * SEQ, NCTX = NB * CTXL, NTOK = NLAT + NCTX, KEYS = SEQ + CTXL;
constexpr int EVEN_IN = 3136, ODD_IN = 4096;
constexpr int U1W = 1056, U2W = 2080;
constexpr int U2_ZA = 0, U2_QB = 512, U2_KB = 768, U2_VB = 1024, U2_GLR = 1536, U2_ZB = 1568;
constexpr float EPS = 1e-6f;
constexpr float LOG2E = 1.4426950408889634f;
constexpr int NCHUNK = 36;

constexpr size_t WS_WT = 0;
constexpr size_t WT_EV_IN = 0, WT_EV_UQ = (size_t)EVEN_IN * D * 2, WT_EV_UKV = WT_EV_UQ + (size_t)768 * 768 * 2,
                 WT_EV_OUT = WT_EV_UKV + (size_t)1024 * 256 * 2;
constexpr size_t WT_OD_IN = 0, WT_OD_OUT = (size_t)ODD_IN * D * 2;
constexpr size_t WT_BYTES = (size_t)ODD_IN * D * 2 + (size_t)D * D * 2;
constexpr size_t WS_MOD = WS_WT + WT_BYTES;
constexpr size_t WS_ROPEC = WS_MOD + 4 * 9 * 3072 * 4;
constexpr size_t WS_ROPES = WS_ROPEC + 2048 * 16 * 4;
constexpr size_t WS_DEC = WS_ROPES + 2048 * 16 * 4;
constexpr size_t WS_CX = WS_DEC + 64 * 36 * 64 * 4;
constexpr size_t WS_R1 = WS_CX + (size_t)NCTX * D * 4;
constexpr size_t R1_QA = 0, R1_KA = (size_t)NB * 8 * KEYS * 96 * 2, R1_VAT = 2 * R1_KA;
constexpr size_t R1_BYTES = 2 * R1_KA + (size_t)NB * 8 * 64 * KEYS * 2;
constexpr size_t WS_R2 = WS_R1 + R1_BYTES;
constexpr size_t R2_BYTES = (size_t)NTOK * U1W * 2;
constexpr size_t WS_U2 = WS_R2 + R2_BYTES;
constexpr size_t U2_BYTES = (size_t)NTOK * U2W * 2;
constexpr size_t WS_KVST = WS_U2 + U2_BYTES;
constexpr size_t KVST_BYTES = (size_t)64 * 36 * 8192 * 2;
constexpr size_t WS_END_EVEN = WS_KVST + KVST_BYTES;
constexpr size_t WS_OH = WS_R1;
constexpr size_t OH_BYTES = (size_t)NTOK * D * 2;
constexpr size_t WS_QC = WS_OH + OH_BYTES;
constexpr size_t QC_BYTES = (size_t)NB * 16 * KEYS * 64 * 2;
constexpr size_t WS_KC = WS_QC + QC_BYTES, WS_VCT = WS_KC + QC_BYTES, WS_ZC = WS_VCT + QC_BYTES;
constexpr size_t WS_END_ODD = WS_ZC + OH_BYTES;
constexpr size_t WS_BAR = ((WS_END_EVEN > WS_END_ODD ? WS_END_EVEN : WS_END_ODD) + 255) / 256 * 256;
constexpr size_t BAR_BYTES = 16384;
constexpr size_t WS_NEED = WS_BAR + BAR_BYTES;

constexpr int LDS_MAIN = 73728;
constexpr int LDS_BYTES = LDS_MAIN + 16;

struct Params {
  const float *x, *c, *ctx, *c_ctx, *norm_g, *ada_w, *ada_b, *ev_w_in, *ev_q_norm, *ev_w_uq, *ev_kv_norm, *ev_w_ukv,
      *ev_q_gain, *ev_k_gain, *ev_gate_w, *ev_gate_b, *ev_gla_norm, *ev_w_out, *od_w_in, *od_q_gain, *od_k_gain, *od_rpb, *od_w_out;
  float* out;
  unsigned char* ws;
};

typedef __bf16 bf16v2_t __attribute__((ext_vector_type(2)));
typedef float f32x2_t __attribute__((ext_vector_type(2)));
DI unsigned pk2(float lo, float hi) { f32x2_t f = {lo, hi}; bf16v2_t b = __builtin_convertvector(f, bf16v2_t); return __builtin_bit_cast(unsigned, b); }
DI bf16_t f2bf(float x) { return (bf16_t)(pk2(x, 0.f) & 0xffffu); }
DI float bf2f(bf16_t b) { return __uint_as_float((unsigned)b << 16); }
DI float bflo(unsigned u) { return __uint_as_float(u << 16); }
DI float bfhi(unsigned u) { return __uint_as_float(u & 0xffff0000u); }
DI u32x4 pack8(const float* v) { u32x4 o; o.x = pk2(v[0], v[1]); o.y = pk2(v[2], v[3]); o.z = pk2(v[4], v[5]); o.w = pk2(v[6], v[7]); return o; }
DI void unpack8(u32x4 u, float* v) { v[0] = bflo(u.x); v[1] = bfhi(u.x); v[2] = bflo(u.y); v[3] = bfhi(u.y); v[4] = bflo(u.z); v[5] = bfhi(u.z); v[6] = bflo(u.w); v[7] = bfhi(u.w); }
DI float wave_sum(float v) {
#pragma unroll
  for (int o = 32; o; o >>= 1) v += __shfl_xor(v, o);
  return v;
}
DI int tid_opaque() { int t = __builtin_amdgcn_workitem_id_x(); asm volatile("" : "+v"(t)); return t; }
DI float silu_f(float z) { return z / (1.f + __expf(-z)); }
DI float exp2_fast(float x) { return __builtin_amdgcn_exp2f(x); }
DI int crow(int i, int h) { return (i & 3) + 8 * (i >> 2) + 4 * h; }
#define MFMA32(a, b, c) __builtin_amdgcn_mfma_f32_32x32x16_bf16((a), (b), (c), 0, 0, 0)
#define MFMA16(a, b, c) __builtin_amdgcn_mfma_f32_16x16x32_bf16((a), (b), (c), 0, 0, 0)


#define XB_TMO      128
#define XB_XCNT(j)  (256  + 64 * (j))
#define XB_XSUB(j)  (1280 + 64 * (j))
#define XB_XGEN(j)  (2304 + 64 * (j))
#define XB_TOP      3328
#define XB_TOPGEN   3392
#define XCD_BAR_WORDS 3456
#define XB_SPIN_CAP (1u << 18)
#define LAS __attribute__((address_space(3)))
DI unsigned xb_ld(unsigned* p) { return __hip_atomic_load(p, __ATOMIC_RELAXED, __HIP_MEMORY_SCOPE_AGENT); }
DI unsigned xb_add(unsigned* p, unsigned v) { return __hip_atomic_fetch_add(p, v, __ATOMIC_RELAXED, __HIP_MEMORY_SCOPE_AGENT); }
DI unsigned xb_xcc_id() { return (unsigned)__builtin_amdgcn_s_getreg((3 << 11) | 20) & 0xFu; }
#define XB_SPIN(cond, bar) do { unsigned _sp = 0; while (cond) { __builtin_amdgcn_s_sleep(1); \
    if ((++_sp & 255u) == 0u) { if (xb_ld(&(bar)[XB_TMO])) break; if (_sp > XB_SPIN_CAP) { atomicAdd(&(bar)[XB_TMO], 1u); break; } } } } while (0)
struct XcdBarrier { unsigned* bar; unsigned x; volatile LAS unsigned* st; };
DI XcdBarrier xcd_barrier_post(unsigned* bar, volatile LAS unsigned* st) {
  XcdBarrier b; b.bar = bar; b.x = xb_xcc_id(); b.st = st;
  if (__builtin_amdgcn_workitem_id_x() == 0) (void)xb_add(&bar[XB_XCNT(b.x)], 1u);
  return b;
}
DI void xcd_barrier_complete(unsigned* bar, unsigned x, unsigned& nloc, unsigned& nx) {
  const unsigned G = gridDim.x * gridDim.y * gridDim.z;
  unsigned sum, cnt, mine, sp = 0u;
  for (;;) {
    sum = 0u; cnt = 0u; mine = 0u;
#pragma unroll
    for (unsigned j = 0; j < 16; ++j) { const unsigned c = xb_ld(&bar[XB_XCNT(j)]); sum += c; cnt += (c > 0u) ? 1u : 0u; mine = (j == x) ? c : mine; }
    if (sum == G) break;
    __builtin_amdgcn_s_sleep(1);
    if ((++sp & 255u) == 0u) { if (xb_ld(&bar[XB_TMO])) break; if (sp > XB_SPIN_CAP) { atomicAdd(&bar[XB_TMO], 1u); break; } }
  }
  nloc = mine > 0u ? mine : 1u; nx = cnt > 0u ? cnt : 1u;
}
DI void xcd_barrier(const XcdBarrier& b) {
  asm volatile("s_waitcnt vmcnt(0)" ::: "memory");
  __syncthreads();
  if (__builtin_amdgcn_workitem_id_x() == 0) {
    unsigned* bar = b.bar;
    const unsigned bx = xb_xcc_id();
    __builtin_amdgcn_s_waitcnt(0);
    unsigned nloc = b.st[0], nx = b.st[1];
    if (nloc == 0u) { xcd_barrier_complete(bar, bx, nloc, nx); b.st[0] = nloc; b.st[1] = nx; }
    const unsigned old = xb_add(&bar[XB_XSUB(bx)], 1u);
    const unsigned gen = old / nloc;
    if (old + 1u == (gen + 1u) * nloc) {
      __builtin_amdgcn_fence(__ATOMIC_RELEASE, "agent");
      asm volatile("s_waitcnt vmcnt(0)" ::: "memory");
      const unsigned og = xb_add(&bar[XB_TOP], 1u);
      const unsigned tg = og / nx;
      if (og + 1u == (tg + 1u) * nx) xb_add(&bar[XB_TOPGEN], 1u);
      else XB_SPIN(xb_ld(&bar[XB_TOPGEN]) == tg, bar);
      __builtin_amdgcn_fence(__ATOMIC_ACQUIRE, "agent");
      xb_add(&bar[XB_XGEN(bx)], 1u);
      asm volatile("s_waitcnt vmcnt(0)" ::: "memory");
    } else {
      XB_SPIN(xb_ld(&bar[XB_XGEN(bx)]) == gen, bar);
      __builtin_amdgcn_fence(__ATOMIC_ACQUIRE, "agent");
      asm volatile("s_waitcnt vmcnt(0)" ::: "memory");
    }
  }
  __syncthreads();
}

DI void tok_bp(int m, int& b, int& pos) {
  if (m < NLAT) { b = m >> 11; pos = m & 2047; } else { int mm = m - NLAT; b = mm >> 8; pos = SEQ + (mm & 255); }
}

DI void phase_setup(const Params& p, unsigned char* lds) {
  const int t = tid_opaque();
  float* MOD = (float*)(p.ws + WS_MOD);
  for (int item = blockIdx.x; item < 384; item += gridDim.x) {
    const int layer = item / 96, n0 = (item % 96) * 32;
    float* sc = (float*)lds;
    float* red = sc + 9 * 1024;
    __syncthreads();
    for (int i = t; i < 9 * 1024; i += 256) {
      const int r = i >> 10, k = i & 1023;
      const float v = (r < 8) ? p.c[r * 1024 + k] : p.c_ctx[k];
      sc[i] = silu_f(v);
    }
    __syncthreads();
    const int col = t & 31, kq = t >> 5;
    float acc[9];
#pragma unroll
    for (int r = 0; r < 9; ++r) acc[r] = 0.f;
    const float* W = p.ada_w + (size_t)layer * 1024 * 3072 + n0 + col;
#pragma unroll 4
    for (int k = kq * 128; k < kq * 128 + 128; k += 4) {
      const float w0 = W[(size_t)k * 3072], w1 = W[(size_t)(k + 1) * 3072], w2 = W[(size_t)(k + 2) * 3072], w3 = W[(size_t)(k + 3) * 3072];
#pragma unroll
      for (int r = 0; r < 9; ++r) {
        const f32x4 s4 = *(const f32x4*)(sc + r * 1024 + k);
        acc[r] += s4.x * w0 + s4.y * w1 + s4.z * w2 + s4.w * w3;
      }
    }
#pragma unroll
    for (int r = 0; r < 9; ++r) red[(kq * 9 + r) * 32 + col] = acc[r];
    __syncthreads();
    for (int i = t; i < 9 * 32; i += 256) {
      const int r = i >> 5, cc = i & 31;
      float v = 0.f;
#pragma unroll
      for (int q = 0; q < 8; ++q) v += red[(q * 9 + r) * 32 + cc];
      MOD[(size_t)(layer * 9 + r) * 3072 + n0 + cc] = v + p.ada_b[layer * 3072 + n0 + cc];
    }
  }
  float* RC = (float*)(p.ws + WS_ROPEC);
  float* RS = (float*)(p.ws + WS_ROPES);
  for (int i = blockIdx.x * 256 + t; i < 2048 * 16; i += gridDim.x * 256) {
    const int pos = i >> 4, a = (i >> 3) & 1, f = i & 7;
    const float coord = (float)(a == 0 ? (pos >> 6) : (pos & 63));
    const float inv = exp2f(-(float)f * 0.125f * 13.287712379549449f);
    const float ang = coord * inv;
    const float k = rintf(ang * 0.15915494309189535f);
    float rr = fmaf(-k, 6.28125f, ang);
    rr = fmaf(-k, 0.0019353071795864769f, rr);
    RC[i] = __cosf(rr);
    RS[i] = __sinf(rr);
  }
}

DI void transpose_item(const float* __restrict__ W, int K, int N, bf16_t* __restrict__ WT, const float* __restrict__ kscale, int item, float* tile) {
  const int t = tid_opaque();
  const int nblk = N >> 6, kb = item / nblk, nb = item % nblk, k0 = kb * 64, n0 = nb * 64;
  __syncthreads();
  {
    const int nn = t & 63, kk0 = t >> 6;
#pragma unroll
    for (int i = 0; i < 16; ++i) {
      const int kk = kk0 + 4 * i;
      float v = W[(size_t)(k0 + kk) * N + n0 + nn];
      if (kscale) v *= kscale[k0 + kk];
      tile[kk * 65 + nn] = v;
    }
  }
  __syncthreads();
  {
    const int n = t >> 2, kc = t & 3;
    float v[16];
#pragma unroll
    for (int j = 0; j < 16; ++j) v[j] = tile[(kc * 16 + j) * 65 + n];
    bf16_t* dst = WT + (size_t)(n0 + n) * K + k0 + kc * 16;
    *(u32x4*)dst = pack8(v);
    *(u32x4*)(dst + 8) = pack8(v + 8);
  }
}

DI void phase_norm(const Params& p, int layer, unsigned char* lds) {
  const int j = layer >> 1;
  bf16_t* WT = (bf16_t*)(p.ws + WS_WT);
  float* tile = (float*)lds;
  if ((layer & 1) == 0) {
    const int n1 = 16 * 49, n2 = n1 + 12 * 12, n3 = n2 + 4 * 16, n4 = n3 + 16 * 16;
    for (int it = blockIdx.x; it < n4; it += gridDim.x) {
      if (it < n1) transpose_item(p.ev_w_in + (size_t)j * D * EVEN_IN, D, EVEN_IN, (bf16_t*)((unsigned char*)WT + WT_EV_IN), nullptr, it, tile);
      else if (it < n2) transpose_item(p.ev_w_uq + (size_t)j * 768 * 768, 768, 768, (bf16_t*)((unsigned char*)WT + WT_EV_UQ), p.ev_q_norm + j * 768, it - n1, tile);
      else if (it < n3) transpose_item(p.ev_w_ukv + (size_t)j * 256 * 1024, 256, 1024, (bf16_t*)((unsigned char*)WT + WT_EV_UKV), p.ev_kv_norm + j * 256, it - n2, tile);
      else transpose_item(p.ev_w_out + (size_t)j * D * D, D, D, (bf16_t*)((unsigned char*)WT + WT_EV_OUT), nullptr, it - n3, tile);
    }
  } else {
    const int n1 = 16 * 64, n2 = n1 + 16 * 16;
    for (int it = blockIdx.x; it < n2; it += gridDim.x) {
      if (it < n1) transpose_item(p.od_w_in + (size_t)j * D * ODD_IN, D, ODD_IN, (bf16_t*)((unsigned char*)WT + WT_OD_IN), nullptr, it, tile);
      else transpose_item(p.od_w_out + (size_t)j * D * D, D, D, (bf16_t*)((unsigned char*)WT + WT_OD_OUT), nullptr, it - n1, tile);
    }
  }
  const int lane = tid_opaque() & 63, wv = tid_opaque() >> 6;
  const float* MOD = (const float*)(p.ws + WS_MOD);
  const float* xl = (layer == 0) ? p.x : p.out;
  const float* xc = (layer == 0) ? p.ctx : (const float*)(p.ws + WS_CX);
  bf16_t* H = (bf16_t*)(p.ws + (((layer & 1) == 0) ? WS_R1 : WS_OH));
  const float* g = p.norm_g + layer * D;
  const int wstride = gridDim.x * 4;
  for (int m0 = blockIdx.x * 4 + wv; m0 < NTOK; m0 += 3 * wstride) {
    f32x4 v[3][4];
    float ss[3];
#pragma unroll
    for (int u = 0; u < 3; ++u) {
      const int m = m0 + u * wstride;
      const int mc = m < NTOK ? m : m0;
      const float* xr = (mc < NLAT) ? xl + (size_t)mc * D : xc + (size_t)(mc - NLAT) * D;
#pragma unroll
      for (int q = 0; q < 4; ++q) v[u][q] = *(const f32x4*)(xr + 4 * lane + 256 * q);
    }
#pragma unroll
    for (int u = 0; u < 3; ++u) {
      float a = 0.f;
#pragma unroll
      for (int q = 0; q < 4; ++q) a += v[u][q].x * v[u][q].x + v[u][q].y * v[u][q].y + v[u][q].z * v[u][q].z + v[u][q].w * v[u][q].w;
      ss[u] = wave_sum(a);
    }
#pragma unroll
    for (int u = 0; u < 3; ++u) {
      const int m = m0 + u * wstride;
      if (m < NTOK) {
        const int r = (m < NLAT) ? (m >> 11) : 8;
        const float* shift = MOD + (size_t)(layer * 9 + r) * 3072;
        const float* scale = shift + 1024;
        const float rstd = rsqrtf(ss[u] * (1.f / D) + EPS);
#pragma unroll
        for (int q = 0; q < 4; ++q) {
          const int k = 4 * lane + 256 * q;
          const f32x4 gg = *(const f32x4*)(g + k), sc = *(const f32x4*)(scale + k), sh = *(const f32x4*)(shift + k);
          const float o0 = v[u][q].x * rstd * gg.x * (1.f + sc.x) + sh.x, o1 = v[u][q].y * rstd * gg.y * (1.f + sc.y) + sh.y;
          const float o2 = v[u][q].z * rstd * gg.z * (1.f + sc.z) + sh.z, o3 = v[u][q].w * rstd * gg.w * (1.f + sc.w) + sh.w;
          u32x2 o; o.x = pk2(o0, o1); o.y = pk2(o2, o3);
          *(u32x2*)(H + (size_t)m * D + k) = o;
        }
      }
    }
  }
}

constexpr int ROWSTAT_OFF = 67584, ROWSTAT2_OFF = ROWSTAT_OFF + 512;

template <int NFRAG, bool SUMSQ>
DI void gemm_mainloop(const bf16_t* __restrict__ A, int lda, const bf16_t* __restrict__ Bt, int K, int nvalid,
                      f32x4 (&acc)[4][NFRAG], unsigned char* lds) {
  constexpr int NBI = NFRAG;
  bf16_t* As = (bf16_t*)lds;
  bf16_t* Bs = As + 128 * 72;
  const int t = tid_opaque(), lane = t & 63, w = t >> 6, wr = w >> 1, wc = w & 1, fr = lane & 15, fq = lane >> 4;
  const int lc = t & 7, lr = t >> 3;
  const bf16_t* Ap = A + (size_t)lr * lda + lc * 8;
  const bf16_t* Bp = Bt + (size_t)lr * K + lc * 8;
  u32x4 ra[4], rb[NBI];
  float ssq[4] = {0.f, 0.f, 0.f, 0.f};
#pragma unroll
  for (int mi = 0; mi < 4; ++mi)
#pragma unroll
    for (int ni = 0; ni < NFRAG; ++ni) acc[mi][ni] = (f32x4){0.f, 0.f, 0.f, 0.f};
  const int nk = K >> 6;
#pragma unroll
  for (int i = 0; i < 4; ++i) ra[i] = *(const u32x4*)(Ap + (size_t)(32 * i) * lda);
#pragma unroll
  for (int i = 0; i < NBI; ++i) rb[i] = (lr + 32 * i < nvalid) ? *(const u32x4*)(Bp + (size_t)(32 * i) * K) : (u32x4){0u, 0u, 0u, 0u};
  for (int kt = 0; kt < nk; ++kt) {
    __syncthreads();
#pragma unroll
    for (int i = 0; i < 4; ++i) {
      *(u32x4*)(As + (lr + 32 * i) * 72 + lc * 8) = ra[i];
      if (SUMSQ) { float v[8]; unpack8(ra[i], v);
#pragma unroll
        for (int e = 0; e < 8; ++e) ssq[i] += v[e] * v[e]; }
    }
#pragma unroll
    for (int i = 0; i < NBI; ++i) *(u32x4*)(Bs + (lr + 32 * i) * 72 + lc * 8) = rb[i];
    __syncthreads();
    if (kt + 1 < nk) {
      const int ko = (kt + 1) * 64;
#pragma unroll
      for (int i = 0; i < 4; ++i) ra[i] = *(const u32x4*)(Ap + (size_t)(32 * i) * lda + ko);
#pragma unroll
      for (int i = 0; i < NBI; ++i) rb[i] = (lr + 32 * i < nvalid) ? *(const u32x4*)(Bp + (size_t)(32 * i) * K + ko) : (u32x4){0u, 0u, 0u, 0u};
    }
#pragma unroll
    for (int kk = 0; kk < 2; ++kk) {
      bf16x8 af[4], bfr[NFRAG];
#pragma unroll
      for (int mi = 0; mi < 4; ++mi) af[mi] = *(const bf16x8*)(As + (wr * 64 + mi * 16 + fr) * 72 + kk * 32 + fq * 8);
#pragma unroll
      for (int ni = 0; ni < NFRAG; ++ni) bfr[ni] = *(const bf16x8*)(Bs + (wc * NFRAG * 16 + ni * 16 + fr) * 72 + kk * 32 + fq * 8);
#pragma unroll
      for (int mi = 0; mi < 4; ++mi)
#pragma unroll
        for (int ni = 0; ni < NFRAG; ++ni) acc[mi][ni] = MFMA16(af[mi], bfr[ni], acc[mi][ni]);
    }
  }
  constexpr int CP = 32 * NFRAG + 4;
  float* Cs = (float*)lds;
  __syncthreads();
#pragma unroll
  for (int mi = 0; mi < 4; ++mi)
#pragma unroll
    for (int ni = 0; ni < NFRAG; ++ni)
#pragma unroll
      for (int jj = 0; jj < 4; ++jj) Cs[(wr * 64 + mi * 16 + fq * 4 + jj) * CP + wc * NFRAG * 16 + ni * 16 + fr] = acc[mi][ni][jj];
  if (SUMSQ) {
    float* rowstat = (float*)(lds + ROWSTAT_OFF);
#pragma unroll
    for (int i = 0; i < 4; ++i) {
      float s = ssq[i];
      s += __shfl_xor(s, 1); s += __shfl_xor(s, 2); s += __shfl_xor(s, 4);
      if (lc == 0) rowstat[lr + 32 * i] = rsqrtf(s / (float)K + EPS);
    }
  }
  __syncthreads();
}

DI void rope8(float* v, const float* pv, const float* RC, const float* RS, int pos, int a, int half) {
  const f32x4 c0 = *(const f32x4*)(RC + pos * 16 + a * 8), c1 = *(const f32x4*)(RC + pos * 16 + a * 8 + 4);
  const f32x4 s0 = *(const f32x4*)(RS + pos * 16 + a * 8), s1 = *(const f32x4*)(RS + pos * 16 + a * 8 + 4);
  const float cs[8] = {c0.x, c0.y, c0.z, c0.w, c1.x, c1.y, c1.z, c1.w};
  const float sn[8] = {s0.x, s0.y, s0.z, s0.w, s1.x, s1.y, s1.z, s1.w};
#pragma unroll
  for (int e = 0; e < 8; ++e) v[e] = (half == 0) ? (v[e] * cs[e] - pv[e] * sn[e]) : (v[e] * cs[e] + pv[e] * sn[e]);
}


DI void xcd_tile(int v, int MPX, int NT, int MC, int& mt, int& nt) {
  const int x = v & 7, L = v >> 3;
  const int c = L / (MC * NT), base = c * MC;
  const int rows = min(MC, MPX - base), rem = L - c * MC * NT;
  nt = rem / rows;
  mt = x * MPX + base + rem % rows;
}

struct TileDesc { const bf16_t* A; const bf16_t* B; int nvalid; };

template <int NFRAG>
DI void g_issue(u32x4 (&ra)[4], u32x4 (&rb)[NFRAG], const bf16_t* cA, const bf16_t* cB, int cnv, int lda, int K, int ko, int lr) {
#pragma unroll
  for (int i = 0; i < 4; ++i) ra[i] = *(const u32x4*)(cA + (size_t)(32 * i) * lda + ko);
#pragma unroll
  for (int i = 0; i < NFRAG; ++i) { const int ro = (lr + 32 * i < cnv) ? 32 * i : 0;
    rb[i] = *(const u32x4*)(cB + (size_t)ro * K + ko); }
}

constexpr int GP = 80;

template <int NFRAG, bool SUMSQ>
DI void g_write(const u32x4 (&ra)[4], const u32x4 (&rb)[NFRAG], float (&ssq)[4], bf16_t* As, bf16_t* Bs, int lr, int lc) {
#pragma unroll
  for (int i = 0; i < 4; ++i) {
    *(u32x4*)(As + (lr + 32 * i) * GP + lc * 8) = ra[i];
    if (SUMSQ) {
      ssq[i] = __builtin_amdgcn_fdot2_f32_bf16(__builtin_bit_cast(bf16v2_t, ra[i].x), __builtin_bit_cast(bf16v2_t, ra[i].x), ssq[i], false);
      ssq[i] = __builtin_amdgcn_fdot2_f32_bf16(__builtin_bit_cast(bf16v2_t, ra[i].y), __builtin_bit_cast(bf16v2_t, ra[i].y), ssq[i], false);
      ssq[i] = __builtin_amdgcn_fdot2_f32_bf16(__builtin_bit_cast(bf16v2_t, ra[i].z), __builtin_bit_cast(bf16v2_t, ra[i].z), ssq[i], false);
      ssq[i] = __builtin_amdgcn_fdot2_f32_bf16(__builtin_bit_cast(bf16v2_t, ra[i].w), __builtin_bit_cast(bf16v2_t, ra[i].w), ssq[i], false);
    }
  }
#pragma unroll
  for (int i = 0; i < NFRAG; ++i) *(u32x4*)(Bs + (lr + 32 * i) * GP + lc * 8) = rb[i];
}

template <int NFRAG>
DI void g_read(bf16x8 (&af)[2][4], bf16x8 (&bfr)[2][NFRAG], const bf16_t* As, const bf16_t* Bs, int wr, int wc, int fr, int fq) {
#pragma unroll
  for (int kk = 0; kk < 2; ++kk) {
#pragma unroll
    for (int mi = 0; mi < 4; ++mi) af[kk][mi] = *(const bf16x8*)(As + (wr * 64 + mi * 16 + fr) * GP + kk * 32 + fq * 8);
#pragma unroll
    for (int ni = 0; ni < NFRAG; ++ni) bfr[kk][ni] = *(const bf16x8*)(Bs + (wc * NFRAG * 16 + ni * 16 + fr) * GP + kk * 32 + fq * 8);
  }
}

template <int NFRAG>
DI void g_mma(f32x4 (&acc)[4][NFRAG], const bf16x8 (&af)[2][4], const bf16x8 (&bfr)[2][NFRAG]) {
#pragma unroll
  for (int kk = 0; kk < 2; ++kk)
#pragma unroll
    for (int mi = 0; mi < 4; ++mi)
#pragma unroll
      for (int ni = 0; ni < NFRAG; ++ni) acc[mi][ni] = MFMA16(af[kk][mi], bfr[kk][ni], acc[mi][ni]);
}

template <int NFRAG, bool SUMSQ, class OPS>
DI void gemm_stream(int ntiles, int lda, int K, const OPS& ops, unsigned char* lds, int rot = 0) {
  bf16_t* As = (bf16_t*)lds;
  bf16_t* Bs = As + 128 * GP;
  const int t = tid_opaque(), lane = t & 63, w = t >> 6, wr = w >> 1, wc = w & 1, fr = lane & 15, fq = lane >> 4;
  const int lc = t & 7, lr = t >> 3;
  const int nk = K >> 6;
  const int G = gridDim.x;
  const int vb = (int)((blockIdx.x + (unsigned)rot) % gridDim.x);
  int lt = vb, lk = 0;
  const bf16_t *cA = nullptr, *cB = nullptr; int cnv = 0;
  if (lt >= ntiles) return;
  { const TileDesc d = ops.tile(lt); cA = d.A + (size_t)lr * lda + lc * 8; cB = d.B + (size_t)lr * K + lc * 8; cnv = d.nvalid; }
  u32x4 ra[4], rb[NFRAG];
#define G_ADVANCE() do { ++lk; if (lk == nk) { lk = 0; lt += G; if (lt < ntiles) { const TileDesc d = ops.tile(lt); cA = d.A + (size_t)lr * lda + lc * 8; cB = d.B + (size_t)lr * K + lc * 8; cnv = d.nvalid; } } } while (0)
  g_issue<NFRAG>(ra, rb, cA, cB, cnv, lda, K, lk * 64, lr);
  G_ADVANCE();
#pragma unroll 1
  for (int tile = vb; tile < ntiles; tile += G) {
    f32x4 acc[4][NFRAG];
    float ssq[4] = {0.f, 0.f, 0.f, 0.f};
#pragma unroll
    for (int mi = 0; mi < 4; ++mi)
#pragma unroll
      for (int ni = 0; ni < NFRAG; ++ni) acc[mi][ni] = (f32x4){0.f, 0.f, 0.f, 0.f};
    __syncthreads();
    g_write<NFRAG, SUMSQ>(ra, rb, ssq, As, Bs, lr, lc);
    g_issue<NFRAG>(ra, rb, cA, cB, cnv, lda, K, lk * 64, lr);
    G_ADVANCE();
    __syncthreads();
#pragma unroll 1
    for (int kt = 0; kt < nk - 1; ++kt) {
      bf16x8 af[2][4], bfr[2][NFRAG];
      g_read<NFRAG>(af, bfr, As, Bs, wr, wc, fr, fq);
      __syncthreads();
      g_write<NFRAG, SUMSQ>(ra, rb, ssq, As, Bs, lr, lc);
      g_issue<NFRAG>(ra, rb, cA, cB, cnv, lda, K, lk * 64, lr);
      G_ADVANCE();
      g_mma<NFRAG>(acc, af, bfr);
      __syncthreads();
    }
    {
      bf16x8 af[2][4], bfr[2][NFRAG];
      g_read<NFRAG>(af, bfr, As, Bs, wr, wc, fr, fq);
      g_mma<NFRAG>(acc, af, bfr);
    }
#undef G_ADVANCE
    constexpr int CP = 32 * NFRAG + 4;
    float* Cs = (float*)lds;
    __syncthreads();
#pragma unroll
    for (int mi = 0; mi < 4; ++mi)
#pragma unroll
      for (int ni = 0; ni < NFRAG; ++ni)
#pragma unroll
        for (int jj = 0; jj < 4; ++jj) Cs[(wr * 64 + mi * 16 + fq * 4 + jj) * CP + wc * NFRAG * 16 + ni * 16 + fr] = acc[mi][ni][jj];
    if (SUMSQ) {
      float* rowstat = (float*)(lds + ROWSTAT_OFF);
#pragma unroll
      for (int i = 0; i < 4; ++i) {
        float sv = ssq[i];
        sv += __shfl_xor(sv, 1); sv += __shfl_xor(sv, 2); sv += __shfl_xor(sv, 4);
        if (lc == 0) rowstat[lr + 32 * i] = rsqrtf(sv / (float)K + EPS);
      }
    }
    __syncthreads();
    ops.epi(tile, lds);
  }
}


template <int NFRAG, class OPS>
DI void gemm_glds(int ntiles, int lda, int K, const OPS& ops, unsigned char* lds, int rot = 0) {
  const int t = tid_opaque(), lane = t & 63, w = t >> 6, wr = w >> 1, wc = w & 1, fr = lane & 15, fq = lane >> 4;
  const int nk = K >> 6;
  const int G = gridDim.x;
  const int vb = (int)((blockIdx.x + (unsigned)rot) % gridDim.x);
  const int srow = t >> 3, skc = (t & 7) ^ ((t >> 3) & 7);
  constexpr int STAGE = 32768, BOFF = 16384;
#pragma unroll 1
  for (int tile = vb; tile < ntiles; tile += G) {
    const TileDesc d = ops.tile(tile);
    const bf16_t* gA = d.A + (size_t)srow * lda + skc * 8;
    const bf16_t* gB = d.B + (size_t)srow * K + skc * 8;
    const int cnv = d.nvalid;
    f32x4 acc[4][NFRAG];
#pragma unroll
    for (int mi = 0; mi < 4; ++mi)
#pragma unroll
      for (int ni = 0; ni < NFRAG; ++ni) acc[mi][ni] = (f32x4){0.f, 0.f, 0.f, 0.f};
    __syncthreads();
#define GLDS_ISSUE(stg, ko) do { \
      _Pragma("unroll") for (int i = 0; i < 4; ++i) \
        __builtin_amdgcn_global_load_lds((const unsigned*)(gA + (size_t)(32 * i) * lda + (ko)), (__attribute__((address_space(3))) unsigned*)(lds + (stg) * STAGE + (i * 256 + t) * 16), 16, 0, 0); \
      _Pragma("unroll") for (int i = 0; i < NFRAG; ++i) { const int ro = (srow + 32 * i < cnv) ? 32 * i : 0; \
        __builtin_amdgcn_global_load_lds((const unsigned*)(gB + (size_t)ro * K + (ko)), (__attribute__((address_space(3))) unsigned*)(lds + (stg) * STAGE + BOFF + (i * 256 + t) * 16), 16, 0, 0); } \
    } while (0)
    GLDS_ISSUE(0, 0);
    asm volatile("s_waitcnt vmcnt(0)" ::: "memory");
    __syncthreads();
#pragma unroll 1
    for (int kt = 0; kt < nk; ++kt) {
      const int sg = kt & 1;
      if (kt + 1 < nk) GLDS_ISSUE(sg ^ 1, (kt + 1) * 64);
      const unsigned char* As = lds + sg * STAGE;
      const unsigned char* Bs = As + BOFF;
#pragma unroll
      for (int kk = 0; kk < 2; ++kk) {
        bf16x8 af[4], bfr[NFRAG];
        const int sw = ((kk * 4 + fq) ^ (fr & 7)) * 16;
#pragma unroll
        for (int mi = 0; mi < 4; ++mi) af[mi] = *(const bf16x8*)(As + (wr * 64 + mi * 16 + fr) * 128 + sw);
#pragma unroll
        for (int ni = 0; ni < NFRAG; ++ni) bfr[ni] = *(const bf16x8*)(Bs + (wc * NFRAG * 16 + ni * 16 + fr) * 128 + sw);
#pragma unroll
        for (int mi = 0; mi < 4; ++mi)
#pragma unroll
          for (int ni = 0; ni < NFRAG; ++ni) acc[mi][ni] = MFMA16(af[mi], bfr[ni], acc[mi][ni]);
      }
      asm volatile("s_waitcnt vmcnt(0)" ::: "memory");
      __syncthreads();
    }
#undef GLDS_ISSUE
    constexpr int CP = 32 * NFRAG + 4;
    float* Cs = (float*)lds;
#pragma unroll
    for (int mi = 0; mi < 4; ++mi)
#pragma unroll
      for (int ni = 0; ni < NFRAG; ++ni)
#pragma unroll
        for (int jj = 0; jj < 4; ++jj) Cs[(wr * 64 + mi * 16 + fq * 4 + jj) * CP + wc * NFRAG * 16 + ni * 16 + fr] = acc[mi][ni][jj];
    __syncthreads();
    ops.epi(tile, lds);
  }
}


template <int NFRAG, class OPS, bool SUMSQ = false, bool LDSEPI = false>
DI void gemm_glds2(int ntiles, int lda, int K, const OPS& ops, unsigned char* lds, int rot = 0) {
  const int t = tid_opaque(), lane = t & 63, w = t >> 6, wr = w >> 1, wc = w & 1, fr = lane & 15, fq = lane >> 4;
  const int nk = K >> 6;
  const int G = gridDim.x;
  const int vb = (int)((blockIdx.x + (unsigned)rot) % gridDim.x);
  const int srow = t >> 3, skc = (t & 7) ^ ((t >> 3) & 7);
  constexpr int STAGE = 32768, BOFF = 16384;
  int tile = vb;
  if (tile >= ntiles) return;
  const bf16_t *gA, *gB; int cnv;
  { const TileDesc d = ops.tile(tile); gA = d.A + (size_t)srow * lda + skc * 8; gB = d.B + (size_t)srow * K + skc * 8; cnv = d.nvalid; }
#define GLDS_ISSUE(stg, ko) do { \
    _Pragma("unroll") for (int i = 0; i < 4; ++i) \
      __builtin_amdgcn_global_load_lds((const unsigned*)(gA + (size_t)(32 * i) * lda + (ko)), (__attribute__((address_space(3))) unsigned*)(lds + (stg) * STAGE + (i * 256 + t) * 16), 16, 0, 0); \
    _Pragma("unroll") for (int i = 0; i < NFRAG; ++i) { const int ro = (srow + 32 * i < cnv) ? 32 * i : 0; \
      __builtin_amdgcn_global_load_lds((const unsigned*)(gB + (size_t)ro * K + (ko)), (__attribute__((address_space(3))) unsigned*)(lds + (stg) * STAGE + BOFF + (i * 256 + t) * 16), 16, 0, 0); } \
  } while (0)
  __syncthreads();
  GLDS_ISSUE(0, 0);
#pragma unroll 1
  for (;;) {
    f32x4 acc[4][NFRAG];
#pragma unroll
    for (int mi = 0; mi < 4; ++mi)
#pragma unroll
      for (int ni = 0; ni < NFRAG; ++ni) acc[mi][ni] = (f32x4){0.f, 0.f, 0.f, 0.f};
    float ssq[4] = {0.f, 0.f, 0.f, 0.f};
    asm volatile("s_waitcnt vmcnt(0)" ::: "memory");
    __syncthreads();
#pragma unroll 1
    for (int kt = 0; kt < nk; ++kt) {
      const int sg = kt & 1;
      const unsigned char* As = lds + sg * STAGE;
      const unsigned char* Bs = As + BOFF;
#pragma unroll
      for (int kk = 0; kk < 2; ++kk) {
        bf16x8 af[4], bfr[NFRAG];
        const int sw = ((kk * 4 + fq) ^ (fr & 7)) * 16;
#pragma unroll
        for (int mi = 0; mi < 4; ++mi) af[mi] = *(const bf16x8*)(As + (wr * 64 + mi * 16 + fr) * 128 + sw);
#pragma unroll
        for (int ni = 0; ni < NFRAG; ++ni) bfr[ni] = *(const bf16x8*)(Bs + (wc * NFRAG * 16 + ni * 16 + fr) * 128 + sw);
        if (SUMSQ) {
#pragma unroll
          for (int mi = 0; mi < 4; ++mi) {
            const u32x4 aw = __builtin_bit_cast(u32x4, af[mi]);
            ssq[mi] = __builtin_amdgcn_fdot2_f32_bf16(__builtin_bit_cast(bf16v2_t, aw.x), __builtin_bit_cast(bf16v2_t, aw.x), ssq[mi], false);
            ssq[mi] = __builtin_amdgcn_fdot2_f32_bf16(__builtin_bit_cast(bf16v2_t, aw.y), __builtin_bit_cast(bf16v2_t, aw.y), ssq[mi], false);
            ssq[mi] = __builtin_amdgcn_fdot2_f32_bf16(__builtin_bit_cast(bf16v2_t, aw.z), __builtin_bit_cast(bf16v2_t, aw.z), ssq[mi], false);
            ssq[mi] = __builtin_amdgcn_fdot2_f32_bf16(__builtin_bit_cast(bf16v2_t, aw.w), __builtin_bit_cast(bf16v2_t, aw.w), ssq[mi], false);
          }
        }
        if (kk == 0 && kt + 1 < nk) GLDS_ISSUE(sg ^ 1, (kt + 1) * 64);
#pragma unroll
        for (int mi = 0; mi < 4; ++mi)
#pragma unroll
          for (int ni = 0; ni < NFRAG; ++ni) acc[mi][ni] = MFMA16(af[mi], bfr[ni], acc[mi][ni]);
      }
      asm volatile("s_waitcnt vmcnt(0)" ::: "memory");
      __syncthreads();
    }
    constexpr int CP = 32 * NFRAG + 4;
    float* Cs = (float*)lds;
#pragma unroll
    for (int mi = 0; mi < 4; ++mi)
#pragma unroll
      for (int ni = 0; ni < NFRAG; ++ni)
#pragma unroll
        for (int jj = 0; jj < 4; ++jj) Cs[(wr * 64 + mi * 16 + fq * 4 + jj) * CP + wc * NFRAG * 16 + ni * 16 + fr] = acc[mi][ni][jj];
    if (SUMSQ) {
      float* rowstat = (float*)(lds + ROWSTAT_OFF);
#pragma unroll
      for (int mi = 0; mi < 4; ++mi) {
        float sv = ssq[mi];
        sv += __shfl_xor(sv, 16); sv += __shfl_xor(sv, 32);
        if (wc == 0 && fq == 0) rowstat[wr * 64 + mi * 16 + fr] = rsqrtf(sv / (float)K + EPS);
      }
    }
    __syncthreads();
    const int cur = tile;
    if (LDSEPI) {
      ops.epi_lds(cur, lds);
      __syncthreads();
      tile += G;
      const bool more = tile < ntiles;
      if (more) {
        const TileDesc d = ops.tile(tile); gA = d.A + (size_t)srow * lda + skc * 8; gB = d.B + (size_t)srow * K + skc * 8; cnv = d.nvalid;
        GLDS_ISSUE(0, 0);
      }
      if (!more) break;
    } else {
      float c[64];
      ops.epi_read(cur, lds, c);
      __syncthreads();
      tile += G;
      const bool more = tile < ntiles;
      if (more) {
        const TileDesc d = ops.tile(tile); gA = d.A + (size_t)srow * lda + skc * 8; gB = d.B + (size_t)srow * K + skc * 8; cnv = d.nvalid;
        GLDS_ISSUE(0, 0);
      }
      ops.epi_write(cur, c);
      if (!more) break;
    }
  }
#undef GLDS_ISSUE
}

struct EvWinOps2 {
  const Params* pp;
  DI void epi_lds(int, unsigned char*) const {}
  DI TileDesc tile(int id) const {
    int mt, nt; xcd_tile(id, 18, 25, 6, mt, nt);
    TileDesc d; d.A = (const bf16_t*)(pp->ws + WS_R1) + (size_t)mt * 128 * D; d.B = (const bf16_t*)(pp->ws + WS_WT + WT_EV_IN) + (size_t)nt * 128 * D; d.nvalid = EVEN_IN - nt * 128;
    return d;
  }
  DI void epi_read(int id, unsigned char* lds, float (&c)[64]) const {
    const int t = tid_opaque();
    const float* Cs = (const float*)lds;
#pragma unroll
    for (int it = 0; it < 8; ++it) {
      const int row = (t >> 4) + 16 * it, ch = t & 15;
      *(f32x4*)(c + it * 8) = *(const f32x4*)(Cs + row * 132 + ch * 8);
      *(f32x4*)(c + it * 8 + 4) = *(const f32x4*)(Cs + row * 132 + ch * 8 + 4);
    }
  }
  DI void epi_write(int id, const float (&c)[64]) const {
    int mt, nt; xcd_tile(id, 18, 25, 6, mt, nt);
    const int m0 = mt * 128, n0 = nt * 128;
    bf16_t* U1 = (bf16_t*)(pp->ws + WS_R2);
    bf16_t* U2 = (bf16_t*)(pp->ws + WS_U2);
    const int t = tid_opaque();
    const int ch = t & 15, col = n0 + ch * 8;
    if (col < EVEN_IN) {
#pragma unroll
      for (int it = 0; it < 8; ++it) {
        const int m = m0 + (t >> 4) + 16 * it;
        bf16_t* dst = (col < U1W) ? U1 + (size_t)m * U1W + col : U2 + (size_t)m * U2W + (col - U1W);
        *(u32x4*)dst = pack8(c + it * 8);
      }
    }
  }
};

struct WoutOps2 {
  const Params* pp; int layer;
  DI void epi_lds(int, unsigned char*) const {}
  DI TileDesc tile(int id) const {
    const bool even = (layer & 1) == 0;
    int mt, nt; xcd_tile(id, (layer == 3) ? 16 : 18, 8, (layer == 3) ? 8 : 6, mt, nt);
    TileDesc d; d.A = (const bf16_t*)(pp->ws + (even ? WS_R2 : WS_OH)) + (size_t)mt * 128 * D;
    d.B = (const bf16_t*)(pp->ws + WS_WT + (even ? WT_EV_OUT : WT_OD_OUT)) + (size_t)nt * 128 * D; d.nvalid = 128;
    return d;
  }
  DI void epi_read(int id, unsigned char* lds, float (&c)[64]) const {
    const int t = tid_opaque();
    const float* Cs = (const float*)lds;
#pragma unroll
    for (int it = 0; it < 16; ++it) {
      const int row = (t >> 5) + 8 * it, c4 = t & 31;
      *(f32x4*)(c + it * 4) = *(const f32x4*)(Cs + row * 132 + c4 * 4);
    }
  }
  DI void epi_write(int id, const float (&c)[64]) const {
    const Params& p = *pp;
    int mt, nt; xcd_tile(id, (layer == 3) ? 16 : 18, 8, (layer == 3) ? 8 : 6, mt, nt);
    const int m0 = mt * 128, n0 = nt * 128;
    const float* MOD = (const float*)(p.ws + WS_MOD);
    float* CX = (float*)(p.ws + WS_CX);
    const int t = tid_opaque();
    const bool lat = m0 < NLAT;
    const int r = lat ? (m0 >> 11) : 8;
    const int n = n0 + (t & 31) * 4;
    const float* xin = (lat ? ((layer == 0 ? p.x : p.out) + (size_t)m0 * D) : ((layer == 0 ? p.ctx : CX) + (size_t)(m0 - NLAT) * D)) + n;
    float* xout = (lat ? (p.out + (size_t)m0 * D) : (CX + (size_t)(m0 - NLAT) * D)) + n;
    const f32x4 g = *(const f32x4*)(MOD + (size_t)(layer * 9 + r) * 3072 + 2048 + n);
#pragma unroll
    for (int half = 0; half < 2; ++half) {
      f32x4 xi[8];
#pragma unroll
      for (int q = 0; q < 8; ++q) xi[q] = *(const f32x4*)(xin + (size_t)((t >> 5) + 8 * (half * 8 + q)) * D);
#pragma unroll
      for (int q = 0; q < 8; ++q) {
        const int it = half * 8 + q;
        f32x4 o; o.x = xi[q].x + g.x * c[it * 4]; o.y = xi[q].y + g.y * c[it * 4 + 1]; o.z = xi[q].z + g.z * c[it * 4 + 2]; o.w = xi[q].w + g.w * c[it * 4 + 3];
        *(f32x4*)(xout + (size_t)((t >> 5) + 8 * it) * D) = o;
      }
    }
  }
};

struct EvWinOps {
  const Params* pp;
  DI TileDesc tile(int id) const {
    int mt, nt; xcd_tile(id, 18, 25, 6, mt, nt);
    TileDesc d; d.A = (const bf16_t*)(pp->ws + WS_R1) + (size_t)mt * 128 * D; d.B = (const bf16_t*)(pp->ws + WS_WT + WT_EV_IN) + (size_t)nt * 128 * D; d.nvalid = EVEN_IN - nt * 128;
    return d;
  }
  DI void epi(int id, unsigned char* lds) const {
    int mt, nt; xcd_tile(id, 18, 25, 6, mt, nt);
    const int m0 = mt * 128, n0 = nt * 128;
    bf16_t* U1 = (bf16_t*)(pp->ws + WS_R2);
    bf16_t* U2 = (bf16_t*)(pp->ws + WS_U2);
    const int t = tid_opaque();
    const float* Cs = (const float*)lds;
    for (int idx = t; idx < 128 * 16; idx += 256) {
      const int row = idx >> 4, ch = idx & 15, col = n0 + ch * 8;
      if (col < EVEN_IN) {
        float v[8];
        *(f32x4*)v = *(const f32x4*)(Cs + row * 132 + ch * 8);
        *(f32x4*)(v + 4) = *(const f32x4*)(Cs + row * 132 + ch * 8 + 4);
        const int m = m0 + row;
        bf16_t* dst = (col < U1W) ? U1 + (size_t)m * U1W + col : U2 + (size_t)m * U2W + (col - U1W);
        *(u32x4*)dst = pack8(v);
      }
    }
  }
};
DI void phase_ev_win(const Params& p, unsigned char* lds) {
  EvWinOps2 ops; ops.pp = &p;
  gemm_glds2<4>(144 * 25, D, D, ops, lds);
}

struct WoutOps {
  const Params* pp; int layer;
  DI TileDesc tile(int id) const {
    const bool even = (layer & 1) == 0;
    int mt, nt; xcd_tile(id, (layer == 3) ? 16 : 18, 8, (layer == 3) ? 8 : 6, mt, nt);
    TileDesc d; d.A = (const bf16_t*)(pp->ws + (even ? WS_R2 : WS_OH)) + (size_t)mt * 128 * D;
    d.B = (const bf16_t*)(pp->ws + WS_WT + (even ? WT_EV_OUT : WT_OD_OUT)) + (size_t)nt * 128 * D; d.nvalid = 128;
    return d;
  }
  DI void epi(int id, unsigned char* lds) const {
    const Params& p = *pp;
    int mt, nt; xcd_tile(id, (layer == 3) ? 16 : 18, 8, (layer == 3) ? 8 : 6, mt, nt);
    const int m0 = mt * 128, n0 = nt * 128;
    const float* MOD = (const float*)(p.ws + WS_MOD);
    float* CX = (float*)(p.ws + WS_CX);
    const int t = tid_opaque();
    const float* Cs = (const float*)lds;
    const bool lat = m0 < NLAT;
    const int r = lat ? (m0 >> 11) : 8;
    const float* gate = MOD + (size_t)(layer * 9 + r) * 3072 + 2048;
    const float* xin = lat ? ((layer == 0 ? p.x : p.out) + (size_t)m0 * D) : ((layer == 0 ? p.ctx : CX) + (size_t)(m0 - NLAT) * D);
    float* xout = lat ? (p.out + (size_t)m0 * D) : (CX + (size_t)(m0 - NLAT) * D);
    for (int idx = t; idx < 128 * 32; idx += 256) {
      const int row = idx >> 5, c4 = idx & 31, n = n0 + c4 * 4;
      const f32x4 a = *(const f32x4*)(Cs + row * 132 + c4 * 4);
      const f32x4 g = *(const f32x4*)(gate + n);
      const f32x4 xi = *(const f32x4*)(xin + (size_t)row * D + n);
      f32x4 o; o.x = xi.x + g.x * a.x; o.y = xi.y + g.y * a.y; o.z = xi.z + g.z * a.z; o.w = xi.w + g.w * a.w;
      *(f32x4*)(xout + (size_t)row * D + n) = o;
    }
  }
};
DI void phase_wout(const Params& p, int layer, unsigned char* lds) {
  WoutOps2 ops; ops.pp = &p; ops.layer = layer;
  gemm_glds2<4>(((layer == 3) ? 128 : 144) * 8, D, D, ops, lds);
}

DI void ev_q_tile(const Params& p, int j, int mt, int head, unsigned char* lds) {
  const bf16_t* U1 = (const bf16_t*)(p.ws + WS_R2);
  const bf16_t* WT = (const bf16_t*)(p.ws + WS_WT + WT_EV_UQ);
  bf16_t* QA = (bf16_t*)(p.ws + WS_R1 + R1_QA);
  const float* RC = (const float*)(p.ws + WS_ROPEC);
  const float* RS = (const float*)(p.ws + WS_ROPES);
  const int t = tid_opaque(), m0 = mt * 128;
  float* Cs = (float*)lds;
  float* rowstat = (float*)(lds + ROWSTAT_OFF);
  float* rowstat2 = (float*)(lds + ROWSTAT2_OFF);
#pragma unroll 1
  for (int it = 0; it < 4; ++it) {
    const int idx = t + 256 * it, row = idx >> 3, l8 = idx & 7;
    float ss = 0.f;
#pragma unroll
    for (int q = 0; q < 3; ++q) { const f32x4 v = *(const f32x4*)(Cs + row * 100 + l8 * 12 + q * 4); ss += v.x * v.x + v.y * v.y + v.z * v.z + v.w * v.w; }
    ss += __shfl_xor(ss, 1); ss += __shfl_xor(ss, 2); ss += __shfl_xor(ss, 4);
    const float rin = rowstat[row];
    const float rstd2 = rsqrtf(ss * rin * rin * (1.f / 96.f) + EPS);
    if (l8 == 0) rowstat2[row] = rin * rstd2;
  }
  __syncthreads();
  const float* qg = p.ev_q_gain + j * 96;
  int b, pos0; tok_bp(m0, b, pos0);
  const bool lat = m0 < NLAT;
  const float QS = 0.10206207261596575f * LOG2E;
  bf16_t* qdst = QA + ((size_t)(b * 8 + head) * KEYS + pos0) * 96;
  {
    const int ch = t & 7;
    const f32x4 g0 = *(const f32x4*)(qg + ch * 8), g1 = *(const f32x4*)(qg + ch * 8 + 4);
    const float gg[8] = {g0.x, g0.y, g0.z, g0.w, g1.x, g1.y, g1.z, g1.w};
#pragma unroll
    for (int it = 0; it < 4; ++it) {
      const int row = (t >> 3) + 32 * it;
      const float f = rowstat2[row] * QS;
      float v[8];
      *(f32x4*)v = *(const f32x4*)(Cs + row * 100 + ch * 8);
      *(f32x4*)(v + 4) = *(const f32x4*)(Cs + row * 100 + ch * 8 + 4);
#pragma unroll
      for (int e = 0; e < 8; ++e) v[e] *= f * gg[e];
      *(u32x4*)(qdst + (size_t)row * 96 + ch * 8) = pack8(v);
    }
  }
  {
    const int rc = t & 3, ch = 8 + rc, pch = ch ^ 1;
    const f32x4 g0 = *(const f32x4*)(qg + ch * 8), g1 = *(const f32x4*)(qg + ch * 8 + 4);
    const f32x4 h0 = *(const f32x4*)(qg + pch * 8), h1 = *(const f32x4*)(qg + pch * 8 + 4);
    const float gg[8] = {g0.x, g0.y, g0.z, g0.w, g1.x, g1.y, g1.z, g1.w};
    const float pg[8] = {h0.x, h0.y, h0.z, h0.w, h1.x, h1.y, h1.z, h1.w};
    f32x4 cs4[2][2], sn4[2][2];
    if (lat) {
#pragma unroll
      for (int it = 0; it < 2; ++it) {
        const int pos = pos0 + (t >> 2) + 64 * it;
        cs4[it][0] = *(const f32x4*)(RC + pos * 16 + (rc >> 1) * 8); cs4[it][1] = *(const f32x4*)(RC + pos * 16 + (rc >> 1) * 8 + 4);
        sn4[it][0] = *(const f32x4*)(RS + pos * 16 + (rc >> 1) * 8); sn4[it][1] = *(const f32x4*)(RS + pos * 16 + (rc >> 1) * 8 + 4);
      }
    }
#pragma unroll
    for (int it = 0; it < 2; ++it) {
      const int row = (t >> 2) + 64 * it;
      const float f = rowstat2[row];
      float v[8], pv[8];
      *(f32x4*)v = *(const f32x4*)(Cs + row * 100 + ch * 8);
      *(f32x4*)(v + 4) = *(const f32x4*)(Cs + row * 100 + ch * 8 + 4);
      *(f32x4*)pv = *(const f32x4*)(Cs + row * 100 + pch * 8);
      *(f32x4*)(pv + 4) = *(const f32x4*)(Cs + row * 100 + pch * 8 + 4);
#pragma unroll
      for (int e = 0; e < 8; ++e) { v[e] *= f * gg[e]; pv[e] *= f * pg[e]; }
      if (lat) {
        const float cs[8] = {cs4[it][0].x, cs4[it][0].y, cs4[it][0].z, cs4[it][0].w, cs4[it][1].x, cs4[it][1].y, cs4[it][1].z, cs4[it][1].w};
        const float sn[8] = {sn4[it][0].x, sn4[it][0].y, sn4[it][0].z, sn4[it][0].w, sn4[it][1].x, sn4[it][1].y, sn4[it][1].z, sn4[it][1].w};
#pragma unroll
        for (int e = 0; e < 8; ++e) v[e] = ((rc & 1) == 0) ? (v[e] * cs[e] - pv[e] * sn[e]) : (v[e] * cs[e] + pv[e] * sn[e]);
      }
#pragma unroll
      for (int e = 0; e < 8; ++e) v[e] *= QS;
      *(u32x4*)(qdst + (size_t)row * 96 + ch * 8) = pack8(v);
    }
  }
}

DI void ev_kv_tile(const Params& p, int j, int mt, int head, unsigned char* lds) {
  const bf16_t* U1 = (const bf16_t*)(p.ws + WS_R2);
  const bf16_t* WT = (const bf16_t*)(p.ws + WS_WT + WT_EV_UKV);
  bf16_t* KA = (bf16_t*)(p.ws + WS_R1 + R1_KA);
  bf16_t* VAT = (bf16_t*)(p.ws + WS_R1 + R1_VAT);
  const float* RC = (const float*)(p.ws + WS_ROPEC);
  const float* RS = (const float*)(p.ws + WS_ROPES);
  const int t = tid_opaque(), m0 = mt * 128;
  float* Cs = (float*)lds;
  float* rowstat = (float*)(lds + ROWSTAT_OFF);
  float* rowstat2 = (float*)(lds + ROWSTAT2_OFF);
  {
    const int l8 = t & 7;
    u32x2 kr[4];
#pragma unroll
    for (int it = 0; it < 4; ++it) kr[it] = *(const u32x2*)(U1 + (size_t)(m0 + (t >> 3) + 32 * it) * U1W + 1024 + l8 * 4);
#pragma unroll
    for (int it = 0; it < 4; ++it) {
      const int row = (t >> 3) + 32 * it;
      const float rin = rowstat[row];
      float ss = 0.f;
#pragma unroll
      for (int q = 0; q < 2; ++q) { const f32x4 v = *(const f32x4*)(Cs + row * 132 + l8 * 8 + q * 4); ss += v.x * v.x + v.y * v.y + v.z * v.z + v.w * v.w; }
      ss *= rin * rin;
      const float k0 = bflo(kr[it].x), k1 = bfhi(kr[it].x), k2 = bflo(kr[it].y), k3 = bfhi(kr[it].y);
      ss += k0 * k0 + k1 * k1 + k2 * k2 + k3 * k3;
      ss += __shfl_xor(ss, 1); ss += __shfl_xor(ss, 2); ss += __shfl_xor(ss, 4);
      if (l8 == 0) rowstat2[row] = rsqrtf(ss * (1.f / 96.f) + EPS);
    }
  }
  __syncthreads();
  const float* kg = p.ev_k_gain + j * 96;
  int b, pos0; tok_bp(m0, b, pos0);
  const bool lat = m0 < NLAT;
  bf16_t* kdst = KA + ((size_t)(b * 8 + head) * KEYS + pos0) * 96;
  {
    const int ch = t & 7;
    const f32x4 g0 = *(const f32x4*)(kg + ch * 8), g1 = *(const f32x4*)(kg + ch * 8 + 4);
    const float gg[8] = {g0.x, g0.y, g0.z, g0.w, g1.x, g1.y, g1.z, g1.w};
#pragma unroll
    for (int it = 0; it < 4; ++it) {
      const int row = (t >> 3) + 32 * it;
      const float f = rowstat[row] * rowstat2[row];
      float v[8];
      *(f32x4*)v = *(const f32x4*)(Cs + row * 132 + ch * 8);
      *(f32x4*)(v + 4) = *(const f32x4*)(Cs + row * 132 + ch * 8 + 4);
#pragma unroll
      for (int e = 0; e < 8; ++e) v[e] *= f * gg[e];
      *(u32x4*)(kdst + (size_t)row * 96 + ch * 8) = pack8(v);
    }
  }
  {
    const int rc = t & 3, prc = rc ^ 1;
    const f32x4 g0 = *(const f32x4*)(kg + 64 + rc * 8), g1 = *(const f32x4*)(kg + 64 + rc * 8 + 4);
    const f32x4 h0 = *(const f32x4*)(kg + 64 + prc * 8), h1 = *(const f32x4*)(kg + 64 + prc * 8 + 4);
    const float gg[8] = {g0.x, g0.y, g0.z, g0.w, g1.x, g1.y, g1.z, g1.w};
    const float pg[8] = {h0.x, h0.y, h0.z, h0.w, h1.x, h1.y, h1.z, h1.w};
    u32x4 own[2], par[2];
    f32x4 cs4[2][2], sn4[2][2];
#pragma unroll
    for (int it = 0; it < 2; ++it) {
      const int row = (t >> 2) + 64 * it;
      const bf16_t* krp = U1 + (size_t)(m0 + row) * U1W + 1024;
      own[it] = *(const u32x4*)(krp + rc * 8);
      par[it] = *(const u32x4*)(krp + prc * 8);
      if (lat) {
        const int pos = pos0 + row;
        cs4[it][0] = *(const f32x4*)(RC + pos * 16 + (rc >> 1) * 8); cs4[it][1] = *(const f32x4*)(RC + pos * 16 + (rc >> 1) * 8 + 4);
        sn4[it][0] = *(const f32x4*)(RS + pos * 16 + (rc >> 1) * 8); sn4[it][1] = *(const f32x4*)(RS + pos * 16 + (rc >> 1) * 8 + 4);
      }
    }
#pragma unroll
    for (int it = 0; it < 2; ++it) {
      const int row = (t >> 2) + 64 * it;
      const float rk = rowstat2[row];
      float v[8], pv[8];
      unpack8(own[it], v);
      unpack8(par[it], pv);
#pragma unroll
      for (int e = 0; e < 8; ++e) { v[e] *= rk * gg[e]; pv[e] *= rk * pg[e]; }
      if (lat) {
        const float cs[8] = {cs4[it][0].x, cs4[it][0].y, cs4[it][0].z, cs4[it][0].w, cs4[it][1].x, cs4[it][1].y, cs4[it][1].z, cs4[it][1].w};
        const float sn[8] = {sn4[it][0].x, sn4[it][0].y, sn4[it][0].z, sn4[it][0].w, sn4[it][1].x, sn4[it][1].y, sn4[it][1].z, sn4[it][1].w};
#pragma unroll
        for (int e = 0; e < 8; ++e) v[e] = ((rc & 1) == 0) ? (v[e] * cs[e] - pv[e] * sn[e]) : (v[e] * cs[e] + pv[e] * sn[e]);
      }
      *(u32x4*)(kdst + (size_t)row * 96 + 64 + rc * 8) = pack8(v);
    }
  }
#pragma unroll
  for (int it = 0; it < 4; ++it) {
    const int idx = t + 256 * it, rg = idx & 15, e = idx >> 4;
    float v[8];
#pragma unroll
    for (int q = 0; q < 8; ++q) v[q] = Cs[(rg * 8 + q) * 132 + 64 + e] * rowstat[rg * 8 + q];
    *(u32x4*)(VAT + ((size_t)(b * 8 + head) * 64 + e) * KEYS + pos0 + rg * 8) = pack8(v);
  }
}

struct EvQOps {
  const Params* pp; int j;
  DI TileDesc tile(int id) const {
    int mt, head; xcd_tile(id, 18, 8, 6, mt, head);
    TileDesc d; d.A = (const bf16_t*)(pp->ws + WS_R2) + (size_t)mt * 128 * U1W; d.B = (const bf16_t*)(pp->ws + WS_WT + WT_EV_UQ) + (size_t)(head * 96) * 768; d.nvalid = 96;
    return d;
  }
  DI void epi(int id, unsigned char* lds) const { int mt, head; xcd_tile(id, 18, 8, 6, mt, head); ev_q_tile(*pp, j, mt, head, lds); }
  DI void epi_lds(int id, unsigned char* lds) const { epi(id, lds); }
  DI void epi_read(int, unsigned char*, float (&)[64]) const {}
  DI void epi_write(int, const float (&)[64]) const {}
};
struct EvKvOps {
  const Params* pp; int j;
  DI TileDesc tile(int id) const {
    int mt, head; xcd_tile(id, 18, 8, 6, mt, head);
    TileDesc d; d.A = (const bf16_t*)(pp->ws + WS_R2) + (size_t)mt * 128 * U1W + 768; d.B = (const bf16_t*)(pp->ws + WS_WT + WT_EV_UKV) + (size_t)(head * 128) * 256; d.nvalid = 128;
    return d;
  }
  DI void epi(int id, unsigned char* lds) const { int mt, head; xcd_tile(id, 18, 8, 6, mt, head); ev_kv_tile(*pp, j, mt, head, lds); }
  DI void epi_lds(int id, unsigned char* lds) const { epi(id, lds); }
  DI void epi_read(int, unsigned char*, float (&)[64]) const {}
  DI void epi_write(int, const float (&)[64]) const {}
};

constexpr int GL_QT = 0, GL_KT = 9216, GL_ATT = 18432, GL_VT = 27648, GL_ST = 46080, GL_RS = 64512, GL_SEG = 72704;

DI float log_sigmoid_f(float x) { return fminf(x, 0.f) - __logf(1.f + __expf(-fabsf(x))); }

template <int DIR>
DI float gla_decay(const float (&gw)[16], float gb, unsigned char* lds, float (&bb)[16]) {
  const int t = tid_opaque(), d = t & 63, qd = t >> 6;
  const float* rs = (const float*)(lds + GL_RS);
  float* seg = (float*)(lds + GL_SEG);
  float ssum = 0.f;
#pragma unroll
  for (int i = 0; i < 16; ++i) {
    const int l = qd * 16 + i;
    float lg = gb;
#pragma unroll
    for (int q = 0; q < 4; ++q) {
      const f32x4 rv = *(const f32x4*)(rs + l * 32 + DIR * 16 + q * 4);
      lg += rv.x * gw[q * 4] + rv.y * gw[q * 4 + 1] + rv.z * gw[q * 4 + 2] + rv.w * gw[q * 4 + 3];
    }
    bb[i] = log_sigmoid_f(lg) * (1.f / 16.f);
    ssum += bb[i];
  }
  __syncthreads();
  seg[qd * 64 + d] = ssum;
  __syncthreads();
  const float s0 = seg[d], s1 = seg[64 + d], s2 = seg[128 + d], s3 = seg[192 + d];
  const float tot = s0 + s1 + s2 + s3;
  if (DIR == 0) {
    float off = (qd > 0 ? s0 : 0.f) + (qd > 1 ? s1 : 0.f) + (qd > 2 ? s2 : 0.f);
#pragma unroll
    for (int i = 0; i < 16; ++i) { off += bb[i]; bb[i] = off; }
  } else {
    float off = (qd < 3 ? s3 : 0.f) + (qd < 2 ? s2 : 0.f) + (qd < 1 ? s1 : 0.f);
#pragma unroll
    for (int i = 15; i >= 0; --i) { off += bb[i]; bb[i] = off; }
  }
  return tot;
}

DI int gla_base_row(int b, int c) { return (c < 32) ? b * SEQ + c * 64 : NLAT + b * CTXL + (c - 32) * 64; }
DI int gla_scan_pos(int c, int dir) { return dir == 0 ? ((c >= 32) ? c - 32 : 4 + c) : ((c >= 32) ? 3 - (c - 32) : 4 + (31 - c)); }

struct GlaRaw { u32x4 v[4]; u32x4 r; };
DI void gla_load_raw(GlaRaw& g, const bf16_t* U2, int base_m, int h) {
  const int t = tid_opaque();
  const bf16_t* vrow = U2 + (size_t)(base_m + (t & 63)) * U2W + U2_VB + h * 128 + (t >> 6) * 32;
#pragma unroll
  for (int i = 0; i < 4; ++i) g.v[i] = *(const u32x4*)(vrow + 8 * i);
  g.r = *(const u32x4*)(U2 + (size_t)(base_m + (t >> 2)) * U2W + U2_GLR + (t & 3) * 8);
}
DI void gla_stage_raw(const GlaRaw& g, unsigned char* lds) {
  const int t = tid_opaque();
  float* rs = (float*)(lds + GL_RS);
  bf16_t* vT = (bf16_t*)(lds + GL_VT);
  {
    const int l = t >> 2, q = t & 3;
    float v[8];
    unpack8(g.r, v);
    *(f32x4*)(rs + l * 32 + q * 8) = (f32x4){v[0], v[1], v[2], v[3]};
    *(f32x4*)(rs + l * 32 + q * 8 + 4) = (f32x4){v[4], v[5], v[6], v[7]};
  }
  {
    const int l = t & 63, e0 = (t >> 6) * 32;
#pragma unroll
    for (int i = 0; i < 4; ++i) {
      const unsigned w4[4] = {g.v[i].x, g.v[i].y, g.v[i].z, g.v[i].w};
#pragma unroll
      for (int q = 0; q < 4; ++q) {
        vT[(e0 + 8 * i + 2 * q) * 72 + l] = (bf16_t)(w4[q] & 0xffffu);
        vT[(e0 + 8 * i + 2 * q + 1) * 72 + l] = (bf16_t)(w4[q] >> 16);
      }
    }
  }
}
DI void gla_load_gate(const Params& p, int j, int h, int dir, int d, float (&gw)[16], float& gb) {
  const float* GW = p.ev_gate_w + ((size_t)(j * 2 + dir) * 16) * 256 + h * 64 + d;
#pragma unroll
  for (int r = 0; r < 16; ++r) gw[r] = GW[r * 256];
  gb = p.ev_gate_b[(j * 2 + dir) * 256 + h * 64 + d];
}

DI void gla_g1_item(const Params& p, int j, int item, unsigned char* lds) {
  const int b = item / (4 * NCHUNK), h = (item / NCHUNK) & 3, c = item % NCHUNK;
  const bf16_t* U2 = (const bf16_t*)(p.ws + WS_U2);
  bf16_t* KVST = (bf16_t*)(p.ws + WS_KVST);
  float* DEC = (float*)(p.ws + WS_DEC);
  const int t = tid_opaque(), d = t & 63, qd = t >> 6, lane = t & 63, w = t >> 6, r = lane & 31, hh = lane >> 5;
  const int base_m = gla_base_row(b, c);
  GlaRaw raw; gla_load_raw(raw, U2, base_m, h);
  bf16_t k16[16];
#pragma unroll
  for (int i = 0; i < 16; ++i) k16[i] = U2[(size_t)(base_m + qd * 16 + i) * U2W + U2_KB + h * 64 + d];
  float gw0[16], gw1[16], gb0, gb1;
  gla_load_gate(p, j, h, 0, d, gw0, gb0);
  gla_load_gate(p, j, h, 1, d, gw1, gb1);
  __syncthreads();
  gla_stage_raw(raw, lds);
  __syncthreads();
  const float* rs = (const float*)(lds + GL_RS);
  float* seg0 = (float*)(lds + GL_SEG);
  float* seg1 = (float*)(lds + GL_ATT);
  float b0[16], b1[16];
  float sum0 = 0.f, sum1 = 0.f;
#pragma unroll
  for (int i = 0; i < 16; ++i) {
    const int l = qd * 16 + i;
    float l0 = gb0, l1 = gb1;
#pragma unroll
    for (int q = 0; q < 4; ++q) {
      const f32x4 r0 = *(const f32x4*)(rs + l * 32 + q * 4), r1 = *(const f32x4*)(rs + l * 32 + 16 + q * 4);
      l0 += r0.x * gw0[q * 4] + r0.y * gw0[q * 4 + 1] + r0.z * gw0[q * 4 + 2] + r0.w * gw0[q * 4 + 3];
      l1 += r1.x * gw1[q * 4] + r1.y * gw1[q * 4 + 1] + r1.z * gw1[q * 4 + 2] + r1.w * gw1[q * 4 + 3];
    }
    b0[i] = log_sigmoid_f(l0) * (1.f / 16.f); sum0 += b0[i];
    b1[i] = log_sigmoid_f(l1) * (1.f / 16.f); sum1 += b1[i];
  }
  seg0[qd * 64 + d] = sum0;
  seg1[qd * 64 + d] = sum1;
  __syncthreads();
  float tot0, tot1;
  {
    const float s0 = seg0[d], s1 = seg0[64 + d], s2 = seg0[128 + d], s3 = seg0[192 + d];
    tot0 = s0 + s1 + s2 + s3;
    float off = (qd > 0 ? s0 : 0.f) + (qd > 1 ? s1 : 0.f) + (qd > 2 ? s2 : 0.f);
#pragma unroll
    for (int i = 0; i < 16; ++i) { off += b0[i]; b0[i] = off; }
  }
  {
    const float s0 = seg1[d], s1 = seg1[64 + d], s2 = seg1[128 + d], s3 = seg1[192 + d];
    tot1 = s0 + s1 + s2 + s3;
    float off = (qd < 3 ? s3 : 0.f) + (qd < 2 ? s2 : 0.f) + (qd < 1 ? s1 : 0.f);
#pragma unroll
    for (int i = 15; i >= 0; --i) { off += b1[i]; b1[i] = off; }
  }
  bf16_t* kdT0 = (bf16_t*)(lds + GL_QT);
  bf16_t* kdT1 = (bf16_t*)(lds + GL_KT);
  const bf16_t* vT = (const bf16_t*)(lds + GL_VT);
#pragma unroll
  for (int i = 0; i < 16; ++i) {
    const float kv = bf2f(k16[i]);
    kdT0[d * 72 + qd * 16 + i] = f2bf(kv * __expf(tot0 - b0[i]));
    kdT1[d * 72 + qd * 16 + i] = f2bf(kv * __expf(tot1 - b1[i]));
  }
  const int chain0 = (b * 4 + h) * 2, sp0 = gla_scan_pos(c, 0), sp1 = gla_scan_pos(c, 1);
  if (qd == 0) DEC[(size_t)(chain0 * NCHUNK + sp0) * 64 + d] = __expf(tot0);
  if (qd == 1) DEC[(size_t)((chain0 + 1) * NCHUNK + sp1) * 64 + d] = __expf(tot1);
  __syncthreads();
  f32x16 acc[2][2];
#pragma unroll
  for (int dir = 0; dir < 2; ++dir)
#pragma unroll
    for (int x = 0; x < 2; ++x)
#pragma unroll
      for (int i = 0; i < 16; ++i) acc[dir][x][i] = 0.f;
#pragma unroll
  for (int s4 = 0; s4 < 4; ++s4) {
    const bf16x8 bq = *(const bf16x8*)(vT + (32 * w + r) * 72 + 16 * s4 + 8 * hh);
#pragma unroll
    for (int x = 0; x < 2; ++x) {
      const bf16x8 a0 = *(const bf16x8*)(kdT0 + (32 * x + r) * 72 + 16 * s4 + 8 * hh);
      const bf16x8 a1 = *(const bf16x8*)(kdT1 + (32 * x + r) * 72 + 16 * s4 + 8 * hh);
      acc[0][x] = MFMA32(a0, bq, acc[0][x]);
      acc[1][x] = MFMA32(a1, bq, acc[1][x]);
    }
  }
#pragma unroll
  for (int dir = 0; dir < 2; ++dir) {
    bf16_t* dst = KVST + (size_t)((chain0 + dir) * NCHUNK + (dir == 0 ? sp0 : sp1)) * 8192 + (32 * w + r) * 64;
#pragma unroll
    for (int x = 0; x < 2; ++x)
#pragma unroll
      for (int g = 0; g < 4; ++g) {
        u32x2 o; o.x = pk2(acc[dir][x][4 * g], acc[dir][x][4 * g + 1]); o.y = pk2(acc[dir][x][4 * g + 2], acc[dir][x][4 * g + 3]);
        *(u32x2*)(dst + 32 * x + 8 * g + 4 * hh) = o;
      }
  }
}

DI void gla_scan_item(const Params& p, int item) {
  bf16_t* KVST = (bf16_t*)(p.ws + WS_KVST);
  const float* DEC = (const float*)(p.ws + WS_DEC);
  const int idx = item * 256 + tid_opaque();
  const int chain = idx >> 11, off = (idx & 2047) * 4, d = off & 63;
  float S[4] = {0.f, 0.f, 0.f, 0.f};
#pragma unroll 1
  for (int sp0 = 0; sp0 < NCHUNK; sp0 += 6) {
    u32x2 kv[6]; f32x4 dc[6];
#pragma unroll
    for (int q = 0; q < 6; ++q) {
      kv[q] = *(const u32x2*)(KVST + (size_t)(chain * NCHUNK + sp0 + q) * 8192 + off);
      dc[q] = *(const f32x4*)(DEC + (size_t)(chain * NCHUNK + sp0 + q) * 64 + d);
    }
#pragma unroll
    for (int q = 0; q < 6; ++q) {
      u32x2 o; o.x = pk2(S[0], S[1]); o.y = pk2(S[2], S[3]);
      *(u32x2*)(KVST + (size_t)(chain * NCHUNK + sp0 + q) * 8192 + off) = o;
      S[0] = S[0] * dc[q].x + bflo(kv[q].x); S[1] = S[1] * dc[q].y + bfhi(kv[q].x); S[2] = S[2] * dc[q].z + bflo(kv[q].y); S[3] = S[3] * dc[q].w + bfhi(kv[q].y);
    }
  }
}

template <int DIR>
DI void gla_g3_dir(const float (&bb)[16], const float (&qreg)[16], const float (&kreg)[16], f32x16 (&o)[2], unsigned char* lds) {
  const int t = tid_opaque(), d = t & 63, qd = t >> 6, lane = t & 63, w = t >> 6, r = lane & 31, hh = lane >> 5;
  bf16_t* qt = (bf16_t*)(lds + GL_QT);
  bf16_t* kt = (bf16_t*)(lds + GL_KT);
  bf16_t* att = (bf16_t*)(lds + GL_ATT);
  const bf16_t* vT = (const bf16_t*)(lds + GL_VT);
  const bf16_t* ST = (const bf16_t*)(lds + GL_ST);
  const int lb = w >> 1, eb0 = 2 * (w & 1);
#pragma unroll
  for (int i = 0; i < 16; ++i) {
    const int l = qd * 16 + i;
    qt[l * 72 + d] = f2bf(qreg[i] * __expf(bb[i]));
    kt[l * 72 + d] = f2bf(kreg[i] * __expf(-bb[i]));
  }
  __syncthreads();
  {
    const int mb = w & 1;
    f32x16 a;
#pragma unroll
    for (int i = 0; i < 16; ++i) a[i] = 0.f;
#pragma unroll
    for (int s = 0; s < 4; ++s) {
      const bf16x8 fa = *(const bf16x8*)(qt + (32 * lb + r) * 72 + 16 * s + 8 * hh);
      const bf16x8 fb = *(const bf16x8*)(kt + (32 * mb + r) * 72 + 16 * s + 8 * hh);
      a = MFMA32(fa, fb, a);
    }
    const int mcol = 32 * mb + r;
#pragma unroll
    for (int i = 0; i < 16; ++i) {
      const int l = 32 * lb + crow(i, hh);
      const bool keep = (DIR == 0) ? (mcol <= l) : (mcol >= l);
      att[l * 72 + mcol] = f2bf(keep ? a[i] : 0.f);
    }
  }
  __syncthreads();
#pragma unroll
  for (int s = 0; s < 4; ++s) {
    const bf16x8 a1 = *(const bf16x8*)(att + (32 * lb + r) * 72 + 16 * s + 8 * hh);
    const bf16x8 a2 = *(const bf16x8*)(qt + (32 * lb + r) * 72 + 16 * s + 8 * hh);
#pragma unroll
    for (int x = 0; x < 2; ++x) {
      const bf16x8 b1 = *(const bf16x8*)(vT + (32 * (eb0 + x) + r) * 72 + 16 * s + 8 * hh);
      const bf16x8 b2 = *(const bf16x8*)(ST + (32 * (eb0 + x) + r) * 72 + 16 * s + 8 * hh);
      o[x] = MFMA32(a1, b1, o[x]);
      o[x] = MFMA32(a2, b2, o[x]);
    }
  }
  __syncthreads();
}

DI void gla_g3_item(const Params& p, int j, int item, unsigned char* lds) {
  const int b = item / (4 * NCHUNK), h = (item / NCHUNK) & 3, c = item % NCHUNK;
  const bf16_t* U2 = (const bf16_t*)(p.ws + WS_U2);
  const bf16_t* KVST = (const bf16_t*)(p.ws + WS_KVST);
  bf16_t* MIX = (bf16_t*)(p.ws + WS_R2);
  const int t = tid_opaque(), d = t & 63, qd = t >> 6, lane = t & 63, w = t >> 6, r = lane & 31, hh = lane >> 5;
  const int base_m = gla_base_row(b, c);
  const int chain0 = (b * 4 + h) * 2;
  GlaRaw raw; gla_load_raw(raw, U2, base_m, h);
  bf16_t k16[16], q16[16];
#pragma unroll
  for (int i = 0; i < 16; ++i) {
    const bf16_t* row = U2 + (size_t)(base_m + qd * 16 + i) * U2W + h * 64 + d;
    k16[i] = row[U2_KB]; q16[i] = row[U2_QB];
  }
  float gw0[16], gw1[16], gb0, gb1;
  gla_load_gate(p, j, h, 0, d, gw0, gb0);
  gla_load_gate(p, j, h, 1, d, gw1, gb1);
  u32x4 st[4];
  {
    const bf16_t* src = KVST + (size_t)(chain0 * NCHUNK + gla_scan_pos(c, 0)) * 8192;
#pragma unroll
    for (int q = 0; q < 4; ++q) st[q] = *(const u32x4*)(src + (size_t)(t + 256 * q) * 8);
  }
  __syncthreads();
  gla_stage_raw(raw, lds);
  bf16_t* STl = (bf16_t*)(lds + GL_ST);
#pragma unroll
  for (int q = 0; q < 4; ++q) { const int ci = t + 256 * q; *(u32x4*)(STl + (ci >> 3) * 72 + (ci & 7) * 8) = st[q]; }
  {
    const bf16_t* src = KVST + (size_t)((chain0 + 1) * NCHUNK + gla_scan_pos(c, 1)) * 8192;
#pragma unroll
    for (int q = 0; q < 4; ++q) st[q] = *(const u32x4*)(src + (size_t)(t + 256 * q) * 8);
  }
  float kreg[16], qreg[16];
#pragma unroll
  for (int i = 0; i < 16; ++i) { kreg[i] = bf2f(k16[i]); qreg[i] = bf2f(q16[i]) * 0.125f; }
  __syncthreads();
  const int lb = w >> 1, eb0 = 2 * (w & 1);
  f32x16 o[2];
#pragma unroll
  for (int x = 0; x < 2; ++x)
#pragma unroll
    for (int i = 0; i < 16; ++i) o[x][i] = 0.f;
  float b0[16], b1[16];
  {
    const float* rs = (const float*)(lds + GL_RS);
    float* seg0 = (float*)(lds + GL_SEG);
    float* seg1 = (float*)(lds + GL_ATT);
    float sum0 = 0.f, sum1 = 0.f;
#pragma unroll
    for (int i = 0; i < 16; ++i) {
      const int l = qd * 16 + i;
      float l0 = gb0, l1 = gb1;
#pragma unroll
      for (int q = 0; q < 4; ++q) {
        const f32x4 r0 = *(const f32x4*)(rs + l * 32 + q * 4), r1 = *(const f32x4*)(rs + l * 32 + 16 + q * 4);
        l0 += r0.x * gw0[q * 4] + r0.y * gw0[q * 4 + 1] + r0.z * gw0[q * 4 + 2] + r0.w * gw0[q * 4 + 3];
        l1 += r1.x * gw1[q * 4] + r1.y * gw1[q * 4 + 1] + r1.z * gw1[q * 4 + 2] + r1.w * gw1[q * 4 + 3];
      }
      b0[i] = log_sigmoid_f(l0) * (1.f / 16.f); sum0 += b0[i];
      b1[i] = log_sigmoid_f(l1) * (1.f / 16.f); sum1 += b1[i];
    }
    seg0[qd * 64 + d] = sum0;
    seg1[qd * 64 + d] = sum1;
    __syncthreads();
    {
      const float s0 = seg0[d], s1 = seg0[64 + d], s2 = seg0[128 + d];
      float off = (qd > 0 ? s0 : 0.f) + (qd > 1 ? s1 : 0.f) + (qd > 2 ? s2 : 0.f);
#pragma unroll
      for (int i = 0; i < 16; ++i) { off += b0[i]; b0[i] = off; }
    }
    {
      const float s1 = seg1[64 + d], s2 = seg1[128 + d], s3 = seg1[192 + d];
      float off = (qd < 3 ? s3 : 0.f) + (qd < 2 ? s2 : 0.f) + (qd < 1 ? s1 : 0.f);
#pragma unroll
      for (int i = 15; i >= 0; --i) { off += b1[i]; b1[i] = off; }
    }
  }
  gla_g3_dir<0>(b0, qreg, kreg, o, lds);
#pragma unroll
  for (int q = 0; q < 4; ++q) { const int ci = t + 256 * q; *(u32x4*)(STl + (ci >> 3) * 72 + (ci & 7) * 8) = st[q]; }
  const int erow = t >> 2, epart = t & 3;
  const int em = base_m + erow;
  u32x4 zb[4];
  {
    const bf16_t* zp = U2 + (size_t)em * U2W + U2_ZB + h * 128 + epart * 32;
#pragma unroll
    for (int q = 0; q < 4; ++q) zb[q] = *(const u32x4*)(zp + q * 8);
  }
  gla_g3_dir<1>(b1, qreg, kreg, o, lds);
  float* ob = (float*)lds;
#pragma unroll
  for (int x = 0; x < 2; ++x)
#pragma unroll
    for (int i = 0; i < 16; ++i) ob[(32 * lb + crow(i, hh)) * 132 + 32 * (eb0 + x) + r] = o[x][i];
  __syncthreads();
  {
    float v[32];
    float ss = 0.f;
#pragma unroll
    for (int q = 0; q < 8; ++q) { *(f32x4*)(v + 4 * q) = *(const f32x4*)(ob + erow * 132 + epart * 32 + q * 4); }
#pragma unroll
    for (int e = 0; e < 32; ++e) ss += v[e] * v[e];
    ss += __shfl_xor(ss, 1); ss += __shfl_xor(ss, 2);
    const float rstd = rsqrtf(ss * (1.f / 128.f) + EPS);
    const float* gn = p.ev_gla_norm + j * 512 + h * 128 + epart * 32;
    bf16_t* dst = MIX + (size_t)em * D + 512 + h * 128 + epart * 32;
#pragma unroll
    for (int q = 0; q < 4; ++q) {
      float z[8], ov[8];
      unpack8(zb[q], z);
#pragma unroll
      for (int e = 0; e < 8; ++e) ov[e] = v[q * 8 + e] * rstd * gn[q * 8 + e] * silu_f(z[e]);
      *(u32x4*)(dst + q * 8) = pack8(ov);
    }
  }
}

template <int DQK, int MODE>
DI void attn_tile(const bf16_t* Ks, const bf16_t* Vs, const bf16x8 (&qf)[DQK / 16], f32x16 (&o)[2], float& mx, float& lsum,
                  int r, int hh, const float* rpbs, int ridx, int qc) {
  constexpr int KP = DQK + 8, VP = 72;
  f32x16 s[2];
#pragma unroll
  for (int kb = 0; kb < 2; ++kb) {
#pragma unroll
    for (int i = 0; i < 16; ++i) s[kb][i] = 0.f;
#pragma unroll
    for (int jj = 0; jj < DQK / 16; ++jj) {
      const bf16x8 a = *(const bf16x8*)(Ks + (32 * kb + r) * KP + 16 * jj + 8 * hh);
      s[kb] = MFMA32(a, qf[jj], s[kb]);
    }
  }
  if (MODE == 1) {
    const int cs = min(max(qc - 8, 0), 48);
    const int u = 4 * hh - cs;
    const float* bp = rpbs + (ridx * 31 + 4 * hh - qc + 15);
#pragma unroll
    for (int kb = 0; kb < 2; ++kb)
#pragma unroll
      for (int i = 0; i < 16; ++i) {
        const int c = 32 * kb + (i & 3) + 8 * (i >> 2);
        const bool valid = (unsigned)(u + c) < 16u;
        s[kb][i] = valid ? (s[kb][i] + bp[c]) : -INFINITY;
      }
  }
  float tmax = s[0][0];
#pragma unroll
  for (int kb = 0; kb < 2; ++kb)
#pragma unroll
    for (int i = 0; i < 16; ++i) tmax = fmaxf(tmax, s[kb][i]);
  tmax = fmaxf(tmax, __shfl_xor(tmax, 32));
  if (__builtin_amdgcn_ballot_w64(tmax > mx) != 0ull) {
    const float mnew = fmaxf(mx, tmax);
    const float alpha = exp2_fast(mx - mnew);
    mx = mnew;
    lsum *= alpha;
#pragma unroll
    for (int x = 0; x < 2; ++x)
#pragma unroll
      for (int i = 0; i < 16; ++i) o[x][i] *= alpha;
  }
  float psum = 0.f;
#pragma unroll
  for (int kb = 0; kb < 2; ++kb)
#pragma unroll
    for (int i = 0; i < 16; ++i) { s[kb][i] = exp2_fast(s[kb][i] - mx); psum += s[kb][i]; }
  lsum += psum;
#pragma unroll
  for (int kb = 0; kb < 2; ++kb)
#pragma unroll
    for (int sx = 0; sx < 2; ++sx) {
      u32x4 pk;
      pk.x = pk2(s[kb][8 * sx + 0], s[kb][8 * sx + 1]); pk.y = pk2(s[kb][8 * sx + 2], s[kb][8 * sx + 3]);
      pk.z = pk2(s[kb][8 * sx + 4], s[kb][8 * sx + 5]); pk.w = pk2(s[kb][8 * sx + 6], s[kb][8 * sx + 7]);
      const bf16x8 pf = __builtin_bit_cast(bf16x8, pk);
#pragma unroll
      for (int eb = 0; eb < 2; ++eb) {
        const bf16_t* vp = Vs + (32 * eb + r) * VP + 32 * kb + 16 * sx + 4 * hh;
        const s16x4 lo = *(const s16x4*)vp, hi = *(const s16x4*)(vp + 8);
        const bf16x8 vf = __builtin_shufflevector(lo, hi, 0, 1, 2, 3, 4, 5, 6, 7);
        o[eb] = MFMA32(vf, pf, o[eb]);
      }
    }
}

template <int DQK>
DI void attn_load_tile(const bf16_t* kg, const bf16_t* vg, u32x4 (&rk)[DQK / 32], u32x4 (&rv)[2]) {
  const int t = tid_opaque();
#pragma unroll
  for (int i = 0; i < DQK / 32; ++i) rk[i] = *(const u32x4*)(kg + (size_t)(t + 256 * i) * 8);
#pragma unroll
  for (int i = 0; i < 2; ++i) { const int ci = t + 256 * i, e = ci >> 3, cc = ci & 7; rv[i] = *(const u32x4*)(vg + (size_t)e * KEYS + cc * 8); }
}
template <int DQK>
DI void attn_store_tile(bf16_t* Ks, bf16_t* Vs, const u32x4 (&rk)[DQK / 32], const u32x4 (&rv)[2]) {
  constexpr int KP = DQK + 8, CPR = DQK / 8;
  const int t = tid_opaque();
#pragma unroll
  for (int i = 0; i < DQK / 32; ++i) { const int ci = t + 256 * i, row = ci / CPR, cc = ci % CPR; *(u32x4*)(Ks + row * KP + cc * 8) = rk[i]; }
#pragma unroll
  for (int i = 0; i < 2; ++i) { const int ci = t + 256 * i, e = ci >> 3, cc = ci & 7; *(u32x4*)(Vs + e * 72 + cc * 8) = rv[i]; }
}

constexpr int AT_KS = 0, AT_VS = 13312, AT_BUF = 22528  , AT_RPB = 45056, AT_QS = 47104;

DI void attn_write_out(const f32x16 (&o)[2], float lsum, const bf16_t* zrow, bf16_t* orow, int hh) {
  const float ltot = lsum + __shfl_xor(lsum, 32);
  const float inv = 1.f / ltot;
#pragma unroll
  for (int eb = 0; eb < 2; ++eb)
#pragma unroll
    for (int g = 0; g < 4; ++g) {
      const int e = 32 * eb + 8 * g + 4 * hh;
      const u32x2 zz = *(const u32x2*)(zrow + e);
      const float v0 = o[eb][4 * g + 0] * inv * silu_f(bflo(zz.x)), v1 = o[eb][4 * g + 1] * inv * silu_f(bfhi(zz.x));
      const float v2 = o[eb][4 * g + 2] * inv * silu_f(bflo(zz.y)), v3 = o[eb][4 * g + 3] * inv * silu_f(bfhi(zz.y));
      u32x2 ov; ov.x = pk2(v0, v1); ov.y = pk2(v2, v3);
      *(u32x2*)(orow + e) = ov;
    }
}

template <int DQK, int NH>
DI void attn_dense_item(const bf16_t* Q, const bf16_t* K, const bf16_t* VT, const bf16_t* Z, int zstride, bf16_t* MIX,
                        int b, int head, int qp0, int k_lo, int ntiles, unsigned char* lds) {
  const int t = tid_opaque(), lane = t & 63, w = t >> 6, r = lane & 31, hh = lane >> 5;
  bf16_t* Ks = (bf16_t*)(lds + AT_KS);
  bf16_t* Vs = (bf16_t*)(lds + AT_VS);
  const size_t bh = (size_t)(b * NH + head);
  const int qpos = qp0 + 32 * w + r;
  bf16x8 qf[DQK / 16];
#pragma unroll
  for (int jj = 0; jj < DQK / 16; ++jj) qf[jj] = *(const bf16x8*)(Q + (bh * KEYS + qpos) * DQK + 16 * jj + 8 * hh);
  f32x16 o[2];
#pragma unroll
  for (int x = 0; x < 2; ++x)
#pragma unroll
    for (int i = 0; i < 16; ++i) o[x][i] = 0.f;
  float mx = -1e30f, lsum = 0.f;
  const bf16_t* kbase = K + (bh * KEYS + k_lo) * DQK;
  const bf16_t* vbase = VT + bh * 64 * KEYS + k_lo;
  u32x4 rk[DQK / 32], rv[2];
  attn_load_tile<DQK>(kbase, vbase, rk, rv);
  for (int tt = 0; tt < ntiles; ++tt) {
    __syncthreads();
    attn_store_tile<DQK>(Ks, Vs, rk, rv);
    __syncthreads();
    if (tt + 1 < ntiles) attn_load_tile<DQK>(kbase + (size_t)(tt + 1) * 64 * DQK, vbase + (tt + 1) * 64, rk, rv);
    attn_tile<DQK, 0>(Ks, Vs, qf, o, mx, lsum, r, hh, nullptr, 0, 0);
  }
  const int m = (qpos < SEQ) ? b * SEQ + qpos : NLAT + b * CTXL + (qpos - SEQ);
  attn_write_out(o, lsum, Z + (size_t)m * zstride + head * 64, MIX + (size_t)m * D + head * 64, hh);
}


template <int DQK, int MODE, bool PARK>
DI void attn_tile2(const bf16_t* Ks, const bf16_t* Vs, const bf16x8 (&qfA)[DQK / 16], const bf16x8 (&qfB)[DQK / 16], const bf16_t* QsB, f32x16 (&o)[2][2], float (&mx)[2], float (&lsum)[2], int r, int hh,
                const float* rpbs, int ridx, int qcA) {
  constexpr int KP = DQK + 8, VP = 72;
  f32x16 s[2][2];
#pragma unroll
  for (int kb = 0; kb < 2; ++kb) {
#pragma unroll
    for (int g = 0; g < 2; ++g)
#pragma unroll
      for (int i = 0; i < 16; ++i) s[g][kb][i] = 0.f;
#pragma unroll
    for (int jj = 0; jj < DQK / 16; ++jj) {
      const bf16x8 a = *(const bf16x8*)(Ks + (32 * kb + r) * KP + 16 * jj + 8 * hh);
      const bf16x8 qb = PARK ? *(const bf16x8*)(QsB + 16 * jj) : qfB[jj];
      s[0][kb] = MFMA32(a, qfA[jj], s[0][kb]);
      s[1][kb] = MFMA32(a, qb, s[1][kb]);
    }
  }
#pragma unroll
  for (int g = 0; g < 2; ++g) {
    if (MODE == 1) {
      const int qc = qcA + 32 * g;
      const int cs = min(max(qc - 8, 0), 48);
      const int u = 4 * hh - cs;
      const float* bp = rpbs + (ridx * 31 + 4 * hh - qc + 15);
#pragma unroll
      for (int kb = 0; kb < 2; ++kb)
#pragma unroll
        for (int i = 0; i < 16; ++i) {
          const int c = 32 * kb + (i & 3) + 8 * (i >> 2);
          const bool valid = (unsigned)(u + c) < 16u;
          s[g][kb][i] = valid ? (s[g][kb][i] + bp[c]) : -INFINITY;
          if ((i & 3) == 3) __builtin_amdgcn_sched_barrier(0);
        }
    }
    float tmax = s[g][0][0];
#pragma unroll
    for (int kb = 0; kb < 2; ++kb)
#pragma unroll
      for (int i = 0; i < 16; ++i) tmax = fmaxf(tmax, s[g][kb][i]);
    tmax = fmaxf(tmax, __shfl_xor(tmax, 32));
    if (__builtin_amdgcn_ballot_w64(tmax > mx[g]) != 0ull) {
      const float mnew = fmaxf(mx[g], tmax);
      const float alpha = exp2_fast(mx[g] - mnew);
      mx[g] = mnew;
      lsum[g] *= alpha;
#pragma unroll
      for (int x = 0; x < 2; ++x)
#pragma unroll
        for (int i = 0; i < 16; ++i) o[g][x][i] *= alpha;
    }
    float psum = 0.f;
#pragma unroll
    for (int kb = 0; kb < 2; ++kb)
#pragma unroll
      for (int i = 0; i < 16; ++i) { s[g][kb][i] = exp2_fast(s[g][kb][i] - mx[g]); psum += s[g][kb][i]; }
    lsum[g] += psum;
#pragma unroll
    for (int kb = 0; kb < 2; ++kb)
#pragma unroll
      for (int sx = 0; sx < 2; ++sx) {
        u32x4 pk;
        pk.x = pk2(s[g][kb][8 * sx + 0], s[g][kb][8 * sx + 1]); pk.y = pk2(s[g][kb][8 * sx + 2], s[g][kb][8 * sx + 3]);
        pk.z = pk2(s[g][kb][8 * sx + 4], s[g][kb][8 * sx + 5]); pk.w = pk2(s[g][kb][8 * sx + 6], s[g][kb][8 * sx + 7]);
        const bf16x8 pf = __builtin_bit_cast(bf16x8, pk);
#pragma unroll
        for (int eb = 0; eb < 2; ++eb) {
          const bf16_t* vp = Vs + (32 * eb + r) * VP + 32 * kb + 16 * sx + 4 * hh;
          const s16x4 lo = *(const s16x4*)vp, hi = *(const s16x4*)(vp + 8);
          const bf16x8 vf = __builtin_shufflevector(lo, hi, 0, 1, 2, 3, 4, 5, 6, 7);
          o[g][eb] = MFMA32(vf, pf, o[g][eb]);
        }
      }
  }
}

template <int DQK, int NH>
DI void attn_dense_item2(const bf16_t* Q, const bf16_t* K, const bf16_t* VT, const bf16_t* Z, int zstride, bf16_t* MIX,
                         int b, int head, int qp0, int k_lo, int ntiles, unsigned char* lds) {
  const int t = tid_opaque(), lane = t & 63, w = t >> 6, r = lane & 31, hh = lane >> 5;
  bf16_t* Ks = (bf16_t*)(lds + AT_KS);
  bf16_t* Vs = (bf16_t*)(lds + AT_VS);
  const size_t bh = (size_t)(b * NH + head);
  const int qpos0 = qp0 + 64 * w + r;
  bf16x8 qfA[DQK / 16];
  bf16_t* QsB = (bf16_t*)(lds + AT_QS) + (32 * w + r) * (DQK + 8) + 8 * hh;
  __syncthreads();
#pragma unroll
  for (int jj = 0; jj < DQK / 16; ++jj) {
    qfA[jj] = *(const bf16x8*)(Q + (bh * KEYS + qpos0) * DQK + 16 * jj + 8 * hh);
    *(bf16x8*)(QsB + 16 * jj) = *(const bf16x8*)(Q + (bh * KEYS + qpos0 + 32) * DQK + 16 * jj + 8 * hh);
  }
  f32x16 o[2][2];
#pragma unroll
  for (int g = 0; g < 2; ++g)
#pragma unroll
    for (int x = 0; x < 2; ++x)
#pragma unroll
      for (int i = 0; i < 16; ++i) o[g][x][i] = 0.f;
  float mx[2] = {-1e30f, -1e30f}, lsum[2] = {0.f, 0.f};
  const bf16_t* kbase = K + (bh * KEYS + k_lo) * DQK;
  const bf16_t* vbase = VT + bh * 64 * KEYS + k_lo;
  u32x4 rk[DQK / 32], rv[2];
  attn_load_tile<DQK>(kbase, vbase, rk, rv);
  attn_store_tile<DQK>(Ks, Vs, rk, rv);
  if (ntiles > 1) attn_load_tile<DQK>(kbase + (size_t)64 * DQK, vbase + 64, rk, rv);
  __syncthreads();
#pragma unroll 1
  for (int tt = 0; tt < ntiles; ++tt) {
    const int bo = (tt & 1) * (AT_BUF / 2);
    attn_tile2<DQK, 0, true>(Ks + bo, Vs + bo, qfA, qfA, QsB, o, mx, lsum, r, hh, nullptr, 0, 0);
    if (tt + 1 < ntiles) {
      const int bn = ((tt + 1) & 1) * (AT_BUF / 2);
      attn_store_tile<DQK>(Ks + bn, Vs + bn, rk, rv);
      if (tt + 2 < ntiles) attn_load_tile<DQK>(kbase + (size_t)(tt + 2) * 64 * DQK, vbase + (tt + 2) * 64, rk, rv);
    }
    __syncthreads();
  }
#pragma unroll
  for (int g = 0; g < 2; ++g) {
    const int qpos = qpos0 + 32 * g;
    const int m = (qpos < SEQ) ? b * SEQ + qpos : NLAT + b * CTXL + (qpos - SEQ);
    attn_write_out(o[g], lsum[g], Z + (size_t)m * zstride + head * 64, MIX + (size_t)m * D + head * 64, hh);
  }
}

DI void natten_item(const Params& p, int j, int item, unsigned char* lds) {
  const int b = item >> 8, head = (item >> 4) & 15, rp = item & 15;
  const bf16_t* Q = (const bf16_t*)(p.ws + WS_QC);
  const bf16_t* K = (const bf16_t*)(p.ws + WS_KC);
  const bf16_t* VT = (const bf16_t*)(p.ws + WS_VCT);
  const bf16_t* Z = (const bf16_t*)(p.ws + WS_ZC);
  bf16_t* MIX = (bf16_t*)(p.ws + WS_OH);
  const int t = tid_opaque(), lane = t & 63, w = t >> 6, r = lane & 31, hh = lane >> 5;
  bf16_t* Ks = (bf16_t*)(lds + AT_KS);
  bf16_t* Vs = (bf16_t*)(lds + AT_VS);
  float* rpbs = (float*)(lds + AT_RPB);
  const size_t bh = (size_t)(b * 16 + head);
  const int r0 = 2 * rp, qrow = r0 + (w >> 1), qc = 32 * (w & 1) + r, qpos = qrow * 64 + qc;
  const int ra = min(max(r0 - 4, 0), 24), rb = min(max(r0 + 1 - 4, 0), 24) + 7;
  const int nlat = rb - ra + 1, ntiles = nlat + 4;
  const int my_rs = min(max(qrow - 4, 0), 24);
  __syncthreads();
  for (int i = t; i < 15 * 31; i += 256) rpbs[i] = p.od_rpb[((size_t)(j * 16 + head)) * 465 + i] * LOG2E;
  bf16x8 qf[4];
#pragma unroll
  for (int jj = 0; jj < 4; ++jj) qf[jj] = *(const bf16x8*)(Q + (bh * KEYS + qpos) * 64 + 16 * jj + 8 * hh);
  f32x16 o[2];
#pragma unroll
  for (int x = 0; x < 2; ++x)
#pragma unroll
    for (int i = 0; i < 16; ++i) o[x][i] = 0.f;
  float mx = -1e30f, lsum = 0.f;
  const bf16_t* kb0 = K + bh * KEYS * 64;
  const bf16_t* vb0 = VT + bh * 64 * KEYS;
  u32x4 rk[2], rv[2];
  attn_load_tile<64>(kb0 + (size_t)(ra * 64) * 64, vb0 + ra * 64, rk, rv);
  for (int tt = 0; tt < ntiles; ++tt) {
    __syncthreads();
    attn_store_tile<64>(Ks, Vs, rk, rv);
    __syncthreads();
    if (tt + 1 < ntiles) {
      const int key0 = (tt + 1 < nlat) ? (ra + tt + 1) * 64 : SEQ + (tt + 1 - nlat) * 64;
      attn_load_tile<64>(kb0 + (size_t)key0 * 64, vb0 + key0, rk, rv);
    }
    if (tt < nlat) {
      const int kr = ra + tt;
      if (kr >= my_rs && kr < my_rs + 8) attn_tile<64, 1>(Ks, Vs, qf, o, mx, lsum, r, hh, rpbs, kr - qrow + 7, qc);
    } else {
      attn_tile<64, 0>(Ks, Vs, qf, o, mx, lsum, r, hh, nullptr, 0, 0);
    }
  }
  const int m = b * SEQ + qpos;
  attn_write_out(o, lsum, Z + (size_t)m * D + head * 64, MIX + (size_t)m * D + head * 64, hh);
}


DI void natten_item2(const Params& p, int j, int item, unsigned char* lds) {
  const int b = item >> 7, head = (item >> 3) & 15, rq = item & 7;
  const bf16_t* Q = (const bf16_t*)(p.ws + WS_QC);
  const bf16_t* K = (const bf16_t*)(p.ws + WS_KC);
  const bf16_t* VT = (const bf16_t*)(p.ws + WS_VCT);
  const bf16_t* Z = (const bf16_t*)(p.ws + WS_ZC);
  bf16_t* MIX = (bf16_t*)(p.ws + WS_OH);
  const int t = tid_opaque(), lane = t & 63, w = t >> 6, r = lane & 31, hh = lane >> 5;
  bf16_t* Ks = (bf16_t*)(lds + AT_KS);
  bf16_t* Vs = (bf16_t*)(lds + AT_VS);
  float* rpbs = (float*)(lds + AT_RPB);
  const size_t bh = (size_t)(b * 16 + head);
  const int r0 = 4 * rq, qrow = r0 + w, qpos0 = qrow * 64 + r;
  const int ra = min(max(r0 - 4, 0), 24), rb = min(max(r0 + 3 - 4, 0), 24) + 7;
  const int nlat = rb - ra + 1, ntiles = nlat + 4;
  const int my_rs = min(max(qrow - 4, 0), 24);
  __syncthreads();
  for (int i = t; i < 15 * 31; i += 256) rpbs[i] = p.od_rpb[((size_t)(j * 16 + head)) * 465 + i] * LOG2E;
  bf16x8 qfA[4];
  bf16_t* QsB = (bf16_t*)(lds + AT_QS) + (32 * w + r) * 72 + 8 * hh;
#pragma unroll
  for (int jj = 0; jj < 4; ++jj) {
    qfA[jj] = *(const bf16x8*)(Q + (bh * KEYS + qpos0) * 64 + 16 * jj + 8 * hh);
    *(bf16x8*)(QsB + 16 * jj) = *(const bf16x8*)(Q + (bh * KEYS + qpos0 + 32) * 64 + 16 * jj + 8 * hh);
  }
  f32x16 o[2][2];
#pragma unroll
  for (int g = 0; g < 2; ++g)
#pragma unroll
    for (int x = 0; x < 2; ++x)
#pragma unroll
      for (int i = 0; i < 16; ++i) o[g][x][i] = 0.f;
  float mx[2] = {-1e30f, -1e30f}, lsum[2] = {0.f, 0.f};
  const bf16_t* kb0 = K + bh * KEYS * 64;
  const bf16_t* vb0 = VT + bh * 64 * KEYS;
  u32x4 rk[2], rv[2];
#define NAT_KEY0(tq) (((tq) < nlat) ? (ra + (tq)) * 64 : SEQ + ((tq) - nlat) * 64)
  attn_load_tile<64>(kb0 + (size_t)(ra * 64) * 64, vb0 + ra * 64, rk, rv);
  attn_store_tile<64>(Ks, Vs, rk, rv);
  { const int k1 = NAT_KEY0(1); attn_load_tile<64>(kb0 + (size_t)k1 * 64, vb0 + k1, rk, rv); }
  __syncthreads();
#pragma unroll 1
  for (int tt = 0; tt < ntiles; ++tt) {
    const int bo = (tt & 1) * (AT_BUF / 2);
    if (tt < nlat) {
      const int kr = ra + tt;
      if (kr >= my_rs && kr < my_rs + 8) attn_tile2<64, 1, true>(Ks + bo, Vs + bo, qfA, qfA, QsB, o, mx, lsum, r, hh, rpbs, kr - qrow + 7, r);
    } else {
      attn_tile2<64, 0, true>(Ks + bo, Vs + bo, qfA, qfA, QsB, o, mx, lsum, r, hh, nullptr, 0, 0);
    }
    if (tt + 1 < ntiles) {
      const int bn = ((tt + 1) & 1) * (AT_BUF / 2);
      attn_store_tile<64>(Ks + bn, Vs + bn, rk, rv);
      if (tt + 2 < ntiles) { const int k2 = NAT_KEY0(tt + 2); attn_load_tile<64>(kb0 + (size_t)k2 * 64, vb0 + k2, rk, rv); }
    }
    __syncthreads();
  }
#undef NAT_KEY0
#pragma unroll
  for (int g = 0; g < 2; ++g) {
    const int m = b * SEQ + qpos0 + 32 * g;
    attn_write_out(o[g], lsum[g], Z + (size_t)m * D + head * 64, MIX + (size_t)m * D + head * 64, hh);
  }
}

DI void od_win_tile(const Params& p, int j, int mt, int nt, unsigned char* lds) {
  const bf16_t* H = (const bf16_t*)(p.ws + WS_OH);
  const bf16_t* WT = (const bf16_t*)(p.ws + WS_WT + WT_OD_IN);
  const int t = tid_opaque(), m0 = mt * 128, n0 = nt * 128;
  const float* Cs = (const float*)lds;
  const int type = n0 >> 10, hh0 = (n0 & 1023) >> 6;
  int b, pos0; tok_bp(m0, b, pos0);
  if (type < 2) {
    bf16_t* dstb = (bf16_t*)(p.ws + (type == 0 ? WS_QC : WS_KC));
    const float* gain = (type == 0 ? p.od_q_gain : p.od_k_gain) + j * 64;
    const float sc = (type == 0) ? 0.125f * LOG2E : 1.f;
#pragma unroll 1
    for (int it = 0; it < 8; ++it) {
      const int idx = t + 256 * it, l8 = idx & 7, hsel = (idx >> 3) & 1, row = idx >> 4;
      float v[8];
      *(f32x4*)v = *(const f32x4*)(Cs + row * 132 + hsel * 64 + l8 * 8);
      *(f32x4*)(v + 4) = *(const f32x4*)(Cs + row * 132 + hsel * 64 + l8 * 8 + 4);
      float ss = 0.f;
#pragma unroll
      for (int e = 0; e < 8; ++e) ss += v[e] * v[e];
      ss += __shfl_xor(ss, 1); ss += __shfl_xor(ss, 2); ss += __shfl_xor(ss, 4);
      const float rstd = rsqrtf(ss * (1.f / 64.f) + EPS) * sc;
#pragma unroll
      for (int e = 0; e < 8; ++e) v[e] *= rstd * gain[l8 * 8 + e];
      *(u32x4*)(dstb + ((size_t)(b * 16 + hh0 + hsel) * KEYS + pos0 + row) * 64 + l8 * 8) = pack8(v);
    }
  } else if (type == 2) {
    bf16_t* VCT = (bf16_t*)(p.ws + WS_VCT);
#pragma unroll 1
    for (int it = 0; it < 8; ++it) {
      const int idx = t + 256 * it, rg = idx & 15, cc = idx >> 4, head = hh0 + (cc >> 6), e = cc & 63;
      float v[8];
#pragma unroll
      for (int q = 0; q < 8; ++q) v[q] = Cs[(rg * 8 + q) * 132 + cc];
      *(u32x4*)(VCT + ((size_t)(b * 16 + head) * 64 + e) * KEYS + pos0 + rg * 8) = pack8(v);
    }
  } else {
    bf16_t* ZC = (bf16_t*)(p.ws + WS_ZC);
#pragma unroll 1
    for (int it = 0; it < 8; ++it) {
      const int idx = t + 256 * it, row = idx >> 4, ch = idx & 15;
      float v[8];
      *(f32x4*)v = *(const f32x4*)(Cs + row * 132 + ch * 8);
      *(f32x4*)(v + 4) = *(const f32x4*)(Cs + row * 132 + ch * 8 + 4);
      *(u32x4*)(ZC + (size_t)(m0 + row) * D + (n0 - 3072) + ch * 8) = pack8(v);
    }
  }
}


struct OdWinOps {
  const Params* pp; int j; int layer;
  DI void map(int id, int& mt, int& nt) const {
    xcd_tile(id, 18, 32, 6, mt, nt);
  }
  DI TileDesc tile(int id) const {
    int mt, nt; map(id, mt, nt);
    TileDesc d; d.A = (const bf16_t*)(pp->ws + WS_OH) + (size_t)mt * 128 * D; d.B = (const bf16_t*)(pp->ws + WS_WT + WT_OD_IN) + (size_t)nt * 128 * D; d.nvalid = 128;
    return d;
  }
  DI void epi(int id, unsigned char* lds) const { int mt, nt; map(id, mt, nt); od_win_tile(*pp, j, mt, nt, lds); }
};


struct OdWinOps2 {
  const Params* pp; int j; int layer;
  DI void epi_lds(int, unsigned char*) const {}
  DI TileDesc tile(int id) const {
    int mt, nt; xcd_tile(id, 18, 32, 6, mt, nt);
    TileDesc d; d.A = (const bf16_t*)(pp->ws + WS_OH) + (size_t)mt * 128 * D; d.B = (const bf16_t*)(pp->ws + WS_WT + WT_OD_IN) + (size_t)nt * 128 * D; d.nvalid = 128;
    return d;
  }
  DI void epi_read(int id, unsigned char* lds, float (&c)[64]) const {
    int mt, nt; xcd_tile(id, 18, 32, 6, mt, nt);
    const int type = nt >> 3;
    const int t = tid_opaque();
    const float* Cs = (const float*)lds;
    if (type == 2) {
      const int rg = t & 15;
#pragma unroll
      for (int it = 0; it < 8; ++it) {
        const int cc = (t >> 4) + 16 * it;
#pragma unroll
        for (int q = 0; q < 8; ++q) c[it * 8 + q] = Cs[(rg * 8 + q) * 132 + cc];
      }
    } else {
      const int off = (type < 2) ? ((t >> 3) & 1) * 64 + (t & 7) * 8 : (t & 15) * 8;
#pragma unroll
      for (int it = 0; it < 8; ++it) {
        const int row = (t >> 4) + 16 * it;
        *(f32x4*)(c + it * 8) = *(const f32x4*)(Cs + row * 132 + off);
        *(f32x4*)(c + it * 8 + 4) = *(const f32x4*)(Cs + row * 132 + off + 4);
      }
    }
  }
  DI void epi_write(int id, const float (&c)[64]) const {
    const Params& p = *pp;
    int mt, nt; xcd_tile(id, 18, 32, 6, mt, nt);
    const int m0 = mt * 128, n0 = nt * 128;
    const int t = tid_opaque();
    const int type = n0 >> 10, hh0 = (n0 & 1023) >> 6;
    int b, pos0; tok_bp(m0, b, pos0);
    if (type < 2) {
      bf16_t* dstb = (bf16_t*)(p.ws + (type == 0 ? WS_QC : WS_KC));
      const int l8 = t & 7, hsel = (t >> 3) & 1;
      const float* gain = (type == 0 ? p.od_q_gain : p.od_k_gain) + j * 64 + l8 * 8;
      const f32x4 g0 = *(const f32x4*)gain, g1 = *(const f32x4*)(gain + 4);
      const float gg[8] = {g0.x, g0.y, g0.z, g0.w, g1.x, g1.y, g1.z, g1.w};
      const float sc = (type == 0) ? 0.125f * LOG2E : 1.f;
#pragma unroll
      for (int it = 0; it < 8; ++it) {
        const int row = (t >> 4) + 16 * it;
        float v[8];
        float ss = 0.f;
#pragma unroll
        for (int e = 0; e < 8; ++e) { v[e] = c[it * 8 + e]; ss += v[e] * v[e]; }
        ss += __shfl_xor(ss, 1); ss += __shfl_xor(ss, 2); ss += __shfl_xor(ss, 4);
        const float rstd = rsqrtf(ss * (1.f / 64.f) + EPS) * sc;
#pragma unroll
        for (int e = 0; e < 8; ++e) v[e] *= rstd * gg[e];
        *(u32x4*)(dstb + ((size_t)(b * 16 + hh0 + hsel) * KEYS + pos0 + row) * 64 + l8 * 8) = pack8(v);
      }
    } else if (type == 2) {
      bf16_t* VCT = (bf16_t*)(p.ws + WS_VCT);
      const int rg = t & 15;
#pragma unroll
      for (int it = 0; it < 8; ++it) {
        const int cc = (t >> 4) + 16 * it, head = hh0 + (cc >> 6), e = cc & 63;
        *(u32x4*)(VCT + ((size_t)(b * 16 + head) * 64 + e) * KEYS + pos0 + rg * 8) = pack8(c + it * 8);
      }
    } else {
      bf16_t* ZC = (bf16_t*)(p.ws + WS_ZC);
      const int ch = t & 15;
#pragma unroll
      for (int it = 0; it < 8; ++it) {
        const int row = (t >> 4) + 16 * it;
        *(u32x4*)(ZC + (size_t)(m0 + row) * D + (n0 - 3072) + ch * 8) = pack8(c + it * 8);
      }
    }
  }
};

__global__ void __launch_bounds__(256, 2) fwd_megakernel(Params p) {
  extern __shared__ __attribute__((aligned(16))) unsigned char smem[];
  cg::grid_group grid = cg::this_grid();
  unsigned char* lds = smem;
  volatile LAS unsigned* stw = (volatile LAS unsigned*)(smem + LDS_MAIN);
  if (__builtin_amdgcn_workitem_id_x() < 4) stw[__builtin_amdgcn_workitem_id_x()] = 0u;
  __syncthreads();
  const XcdBarrier xbar = xcd_barrier_post((unsigned*)(p.ws + WS_BAR), stw);
  if (p.ws == nullptr) grid.sync();

  for (int rep = 0; rep < NREP(5); ++rep) phase_setup(p, lds);
  GSYNC();

  for (int layer = 0; layer < 4; ++layer) {
    const int j = layer >> 1;
    for (int rep = 0; rep < NREP(4); ++rep) phase_norm(p, layer, lds);
    GSYNC();
    if ((layer & 1) == 0) {
      for (int rep = 0; rep < NREP(0); ++rep) phase_ev_win(p, lds);
      GSYNC();
      for (int rep = 0; rep < NREP(2); ++rep) {
        { EvQOps ops; ops.pp = &p; ops.j = j; gemm_glds2<3, EvQOps, true, true>(1152, U1W, 768, ops, lds); }
        { EvKvOps ops; ops.pp = &p; ops.j = j; gemm_glds2<4, EvKvOps, true, true>(1152, U1W, 256, ops, lds, 128); }
        for (int id = (blockIdx.x + 256) % gridDim.x; id < 1152; id += gridDim.x) gla_g1_item(p, j, id, lds);
      }
      GSYNC();
      {
        const bf16_t* QA = (const bf16_t*)(p.ws + WS_R1 + R1_QA);
        const bf16_t* KA = (const bf16_t*)(p.ws + WS_R1 + R1_KA);
        const bf16_t* VAT = (const bf16_t*)(p.ws + WS_R1 + R1_VAT);
        const bf16_t* U2 = (const bf16_t*)(p.ws + WS_U2);
        bf16_t* MIX = (bf16_t*)(p.ws + WS_R2);
        for (int rep = 0; rep < NREP(1); ++rep)
        for (int id = blockIdx.x; id < (rep == 0 ? 512 + 512 : 512); id += gridDim.x) {
          if (id < 512) {
            const int qb = id & 7, head = (id >> 3) & 7, b = id >> 6;
            attn_dense_item2<96, 8>(QA, KA, VAT, U2 + U2_ZA, U2W, MIX, b, head, qb * 256, 0, KEYS / 64, lds);
          } else {
            gla_scan_item(p, id - 512);
          }
        }
      }
      GSYNC();
      {
        const bf16_t* QA = (const bf16_t*)(p.ws + WS_R1 + R1_QA);
        const bf16_t* KA = (const bf16_t*)(p.ws + WS_R1 + R1_KA);
        const bf16_t* VAT = (const bf16_t*)(p.ws + WS_R1 + R1_VAT);
        const bf16_t* U2 = (const bf16_t*)(p.ws + WS_U2);
        bf16_t* MIX = (bf16_t*)(p.ws + WS_R2);
        for (int rep = 0; rep < NREP(3); ++rep)
        for (int id = blockIdx.x; id < 1152 + 64; id += gridDim.x) {
          if (id < 1152) gla_g3_item(p, j, id, lds);
          else {
            const int i2 = id - 1152, head = i2 & 7, b = i2 >> 3;
            attn_dense_item2<96, 8>(QA, KA, VAT, U2 + U2_ZA, U2W, MIX, b, head, SEQ, SEQ, CTXL / 64, lds);
          }
        }
      }
      GSYNC();
    } else {
      for (int rep = 0; rep < NREP(0); ++rep) {
        OdWinOps2 ops; ops.pp = &p; ops.j = j; ops.layer = layer;
        gemm_glds2<4>(144 * 32, D, D, ops, lds);
      }
      GSYNC();
      {
        const int nctx = (layer == 3) ? 0 : 128;
        const bf16_t* QC = (const bf16_t*)(p.ws + WS_QC);
        const bf16_t* KC = (const bf16_t*)(p.ws + WS_KC);
        const bf16_t* VCT = (const bf16_t*)(p.ws + WS_VCT);
        const bf16_t* ZC = (const bf16_t*)(p.ws + WS_ZC);
        bf16_t* MIX = (bf16_t*)(p.ws + WS_OH);
        for (int rep = 0; rep < NREP(1); ++rep)
        for (int id = blockIdx.x; id < 1024 + nctx; id += gridDim.x) {
          if (id < 1024) natten_item2(p, j, id, lds);
          else {
            const int i2 = id - 1024, head = i2 & 15, b = i2 >> 4;
            attn_dense_item2<64, 16>(QC, KC, VCT, ZC, D, MIX, b, head, SEQ, SEQ, CTXL / 64, lds);
          }
        }
      }
      GSYNC();
    }
    phase_wout(p, layer, lds);
    if (layer < 3) GSYNC();
  }
}

extern "C" void kernel_launch(void* const* d_in, const int* in_sizes, int n_in, void* d_out, int out_size, void* d_ws, size_t ws_size,
                              hipStream_t stream) {
  static int grid_blocks = 0;
  if (!grid_blocks) {
    int dev = 0, cus = 0, per_cu = 0;
    hipGetDevice(&dev);
    hipDeviceGetAttribute(&cus, hipDeviceAttributeMultiprocessorCount, dev);
    hipFuncSetAttribute((const void*)fwd_megakernel, hipFuncAttributeMaxDynamicSharedMemorySize, LDS_BYTES);
    hipOccupancyMaxActiveBlocksPerMultiprocessor(&per_cu, (const void*)fwd_megakernel, 256, LDS_BYTES);
    if (per_cu < 1) per_cu = 1;
    if (per_cu > 2) per_cu = 2;
    grid_blocks = cus * per_cu;
    if (ws_size < WS_NEED) fprintf(stderr, "kernel_launch: workspace too small: %zu < %zu\n", ws_size, (size_t)WS_NEED);
  }
  Params p{};
  const float** pp = (const float**)&p;
  for (int i = 0; i < 23; ++i) pp[i] = (const float*)d_in[i];
  p.out = (float*)d_out;
  p.ws = (unsigned char*)d_ws;
  hipMemsetAsync((unsigned char*)d_ws + WS_BAR, 0, BAR_BYTES, stream);
  void* args[] = {&p};
  hipError_t e = hipLaunchCooperativeKernel((const void*)fwd_megakernel, dim3(grid_blocks), dim3(256), args, LDS_BYTES, stream);
  if (e != hipSuccess) fprintf(stderr, "cooperative launch failed: %s (grid %d)\n", hipGetErrorString(e), grid_blocks);
}
```
